# Optimizing an MI355X kernel written in HIP

```python
import math
import jax, jax.numpy as jnp
from jax import lax
import numpy as np

D_MODEL = 2048
BATCH = 2
SEQ = 4096
DEPTH = 2
DEC_BATCH = 128
DEC_SEQ = 8
PAST_LEN = 8192
PAGE_SIZE = 128

N_EVEN = (DEPTH + 1) // 2
N_ODD = DEPTH // 2

SWA_HEADS = 16
SWA_KV_HEADS = 4
SWA_HEAD_DIM = 64
SWA_GROUP = SWA_HEADS // SWA_KV_HEADS
WINDOW = 128
ROPE_THETA = 500000.0
ROPE_DIM = SWA_HEAD_DIM // 4

GMLP_GROUPS = 4
GMLP_WIDTH = 1024
GMLP_GROUP_DIM = GMLP_WIDTH // GMLP_GROUPS
GMLP_CHUNK = 128

SWA_Q_W = SWA_HEADS * SWA_HEAD_DIM
SWA_KV_W = SWA_KV_HEADS * SWA_HEAD_DIM
AB_IN = SWA_Q_W + 2 * SWA_KV_W + 2 * GMLP_WIDTH
AB_OUT = SWA_Q_W + GMLP_WIDTH

RET_HEADS = 8
RET_KEY_DIM = D_MODEL // RET_HEADS
RET_VAL_DIM = 2 * RET_KEY_DIM
RET_CHUNK = 128
RET_THETA = 10000.0
RET_IN = 2 * RET_HEADS * RET_KEY_DIM + 2 * RET_HEADS * RET_VAL_DIM

MEM_LEN = 256
MEM_HEADS = 4
MEM_HEAD_DIM = 128
MEM_W = MEM_HEADS * MEM_HEAD_DIM

D_FF = 4 * D_MODEL

EPS = 1e-6
NEG_INF = -1e30

kernel_name = "hybrid_swa_gmlp_retention_decode_step"


def rms_norm(x, g):
    xf = x.astype(jnp.float32)
    y = xf * lax.rsqrt(jnp.mean(xf * xf, axis=-1, keepdims=True) + EPS)
    return (y * g.astype(jnp.float32)).astype(x.dtype)


def layer_norm(x, g, b):
    xf = x.astype(jnp.float32)
    mu = jnp.mean(xf, axis=-1, keepdims=True)
    xc = xf - mu
    y = xc * lax.rsqrt(jnp.mean(xc * xc, axis=-1, keepdims=True) + EPS)
    return (y * g.astype(jnp.float32) + b.astype(jnp.float32)).astype(x.dtype)


def rope(x, pos, rot_dim, theta):
    half = rot_dim // 2
    inv = theta ** (-jnp.arange(half, dtype=jnp.float32) / half)
    ang = pos.astype(jnp.float32)[:, None] * inv[None, :]
    cos = jnp.cos(ang)[:, None, :]
    sin = jnp.sin(ang)[:, None, :]
    xf = x[..., :rot_dim].astype(jnp.float32)
    x1, x2 = xf[..., :half], xf[..., half:]
    rot = jnp.concatenate([x1 * cos - x2 * sin, x2 * cos + x1 * sin], axis=-1).astype(x.dtype)
    return jnp.concatenate([rot, x[..., rot_dim:]], axis=-1)


def sink_softmax(scores, sinks):
    m = jnp.maximum(jnp.max(scores, axis=-1, keepdims=True), sinks)
    p = jnp.exp(scores - m)
    return p / (jnp.sum(p, axis=-1, keepdims=True) + jnp.exp(sinks - m))


def ab_project(h, pos, w_in, ln_g, ln_b):
    z = h @ w_in
    q, k, v, zu, zv = jnp.split(z, [SWA_Q_W, SWA_Q_W + SWA_KV_W, SWA_Q_W + 2 * SWA_KV_W,
                                   SWA_Q_W + 2 * SWA_KV_W + GMLP_WIDTH], axis=-1)
    lead = h.shape[:-1]
    q = rope(q.reshape(*lead, SWA_HEADS, SWA_HEAD_DIM), pos, ROPE_DIM, ROPE_THETA)
    k = rope(k.reshape(*lead, SWA_KV_HEADS, SWA_HEAD_DIM), pos, ROPE_DIM, ROPE_THETA)
    v = v.reshape(*lead, SWA_KV_HEADS, SWA_HEAD_DIM)
    zu = jax.nn.gelu(zu)
    zv = layer_norm(jax.nn.gelu(zv), ln_g, ln_b)
    return q, k, v, zu, zv


def swa_banded(q, k, v, sinks):
    b, s = q.shape[:2]
    nb = s // WINDOW
    qb = q.reshape(b, nb, WINDOW, SWA_KV_HEADS, SWA_GROUP, SWA_HEAD_DIM)
    kb = k.reshape(b, nb, WINDOW, SWA_KV_HEADS, SWA_HEAD_DIM)
    vb = v.reshape(b, nb, WINDOW, SWA_KV_HEADS, SWA_HEAD_DIM)
    pad = ((0, 0), (1, 0), (0, 0), (0, 0), (0, 0))
    kcat = jnp.concatenate([jnp.pad(kb, pad)[:, :-1], kb], axis=2)
    vcat = jnp.concatenate([jnp.pad(vb, pad)[:, :-1], vb], axis=2)
    scores = jnp.einsum('bnqkgd,bnskd->bnkgqs', qb, kcat,
                        preferred_element_type=jnp.float32) * (SWA_HEAD_DIM ** -0.5)
    t = jnp.arange(WINDOW)[:, None]
    sk = jnp.arange(2 * WINDOW)[None, :]
    band = (sk <= t + WINDOW) & (sk > t)
    not_pad = (jnp.arange(nb)[:, None, None] > 0) | (sk[None] >= WINDOW)
    valid = band[None] & not_pad
    scores = jnp.where(valid[None, :, None, None], scores, NEG_INF)
    probs = sink_softmax(scores, sinks.astype(jnp.float32).reshape(SWA_KV_HEADS, SWA_GROUP)[:, :, None, None])
    o = jnp.einsum('bnkgqs,bnskd->bnqkgd', probs.astype(v.dtype), vcat)
    return o.reshape(b, s, SWA_HEADS, SWA_HEAD_DIM)


def swa_with_buffer(q, k, v, buf_k, buf_v, sinks):
    n, t = q.shape[:2]
    kall = jnp.concatenate([buf_k.astype(k.dtype), k], axis=1)
    vall = jnp.concatenate([buf_v.astype(v.dtype), v], axis=1)
    qg = q.reshape(n, t, SWA_KV_HEADS, SWA_GROUP, SWA_HEAD_DIM)
    scores = jnp.einsum('ntkgd,nskd->nkgts', qg, kall,
                        preferred_element_type=jnp.float32) * (SWA_HEAD_DIM ** -0.5)
    qpos = PAST_LEN + jnp.arange(t)[:, None]
    kpos = PAST_LEN - WINDOW + jnp.arange(WINDOW + t)[None, :]
    valid = (kpos <= qpos) & (kpos > qpos - WINDOW)
    scores = jnp.where(valid, scores, NEG_INF)
    probs = sink_softmax(scores, sinks.astype(jnp.float32).reshape(SWA_KV_HEADS, SWA_GROUP)[:, :, None, None])
    o = jnp.einsum('nkgts,nskd->ntkgd', probs.astype(vall.dtype), vall)
    return o.reshape(n, t, SWA_HEADS, SWA_HEAD_DIM), kall[:, -WINDOW:], vall[:, -WINDOW:]


def spatial_gate(zu, zv, w_s, b_s):
    l = zv.shape[-3]
    w = jnp.tril(w_s[:, :l, :l])
    mixed = jnp.einsum('gij,...jgd->...igd', w.astype(zv.dtype), zv) + b_s[:, :l].T[:, :, None]
    return zu * mixed


def ab_mixer_prompt(h, pos, w_in, w_out, sinks, ln_g, ln_b, w_s, b_s):
    q, k, v, zu, zv = ab_project(h, pos, w_in, ln_g, ln_b)
    b, s = h.shape[:2]
    attn = swa_banded(q, k, v, sinks).reshape(b, s, SWA_Q_W)
    nc = s // GMLP_CHUNK
    shp = (b, nc, GMLP_CHUNK, GMLP_GROUPS, GMLP_GROUP_DIM)
    gate = spatial_gate(zu.reshape(shp), zv.reshape(shp), w_s, b_s).reshape(b, s, GMLP_WIDTH)
    y = jnp.concatenate([attn, gate], axis=-1) @ w_out
    return y, k[:, -WINDOW:], v[:, -WINDOW:]


def ab_mixer_sample(h, pos, buf_k, buf_v, w_in, w_out, sinks, ln_g, ln_b, w_s, b_s):
    q, k, v, zu, zv = ab_project(h, pos, w_in, ln_g, ln_b)
    n, t = h.shape[:2]
    attn, new_k, new_v = swa_with_buffer(q, k, v, buf_k, buf_v, sinks)
    shp = (n, t, GMLP_GROUPS, GMLP_GROUP_DIM)
    gate = spatial_gate(zu.reshape(shp), zv.reshape(shp), w_s, b_s).reshape(n, t, GMLP_WIDTH)
    y = jnp.concatenate([attn.reshape(n, t, SWA_Q_W), gate], axis=-1) @ w_out
    return y, new_k, new_v, zv


def ret_log_decay():
    return jnp.log1p(-jnp.exp2(-5.0 - jnp.arange(RET_HEADS, dtype=jnp.float32)))


def ret_project(h, pos, w_in):
    z = h @ w_in
    nk = RET_HEADS * RET_KEY_DIM
    nv = RET_HEADS * RET_VAL_DIM
    q, k, v, g = jnp.split(z, [nk, 2 * nk, 2 * nk + nv], axis=-1)
    lead = h.shape[:-1]
    q = rope(q.reshape(*lead, RET_HEADS, RET_KEY_DIM), pos, RET_KEY_DIM, RET_THETA)
    k = rope(k.reshape(*lead, RET_HEADS, RET_KEY_DIM), pos, RET_KEY_DIM, RET_THETA) * (RET_KEY_DIM ** -0.5)
    v = v.reshape(*lead, RET_HEADS, RET_VAL_DIM)
    return q, k, v, g


def retention_chunk(s0, q, k, v):
    l = q.shape[1]
    lg = ret_log_decay()
    idx = jnp.arange(l, dtype=jnp.float32)
    diff = idx[:, None] - idx[None, :]
    dmat = jnp.where(diff >= 0, jnp.exp(lg[:, None, None] * jnp.maximum(diff, 0.0)), 0.0)
    q_dec = jnp.exp(lg[None, :] * (idx[:, None] + 1.0))
    k_dec = jnp.exp(lg[None, :] * (l - 1.0 - idx[:, None]))
    qf, kf, vf = q.astype(jnp.float32), k.astype(jnp.float32), v.astype(jnp.float32)
    att = jnp.einsum('nihd,njhd->nhij', qf, kf) * dmat
    o = (jnp.einsum('nhij,njhe->nihe', att, vf)
         + jnp.einsum('nihd,nhde->nihe', qf * q_dec[:, :, None], s0))
    s1 = (s0 * jnp.exp(lg * l)[:, None, None]
          + jnp.einsum('njhd,njhe->nhde', kf * k_dec[:, :, None], vf))
    return s1, o


def ret_output(o, g, w_out):
    on = o * lax.rsqrt(jnp.mean(o * o, axis=-1, keepdims=True) + EPS)
    lead = g.shape[:-1]
    y = on.reshape(*lead, RET_HEADS * RET_VAL_DIM).astype(g.dtype) * jax.nn.silu(g)
    return y @ w_out


def ret_mixer_prompt(h, pos, w_in, w_out):
    q, k, v, g = ret_project(h, pos, w_in)
    b, s = h.shape[:2]
    nc = s // RET_CHUNK
    def to_chunks(a):
        return a.reshape(b, nc, RET_CHUNK, *a.shape[2:]).swapaxes(0, 1)
    s0 = jnp.zeros((b, RET_HEADS, RET_KEY_DIM, RET_VAL_DIM), jnp.float32)
    s_final, o = lax.scan(lambda st, xs: retention_chunk(st, *xs), s0,
                          (to_chunks(q), to_chunks(k), to_chunks(v)))
    o = o.swapaxes(0, 1).reshape(b, s, RET_HEADS, RET_VAL_DIM)
    return ret_output(o, g, w_out), s_final


def ret_mixer_sample(h, pos, state, w_in, w_out):
    q, k, v, g = ret_project(h, pos, w_in)
    s1, o = retention_chunk(state.astype(jnp.float32), q, k, v)
    return ret_output(o, g, w_out), s1


def mem_kv(mem, g, w_k, w_v):
    m = rms_norm(mem, g)
    lead = mem.shape[:-1]
    return ((m @ w_k).reshape(*lead, MEM_HEADS, MEM_HEAD_DIM),
            (m @ w_v).reshape(*lead, MEM_HEADS, MEM_HEAD_DIM))


def mem_attend(h, w_q, w_o, k, v):
    lead = h.shape[:-1]
    q = (h @ w_q).reshape(*lead, MEM_HEADS, MEM_HEAD_DIM)
    s = jnp.einsum('nshd,nmhd->nhsm', q, k.astype(q.dtype),
                   preferred_element_type=jnp.float32) * (MEM_HEAD_DIM ** -0.5)
    p = jax.nn.softmax(s, axis=-1).astype(q.dtype)
    o = jnp.einsum('nhsm,nmhd->nshd', p, v.astype(q.dtype)).reshape(*lead, MEM_W)
    return o @ w_o


def sq_relu_mlp(h, w_up, w_down):
    a = jax.nn.relu(h @ w_up)
    return (a * a) @ w_down


def setup_inputs(seed: int = 0) -> dict:
    key = jax.random.key(seed)
    keys = iter(jax.random.split(key, 48))

    def nrm(shape, scale):
        return jax.random.normal(next(keys), shape, jnp.float32) * scale

    def gain(shape):
        return 1.0 + nrm(shape, 0.05)

    d = D_MODEL
    return {
        'x_prompt': nrm((BATCH, SEQ, d), 1.0),
        'x_sample': nrm((DEC_BATCH, DEC_SEQ, d), 1.0),
        'cache_swa_k': nrm((N_EVEN, DEC_BATCH, WINDOW, SWA_KV_HEADS, SWA_HEAD_DIM), 1.0),
        'cache_swa_v': nrm((N_EVEN, DEC_BATCH, WINDOW, SWA_KV_HEADS, SWA_HEAD_DIM), 1.0),
        'state_ret': nrm((N_ODD, DEC_BATCH, RET_HEADS, RET_KEY_DIM, RET_VAL_DIM), 0.1),
        'cache_mem_k': nrm((DEPTH, DEC_BATCH, MEM_LEN, MEM_HEADS, MEM_HEAD_DIM), 1.0),
        'cache_mem_v': nrm((DEPTH, DEC_BATCH, MEM_LEN, MEM_HEADS, MEM_HEAD_DIM), 1.0),
        'mem_prompt': nrm((BATCH, MEM_LEN, d), 1.0),
        'norm_mix_pre': gain((DEPTH, d)),
        'norm_mix_post': gain((DEPTH, d)),
        'norm_mem': gain((DEPTH, d)),
        'norm_x_pre': gain((DEPTH, d)),
        'norm_x_post': gain((DEPTH, d)),
        'norm_ffn_pre': gain((DEPTH, d)),
        'norm_ffn_post': gain((DEPTH, d)),
        'w_ab_in': nrm((N_EVEN, d, AB_IN), d ** -0.5),
        'w_ab_out': nrm((N_EVEN, AB_OUT, d), AB_OUT ** -0.5),
        'swa_sinks': nrm((N_EVEN, SWA_HEADS), 0.5),
        'gmlp_ln_g': gain((N_EVEN, GMLP_WIDTH)),
        'gmlp_ln_b': nrm((N_EVEN, GMLP_WIDTH), 0.02),
        'gmlp_w_s': nrm((N_EVEN, GMLP_GROUPS, GMLP_CHUNK, GMLP_CHUNK), GMLP_CHUNK ** -0.5),
        'gmlp_b_s': gain((N_EVEN, GMLP_GROUPS, GMLP_CHUNK)),
        'w_ret_in': nrm((N_ODD, d, RET_IN), d ** -0.5),
        'w_ret_out': nrm((N_ODD, RET_HEADS * RET_VAL_DIM, d), (RET_HEADS * RET_VAL_DIM) ** -0.5),
        'w_mem_q': nrm((DEPTH, d, MEM_W), d ** -0.5),
        'w_mem_k': nrm((DEPTH, d, MEM_W), d ** -0.5),
        'w_mem_v': nrm((DEPTH, d, MEM_W), d ** -0.5),
        'w_mem_o': nrm((DEPTH, MEM_W, d), MEM_W ** -0.5),
        'w_ffn_up': nrm((DEPTH, d, D_FF), d ** -0.5),
        'w_ffn_down': nrm((DEPTH, D_FF, d), D_FF ** -0.5),
    }


def reference(x_prompt, x_sample, cache_swa_k, cache_swa_v, state_ret, cache_mem_k, cache_mem_v,
              mem_prompt, norm_mix_pre, norm_mix_post, norm_mem, norm_x_pre, norm_x_post,
              norm_ffn_pre, norm_ffn_post, w_ab_in, w_ab_out, swa_sinks, gmlp_ln_g, gmlp_ln_b,
              gmlp_w_s, gmlp_b_s, w_ret_in, w_ret_out, w_mem_q, w_mem_k, w_mem_v, w_mem_o,
              w_ffn_up, w_ffn_down):
    pos_p = jnp.arange(x_prompt.shape[1], dtype=jnp.int32)
    pos_s = PAST_LEN + jnp.arange(x_sample.shape[1], dtype=jnp.int32)
    xp, xs = x_prompt, x_sample
    swa_k_p, swa_v_p, swa_k_s, swa_v_s, gmlp_v_s = [], [], [], [], []
    ret_p, ret_s, mem_k_p, mem_v_p = [], [], [], []
    for layer in range(DEPTH):
        j = layer // 2
        hp = rms_norm(xp, norm_mix_pre[layer])
        hs = rms_norm(xs, norm_mix_pre[layer])
        if layer % 2 == 0:
            yp, kp_new, vp_new = ab_mixer_prompt(hp, pos_p, w_ab_in[j], w_ab_out[j], swa_sinks[j],
                                                 gmlp_ln_g[j], gmlp_ln_b[j], gmlp_w_s[j], gmlp_b_s[j])
            ys, ks_new, vs_new, gv_new = ab_mixer_sample(hs, pos_s, cache_swa_k[j], cache_swa_v[j],
                                                         w_ab_in[j], w_ab_out[j], swa_sinks[j],
                                                         gmlp_ln_g[j], gmlp_ln_b[j], gmlp_w_s[j], gmlp_b_s[j])
            swa_k_p.append(kp_new)
            swa_v_p.append(vp_new)
            swa_k_s.append(ks_new)
            swa_v_s.append(vs_new)
            gmlp_v_s.append(gv_new)
        else:
            yp, sp_new = ret_mixer_prompt(hp, pos_p, w_ret_in[j], w_ret_out[j])
            ys, ss_new = ret_mixer_sample(hs, pos_s, state_ret[j], w_ret_in[j], w_ret_out[j])
            ret_p.append(sp_new.astype(state_ret.dtype))
            ret_s.append(ss_new.astype(state_ret.dtype))
        xp = xp + rms_norm(yp, norm_mix_post[layer])
        xs = xs + rms_norm(ys, norm_mix_post[layer])
        mk, mv = mem_kv(mem_prompt, norm_mem[layer], w_mem_k[layer], w_mem_v[layer])
        mem_k_p.append(mk)
        mem_v_p.append(mv)
        xp = xp + rms_norm(mem_attend(rms_norm(xp, norm_x_pre[layer]), w_mem_q[layer], w_mem_o[layer], mk, mv),
                           norm_x_post[layer])
        xs = xs + rms_norm(mem_attend(rms_norm(xs, norm_x_pre[layer]), w_mem_q[layer], w_mem_o[layer],
                                      cache_mem_k[layer], cache_mem_v[layer]), norm_x_post[layer])
        xp = xp + rms_norm(sq_relu_mlp(rms_norm(xp, norm_ffn_pre[layer]), w_ffn_up[layer], w_ffn_down[layer]),
                           norm_ffn_post[layer])
        xs = xs + rms_norm(sq_relu_mlp(rms_norm(xs, norm_ffn_pre[layer]), w_ffn_up[layer], w_ffn_down[layer]),
                           norm_ffn_post[layer])
    return (xp, xs, jnp.stack(swa_k_p), jnp.stack(swa_v_p), jnp.stack(swa_k_s), jnp.stack(swa_v_s),
            jnp.stack(gmlp_v_s), jnp.stack(ret_p), jnp.stack(ret_s), jnp.stack(mem_k_p), jnp.stack(mem_v_p))
```

```cpp
#include <hip/hip_runtime.h>
#include <cstdio>
#include <cstdint>

namespace pg8 {
#define PG8_LAS __attribute__((address_space(3)))
typedef unsigned short bf16_t;
typedef short bf16x8 __attribute__((ext_vector_type(8)));
typedef float f32x4 __attribute__((ext_vector_type(4)));
typedef unsigned u32x4 __attribute__((ext_vector_type(4)));
typedef unsigned u32x2 __attribute__((ext_vector_type(2)));
constexpr int BM = 256, BK = 64, HALF = 128, HTB = HALF * BK * 2  , STAGE_BYTES = 8 * HTB, NXCD = 8, WGM = 8;

__host__ __device__ __forceinline__ int lds_byte(int r, int c) { const int st = (r >> 4) * 2 + (c >> 5), rr = r & 15, cc = c & 31, ob = rr * 64 + cc * 2; return st * 1024 + (ob ^ (((ob >> 9) & 1) << 5)); }
__host__ __device__ __forceinline__ void stage_rc(int b, int& R, int& C) { const int st = b / 1024, sb = b % 1024, swz = sb ^ (((sb >> 9) & 1) << 5); R = (st >> 1) * 16 + swz / 64; C = (st & 1) * 32 + (swz % 64) / 2; }
__host__ __device__ __forceinline__ int perm32(int rho) { const int n = rho >> 4, i = rho & 15; return 8 * (i >> 2) + 4 * n + (i & 3); }

struct Unit { int pm, pn, kt0, nkt; };
struct Gemm { const bf16_t* A; const bf16_t* Bt; int M, N, K; int lda = 0, ldb = 0; };

struct StaticOrder {
    int nM, nN, nwg, G, c, nkt;
    __device__ void init(int M, int N, int K, int G_, int c_) { nM = M / BM; nN = N / BM; nwg = nM * nN; G = G_; c = c_; nkt = K / BK; }
    __device__ bool next(int i, Unit& u) const {
        const int L = i * G + c; if (L >= nwg) return false;
        int wgid = L; { const int q = nwg >> 3, r = nwg & 7, xcd = wgid & 7, off = wgid >> 3; wgid = (xcd < r ? xcd * (q + 1) : r * (q + 1) + (xcd - r) * q) + off; }
        const int nig = WGM * nN, gid = wgid / nig, rem = wgid - gid * nig, fm = gid * WGM; const bool full = (nM - fm) >= WGM;
        u.pm = fm + (full ? (rem & 7) : (rem & 3)); u.pn = full ? (rem >> 3) : (rem >> 2); u.kt0 = 0; u.nkt = nkt; return true;
    }
};
struct StreamK {
    int dpu, nN, w; long S, total;
    __device__ void init(int M, int N, int K, int G_, int w_) { dpu = K / (2 * BK); nN = N / BM; total = (long)(M / BM) * nN * dpu; S = (total + G_ - 1) / G_; w = w_; }
    __device__ bool next(int i, Unit& u) const {
        long pos = (long)w * S; long end = pos + S; if (end > total) end = total;
        for (int k = 0;; ++k) {
            if (pos >= end) return false;
            const int un = (int)(pos / dpu), off = (int)(pos % dpu); long len = dpu - off; if (len > end - pos) len = end - pos;
            if (k == i) { u.pm = un / nN; u.pn = un % nN; u.kt0 = 2 * off; u.nkt = 2 * (int)len; return true; }
            pos += len;
        }
    }
    __device__ static bool split(int pm, int pn, int nN_, int dpu_, long S_) { const long a = (long)(pm * nN_ + pn) * dpu_; return (a / S_) != ((a + dpu_ - 1) / S_); }
};

struct SplitK2 {
    int G, c, nkt;
    __device__ void init(int K, int G_, int c_) { G = G_; c = c_; nkt = K / BK; }
    __device__ bool next(int i, Unit& u) const { const int idx = i * G + c; if (idx >= 144) return false; const int un = idx >> 1; u.pm = un >> 1; u.pn = un & 1; u.kt0 = (idx & 1) * (nkt >> 1); u.nkt = nkt >> 1; return true; }
};
struct PanelK {
    int w, G, nkt, ls;
    int splits;
    __device__ void init(int K, int G_, int w_) { w = w_; G = G_; nkt = K / BK; ls = (nkt >= 16) ? 3 : 2; splits = 1 << ls; }
    __device__ bool next(int i, Unit& u) const {
        int np = 0; for (int x = w; x < 256; x += G) ++np;
        if (i < np) { const int un = w + i * G; u.pm = un >> 3; u.pn = un & 7; u.kt0 = 0; u.nkt = nkt; return true; }
        const int idx = w + (i - np) * G; if (idx >= (32 << ls)) return false;
        const int ns = nkt >> ls, seg = (idx >> 3) & (splits - 1);
        u.pm = 32 + (idx >> (3 + ls)); u.pn = idx & 7; u.kt0 = seg * ns; u.nkt = ns; return true;
    }
};

__device__ __forceinline__ unsigned cvt_pk_bf16(float lo, float hi) { unsigned r; asm volatile("v_cvt_pk_bf16_f32 %0, %1, %2" : "=v"(r) : "v"(lo), "v"(hi)); return r; }

constexpr int MROWS = 9216, NPROMPT = 8192, SEQ = 4096;
__device__ __forceinline__ float pos_of_row(int row) { return (float)(row < NPROMPT ? (row & (SEQ - 1)) : 8192 + ((row - NPROMPT) & 7)); }
__device__ __forceinline__ float rope_inv_turns(int i, float inv_half_log2theta) { return __builtin_amdgcn_exp2f(-(float)i * inv_half_log2theta) * 0.15915494309189535f; }
__device__ __forceinline__ void sincos_turns(float t, float& sn, float& cs) { const float f = __builtin_amdgcn_fractf(t); sn = __builtin_amdgcn_sinf(f); cs = __builtin_amdgcn_cosf(f); }
__device__ __forceinline__ float gelu_tanh(float x) {
    const float u = 0.7978845608028654f * (x + 0.044715f * x * x * x);
    return x * __builtin_amdgcn_rcpf(1.0f + __builtin_amdgcn_exp2f(-2.885390081777927f * u));
}
__device__ __forceinline__ float silu_f(float x) { return x * __builtin_amdgcn_rcpf(1.0f + __builtin_amdgcn_exp2f(-1.4426950408889634f * x)); }
__device__ __forceinline__ u32x4 pack8(const f32x4& a, const f32x4& b) { u32x4 w; w.x = cvt_pk_bf16(a[0], a[1]); w.y = cvt_pk_bf16(a[2], a[3]); w.z = cvt_pk_bf16(b[0], b[1]); w.w = cvt_pk_bf16(b[2], b[3]); return w; }

struct EpiPart {
    static constexpr bool PERM = true, AFTER_DRAIN = false;
    bf16_t* Y; bf16_t* P;
    __device__ __forceinline__ void operator()(const f32x4 (&acc)[2][2][4][2], const Unit& u, int wr, int wc, int fr, int fq) const {
        bf16_t* base = (u.pm < 32) ? Y + (size_t)u.pm * BM * 2048 : P + ((size_t)(u.kt0 >> __builtin_ctz(u.nkt)) * 1024 + (size_t)(u.pm - 32) * BM) * 2048;
        const int col0 = u.pn * BM + wc * 32 + 8 * fq;
#pragma unroll
        for (int ai = 0; ai < 2; ++ai)
#pragma unroll
            for (int m = 0; m < 4; ++m) { bf16_t* rowp = base + (size_t)(ai * HALF + wr * 64 + m * 16 + fr) * 2048 + col0;
#pragma unroll
                for (int bj = 0; bj < 2; ++bj) *(u32x4*)(rowp + bj * HALF) = pack8(acc[ai][bj][m][0], acc[ai][bj][m][1]);
                asm volatile("" ::: "memory"); }
    }
};
template <int ACT> struct EpiBf16 {
    static constexpr bool PERM = true, AFTER_DRAIN = false;
    bf16_t* O; int ldc; const float* rs;
    size_t seg_stride = 0;
    __device__ __forceinline__ void operator()(const f32x4 (&acc)[2][2][4][2], const Unit& u, int wr, int wc, int fr, int fq) const {
        const int col0 = u.pn * BM + wc * 32 + 8 * fq;
        float rsv[2][4];
#pragma unroll
        for (int ai = 0; ai < 2; ++ai)
#pragma unroll
            for (int m = 0; m < 4; ++m) rsv[ai][m] = rs[u.pm * BM + ai * HALF + wr * 64 + m * 16 + fr];
#pragma unroll
        for (int ai = 0; ai < 2; ++ai)
#pragma unroll
            for (int m = 0; m < 4; ++m) { const int row = u.pm * BM + ai * HALF + wr * 64 + m * 16 + fr; const float scale = rsv[ai][m]; bf16_t* rowp = O + (u.kt0 ? seg_stride : 0) + (size_t)row * ldc + col0;
#pragma unroll
                for (int bj = 0; bj < 2; ++bj) { f32x4 v0 = acc[ai][bj][m][0], v1 = acc[ai][bj][m][1];
                    if (ACT == 2) {
#pragma unroll
                        for (int e = 0; e < 4; ++e) { const float a = fmaxf(v0[e] * scale, 0.f), b = fmaxf(v1[e] * scale, 0.f); v0[e] = a * a; v1[e] = b * b; } }
                    else { v0 = v0 * scale; v1 = v1 * scale; }
                    *(u32x4*)(rowp + bj * HALF) = pack8(v0, v1); }
                asm volatile("" ::: "memory"); }
    }
};
struct EpiAbIn {
    static constexpr bool PERM = true, AFTER_DRAIN = false;
    bf16_t* big; float* out;
    const float* rs;
    unsigned long long* zvstat;
    static constexpr size_t OQ = 0, OK = 9437184, OV = OK + 2359296, OZU = 14155776, OZV = 23592960;
    static constexpr size_t OKP = 18874368, OVP = 18939904, OKS = 19005440, OVS = 23199744;
    __device__ __forceinline__ void operator()(const f32x4 (&acc)[2][2][4][2], const Unit& u, int wr, int wc, int fr, int fq) const {
        const int pn = u.pn;
        bf16_t* const Q = big + OQ; bf16_t* const K = big + OK; bf16_t* const V = big + OV; bf16_t* const ZU = big + OZU; bf16_t* const ZV = big + OZV;
        float* const okp = out + OKP; float* const ovp = out + OVP; float* const oks = out + OKS; float* const ovs = out + OVS;
        float rsv[2][4];
#pragma unroll
        for (int ai = 0; ai < 2; ++ai)
#pragma unroll
            for (int m = 0; m < 4; ++m) rsv[ai][m] = rs[u.pm * BM + ai * HALF + wr * 64 + m * 16 + fr];
#pragma unroll
        for (int ai = 0; ai < 2; ++ai)
#pragma unroll
            for (int m = 0; m < 4; ++m) {
                const int row = u.pm * BM + ai * HALF + wr * 64 + m * 16 + fr; const float rsc = rsv[ai][m];
                if (pn < 5) {
                    const float pos = pos_of_row(row);
#pragma unroll
                    for (int bj = 0; bj < 2; ++bj) { f32x4 v0 = acc[ai][bj][m][0] * rsc, v1 = acc[ai][bj][m][1] * rsc;
                        if ((wc & 1) == 0) {
                            const float sg = (fq == 0) ? -1.f : 1.f;
#pragma unroll
                            for (int e = 0; e < 4; ++e) { const float p0 = __shfl_xor(v0[e], 16), p1 = __shfl_xor(v1[e], 16); float sn, cs;
                                sincos_turns(pos * rope_inv_turns(e, 2.3664460f), sn, cs); const float r0 = v0[e] * cs + sg * p0 * sn;
                                sincos_turns(pos * rope_inv_turns(4 + e, 2.3664460f), sn, cs); const float r1 = v1[e] * cs + sg * p1 * sn;
                                if (fq < 2) { v0[e] = r0; v1[e] = r1; } }
                        }
                        const int c = bj * HALF + wc * 32 + 8 * fq;
                        if (pn < 4) *(u32x4*)(Q + (size_t)row * 1024 + pn * BM + c) = pack8(v0, v1);
                        else { *(u32x4*)(K + (size_t)row * 256 + c) = pack8(v0, v1);
                            float* o = nullptr;
                            if (row < NPROMPT) { const int s = row & (SEQ - 1); if (s >= SEQ - 128) o = okp + ((size_t)(row >> 12) * 128 + (s - (SEQ - 128))) * 256 + c; }
                            else { const int r = row - NPROMPT; o = oks + ((size_t)(r >> 3) * 128 + 120 + (r & 7)) * 256 + c; }
                            if (o) { *(f32x4*)o = v0; *(f32x4*)(o + 4) = v1; } }
                    }
                } else if (pn == 5) {
#pragma unroll
                    for (int bj = 0; bj < 2; ++bj) { const f32x4 v0 = acc[ai][bj][m][0] * rsc, v1 = acc[ai][bj][m][1] * rsc; const int c = bj * HALF + wc * 32 + 8 * fq;
                        *(u32x4*)(V + (size_t)row * 256 + c) = pack8(v0, v1);
                        float* o = nullptr;
                        if (row < NPROMPT) { const int s = row & (SEQ - 1); if (s >= SEQ - 128) o = ovp + ((size_t)(row >> 12) * 128 + (s - (SEQ - 128))) * 256 + c; }
                        else { const int r = row - NPROMPT; o = ovs + ((size_t)(r >> 3) * 128 + 120 + (r & 7)) * 256 + c; }
                        if (o) { *(f32x4*)o = v0; *(f32x4*)(o + 4) = v1; } }
                } else {
                    float s1 = 0.f, s2 = 0.f;
#pragma unroll
                    for (int bj = 0; bj < 2; ++bj) { f32x4 v0 = acc[ai][bj][m][0] * rsc, v1 = acc[ai][bj][m][1] * rsc;
#pragma unroll
                        for (int e = 0; e < 4; ++e) { v0[e] = gelu_tanh(v0[e]); v1[e] = gelu_tanh(v1[e]); s1 += v0[e] + v1[e]; s2 += v0[e] * v0[e] + v1[e] * v1[e]; }
                        const int c = bj * HALF + wc * 32 + 8 * fq;
                        if (pn < 10) *(u32x4*)(ZU + (size_t)row * 1024 + (pn - 6) * BM + c) = pack8(v0, v1);
                        else *(u32x4*)(ZV + (size_t)row * 1024 + (pn - 10) * BM + c) = pack8(v0, v1); }
                    if (pn >= 10) { s1 += __shfl_xor(s1, 16); s1 += __shfl_xor(s1, 32); s2 += __shfl_xor(s2, 16); s2 += __shfl_xor(s2, 32);
                        if (fq == 0) { atomicAdd(zvstat + 2 * row, (unsigned long long)(long long)__float2ll_rn(s1 * 16777216.0f)); atomicAdd(zvstat + 2 * row + 1, (unsigned long long)(long long)__float2ll_rn(s2 * 16777216.0f)); } }
                }
                asm volatile("" ::: "memory");
            }
    }
};
struct EpiRetIn {
    static constexpr bool PERM = true, AFTER_DRAIN = false;
    bf16_t* Z; const float* rs;
    __device__ __forceinline__ void operator()(const f32x4 (&acc)[2][2][4][2], const Unit& u, int wr, int wc, int fr, int fq) const {
        const int pn = u.pn;
        float rsv[2][4];
#pragma unroll
        for (int ai = 0; ai < 2; ++ai)
#pragma unroll
            for (int m = 0; m < 4; ++m) rsv[ai][m] = rs[u.pm * BM + ai * HALF + wr * 64 + m * 16 + fr];
#pragma unroll
        for (int ai = 0; ai < 2; ++ai)
#pragma unroll
            for (int m = 0; m < 4; ++m) {
                const int row = u.pm * BM + ai * HALF + wr * 64 + m * 16 + fr;
                bf16_t* rowp = Z + (size_t)row * 12288 + pn * BM + wc * 32 + 8 * fq;
                if (pn < 16) {
                    const float pos = pos_of_row(row); const int ib = wc * 32 + 8 * fq;
                    f32x4 cs[4];
#pragma unroll
                    for (int t = 0; t < 4; ++t) { float s0, c0, s1, c1; sincos_turns(pos * rope_inv_turns(ib + 2 * t, 0.10381025f), s0, c0); sincos_turns(pos * rope_inv_turns(ib + 2 * t + 1, 0.10381025f), s1, c1); cs[t] = (f32x4){c0, s0, c1, s1}; }
                    const float sc = ((pn >= 8) ? 0.0625f : 1.0f) * rsv[ai][m];
                    f32x4 a0 = acc[ai][0][m][0], a1 = acc[ai][0][m][1], b0 = acc[ai][1][m][0], b1 = acc[ai][1][m][1], r0, r1, q0, q1;
                    r0[0] = a0[0] * cs[0][0] - b0[0] * cs[0][1]; q0[0] = b0[0] * cs[0][0] + a0[0] * cs[0][1];
                    r0[1] = a0[1] * cs[0][2] - b0[1] * cs[0][3]; q0[1] = b0[1] * cs[0][2] + a0[1] * cs[0][3];
                    r0[2] = a0[2] * cs[1][0] - b0[2] * cs[1][1]; q0[2] = b0[2] * cs[1][0] + a0[2] * cs[1][1];
                    r0[3] = a0[3] * cs[1][2] - b0[3] * cs[1][3]; q0[3] = b0[3] * cs[1][2] + a0[3] * cs[1][3];
                    r1[0] = a1[0] * cs[2][0] - b1[0] * cs[2][1]; q1[0] = b1[0] * cs[2][0] + a1[0] * cs[2][1];
                    r1[1] = a1[1] * cs[2][2] - b1[1] * cs[2][3]; q1[1] = b1[1] * cs[2][2] + a1[1] * cs[2][3];
                    r1[2] = a1[2] * cs[3][0] - b1[2] * cs[3][1]; q1[2] = b1[2] * cs[3][0] + a1[2] * cs[3][1];
                    r1[3] = a1[3] * cs[3][2] - b1[3] * cs[3][3]; q1[3] = b1[3] * cs[3][2] + a1[3] * cs[3][3];
                    *(u32x4*)(rowp) = pack8(r0 * sc, r1 * sc); *(u32x4*)(rowp + HALF) = pack8(q0 * sc, q1 * sc);
                } else {
                    const float rsc = rsv[ai][m];
#pragma unroll
                    for (int bj = 0; bj < 2; ++bj) { f32x4 v0 = acc[ai][bj][m][0] * rsc, v1 = acc[ai][bj][m][1] * rsc;
                        if (pn >= 32) {
#pragma unroll
                            for (int e = 0; e < 4; ++e) { v0[e] = silu_f(v0[e]); v1[e] = silu_f(v1[e]); } }
                        *(u32x4*)(rowp + bj * HALF) = pack8(v0, v1); }
                }
                asm volatile("" ::: "memory");
            }
    }
};
struct MemKVOrder {
    int G, c;
    __device__ bool next(int i, Unit& u) const { const int idx = i * G + c; if (idx >= 16) return false; u.pm = idx >> 2; u.pn = (u.pm >> 1) * 4 + (idx & 3); u.kt0 = 0; u.nkt = 32; return true; }
};
struct EpiMemKV {
    static constexpr bool PERM = false, AFTER_DRAIN = false;
    float* ok; float* ov; bf16_t* KV;
    __device__ __forceinline__ void operator()(const f32x4 (&acc)[2][2][4][2], const Unit& u, int wr, int wc, int fr, int fq) const {
        const int layer = u.pm >> 1, pn = u.pn & 3;
        const int col0 = pn * BM + wc * 32 + 4 * fq;
        float* o = ((pn < 2) ? ok : ov) + (size_t)layer * 512 * 512; const int cb = (pn < 2) ? col0 : col0 - 512;
        bf16_t* kv = KV + (size_t)layer * 512 * 1024;
#pragma unroll
        for (int ai = 0; ai < 2; ++ai)
#pragma unroll
            for (int m = 0; m < 4; ++m) { const int row = (u.pm & 1) * BM + ai * HALF + wr * 64 + m * 16 + fr;
#pragma unroll
                for (int bj = 0; bj < 2; ++bj)
#pragma unroll
                    for (int n = 0; n < 2; ++n) { const f32x4 v = acc[ai][bj][m][n]; const int c = bj * HALF + n * 16;
                        *(f32x4*)(o + (size_t)row * 512 + cb + c) = v;
                        u32x2 w; w.x = cvt_pk_bf16(v[0], v[1]); w.y = cvt_pk_bf16(v[2], v[3]); *(u32x2*)(kv + (size_t)row * 1024 + col0 + c) = w; }
                asm volatile("" ::: "memory"); }
    }
};

template <class Epi, class Sched, bool ALIGN_EPI = false, bool SP2 = false>
__device__ __forceinline__ void gemm_phase(PG8_LAS unsigned char* lds, const Gemm g, const Sched& S, const Epi& E) {
    int tid_ = threadIdx.x; asm volatile("" : "+v"(tid_));
    const int tid = tid_, wid = __builtin_amdgcn_readfirstlane(tid >> 6), lane = tid & 63, wr = wid >> 2, wc = wid & 3, fr = lane & 15, fq = lane >> 4;
    const int K = g.K, lda = g.lda ? g.lda : K, ldb = g.ldb ? g.ldb : K; int nt; (void)K;
    unsigned voffA[2], voffB[2];
#pragma unroll
    for (int i = 0; i < 2; ++i) { int R, C; stage_rc(tid * 16 + i * 8192, R, C); const int Rb = Epi::PERM ? ((R & ~31) + perm32(R & 31)) : R;
        voffA[i] = (unsigned)(R * lda + C) * 2u; voffB[i] = (unsigned)(Rb * ldb + C) * 2u; }
    const size_t kstep = (size_t)(BK * 2);
    const size_t hstepA = (size_t)HALF * lda * 2, hstepB = (size_t)HALF * ldb * 2;
    const size_t tstepA = 2 * hstepA, tstepB = 2 * hstepB;
    const unsigned ldsw = (unsigned)wid * 1024u;
    const int aoff = lds_byte(wr * 64 + fr, fq * 8), boff = lds_byte(wc * 32 + fr, fq * 8);
#define PG8_SA(b, h) (((b) * 2 + (h)) * HTB)
#define PG8_SB(b, h) ((4 + (b) * 2 + (h)) * HTB)
#define PG8_STAGE(bufoff, gbase, voff) do { _Pragma("unroll") for (int _i = 0; _i < 2; ++_i) \
        __builtin_amdgcn_global_load_lds((const unsigned*)((const char*)(gbase) + (voff)[_i]), (PG8_LAS unsigned*)(lds + (bufoff) + ldsw + _i * 8192), 16, 0, 0); } while (0)
#define PG8_LDA(dst, b, h) do { _Pragma("unroll") for (int m = 0; m < 4; ++m) _Pragma("unroll") for (int k = 0; k < 2; ++k) dst[m][k] = *(const PG8_LAS bf16x8*)(lds + PG8_SA(b, h) + aoff + m * 2048 + k * 1024); } while (0)
#define PG8_LDB(dst, b, h) do { _Pragma("unroll") for (int n = 0; n < 2; ++n) _Pragma("unroll") for (int k = 0; k < 2; ++k) dst[n][k] = *(const PG8_LAS bf16x8*)(lds + PG8_SB(b, h) + boff + n * 2048 + k * 1024); } while (0)
#define PG8_MMA(ai, bj, At, Bt) do { __builtin_amdgcn_s_setprio(1); _Pragma("unroll") for (int m = 0; m < 4; ++m) _Pragma("unroll") for (int n = 0; n < 2; ++n) _Pragma("unroll") for (int k = 0; k < 2; ++k) \
        acc[ai][bj][m][n] = __builtin_amdgcn_mfma_f32_16x16x32_bf16(Bt[n][k], At[m][k], acc[ai][bj][m][n], 0, 0, 0); __builtin_amdgcn_s_setprio(0); } while (0)
#define PG8_WAIT_V(n) asm volatile("s_waitcnt vmcnt(" #n ")" ::: "memory")
#define PG8_WAIT_L(n) asm volatile("s_waitcnt lgkmcnt(" #n ")" ::: "memory")
#define PG8_BAR __builtin_amdgcn_s_barrier()
#define PG8_SCHED __builtin_amdgcn_sched_barrier(0)
    Unit cur, nxt; int ui = 0;
    if (!S.next(0, cur)) return;
    f32x4 acc[2][2][4][2];
#pragma unroll
    for (int a = 0; a < 2; ++a)
#pragma unroll
        for (int b = 0; b < 2; ++b)
#pragma unroll
            for (int m = 0; m < 4; ++m)
#pragma unroll
                for (int n = 0; n < 2; ++n) acc[a][b][m][n] = (f32x4){0.f, 0.f, 0.f, 0.f};
    bf16x8 At[4][2], B0[2][2], B1[2][2];
    const char* cA = (const char*)g.A + (size_t)cur.pm * tstepA + (size_t)cur.kt0 * kstep; const char* cB = (const char*)g.Bt + (size_t)cur.pn * tstepB + (size_t)cur.kt0 * kstep; nt = cur.nkt;
    if constexpr (SP2) {
        PG8_STAGE(PG8_SB(0, 0), cB, voffB); PG8_STAGE(PG8_SB(0, 1), cB + hstepB, voffB); PG8_STAGE(PG8_SA(0, 0), cA, voffA); PG8_STAGE(PG8_SA(0, 1), cA + hstepA, voffA);
        if (wr == 1) PG8_BAR;
        PG8_WAIT_V(2); PG8_BAR;
        PG8_STAGE(PG8_SB(1, 0), cB + kstep, voffB); PG8_STAGE(PG8_SA(1, 0), cA + kstep, voffA); PG8_STAGE(PG8_SB(1, 1), cB + hstepB + kstep, voffB);
        PG8_WAIT_V(6); PG8_BAR;
    } else {
        PG8_STAGE(PG8_SB(0, 0), cB, voffB); PG8_STAGE(PG8_SA(0, 0), cA, voffA); PG8_STAGE(PG8_SB(0, 1), cB + hstepB, voffB); PG8_STAGE(PG8_SA(0, 1), cA + hstepA, voffA);
        if (wr == 1) PG8_BAR;
        PG8_WAIT_V(4); PG8_BAR;
        PG8_STAGE(PG8_SB(1, 0), cB + kstep, voffB); PG8_STAGE(PG8_SA(1, 0), cA + kstep, voffA); PG8_STAGE(PG8_SB(1, 1), cB + hstepB + kstep, voffB);
        PG8_WAIT_V(6); PG8_BAR;
    }
    for (;;) {
        const bool has_next = S.next(ui + 1, nxt);
        const char* nA = has_next ? (const char*)g.A + (size_t)nxt.pm * tstepA + (size_t)nxt.kt0 * kstep : cA; const char* nB = has_next ? (const char*)g.Bt + (size_t)nxt.pn * tstepB + (size_t)nxt.kt0 * kstep : cB;
        for (int t = 0; t < nt; t += 2) {
            const bool last = (t == nt - 2);
            const char* a1 = cA + (size_t)(t + 1) * kstep;
            const char* a2 = last ? nA : cA + (size_t)(t + 2) * kstep; const char* b2 = last ? nB : cB + (size_t)(t + 2) * kstep;
            const char* a3 = a2 + kstep; const char* b3 = b2 + kstep;
            if constexpr (SP2) {
            PG8_LDB(B0, 0, 0); PG8_LDB(B1, 0, 1); PG8_SCHED; PG8_LDA(At, 0, 0); PG8_STAGE(PG8_SA(1, 1), a1 + hstepA, voffA);
            PG8_WAIT_V(8); PG8_WAIT_L(0); PG8_BAR; PG8_MMA(0, 0, At, B0); PG8_MMA(0, 1, At, B1); PG8_BAR; PG8_SCHED;
            PG8_LDA(At, 0, 1); PG8_STAGE(PG8_SB(0, 0), b2, voffB); PG8_STAGE(PG8_SB(0, 1), b2 + hstepB, voffB); PG8_STAGE(PG8_SA(0, 0), a2, voffA);
            PG8_WAIT_V(8); PG8_WAIT_L(0); PG8_BAR; PG8_MMA(1, 0, At, B0); PG8_MMA(1, 1, At, B1); PG8_BAR; PG8_SCHED;
            PG8_LDB(B0, 1, 0); PG8_LDB(B1, 1, 1); PG8_SCHED; PG8_LDA(At, 1, 0); PG8_STAGE(PG8_SA(0, 1), a2 + hstepA, voffA);
            PG8_WAIT_V(8); PG8_WAIT_L(0); PG8_BAR; PG8_MMA(0, 0, At, B0); PG8_MMA(0, 1, At, B1); PG8_BAR; PG8_SCHED;
            PG8_LDA(At, 1, 1); PG8_STAGE(PG8_SB(1, 0), b3, voffB); PG8_STAGE(PG8_SB(1, 1), b3 + hstepB, voffB); PG8_STAGE(PG8_SA(1, 0), a3, voffA);
            PG8_WAIT_V(8); PG8_WAIT_L(0); PG8_BAR; PG8_MMA(1, 0, At, B0); PG8_MMA(1, 1, At, B1); PG8_BAR; PG8_SCHED;
            } else {
            PG8_LDB(B0, 0, 0); PG8_SCHED; PG8_LDA(At, 0, 0); PG8_STAGE(PG8_SA(1, 1), a1 + hstepA, voffA);
            PG8_WAIT_L(8); PG8_BAR; PG8_WAIT_L(0); PG8_MMA(0, 0, At, B0); PG8_BAR; PG8_SCHED;
            PG8_LDB(B1, 0, 1); PG8_STAGE(PG8_SB(0, 0), b2, voffB);
            PG8_BAR; PG8_WAIT_L(0); PG8_MMA(0, 1, At, B1); PG8_BAR;
            PG8_LDA(At, 0, 1); PG8_STAGE(PG8_SA(0, 0), a2, voffA);
            PG8_BAR; PG8_WAIT_L(0); PG8_MMA(1, 0, At, B0); PG8_BAR; PG8_SCHED;
            PG8_STAGE(PG8_SB(0, 1), b2 + hstepB, voffB);
            PG8_WAIT_V(6); PG8_BAR; PG8_MMA(1, 1, At, B1); PG8_BAR;
            PG8_LDB(B0, 1, 0); PG8_SCHED; PG8_LDA(At, 1, 0); PG8_STAGE(PG8_SA(0, 1), a2 + hstepA, voffA);
            PG8_WAIT_L(8); PG8_BAR; PG8_WAIT_L(0); PG8_MMA(0, 0, At, B0); PG8_BAR; PG8_SCHED;
            PG8_LDB(B1, 1, 1); PG8_STAGE(PG8_SB(1, 0), b3, voffB);
            PG8_BAR; PG8_WAIT_L(0); PG8_MMA(0, 1, At, B1); PG8_BAR;
            PG8_LDA(At, 1, 1); PG8_STAGE(PG8_SA(1, 0), a3, voffA);
            PG8_BAR; PG8_WAIT_L(0); PG8_MMA(1, 0, At, B0); PG8_BAR; PG8_SCHED;
            PG8_STAGE(PG8_SB(1, 1), b3 + hstepB, voffB);
            PG8_WAIT_V(6); PG8_BAR; PG8_MMA(1, 1, At, B1); PG8_BAR;
            }
        }
        if constexpr (ALIGN_EPI) { if (wr == 0) PG8_BAR; }
        if constexpr (!Epi::AFTER_DRAIN) { E(acc, cur, wr, wc, fr, fq); }
        if (!has_next) break;
#pragma unroll
        for (int a = 0; a < 2; ++a)
#pragma unroll
            for (int b = 0; b < 2; ++b)
#pragma unroll
                for (int m = 0; m < 4; ++m)
#pragma unroll
                    for (int n = 0; n < 2; ++n) acc[a][b][m][n] = (f32x4){0.f, 0.f, 0.f, 0.f};
        cur = nxt; cA = nA; cB = nB; ++ui; nt = cur.nkt;
        if constexpr (ALIGN_EPI) { if (wr == 1) PG8_BAR; }
    }
    PG8_WAIT_V(0);
    if constexpr (!ALIGN_EPI) { if (wr == 0) PG8_BAR; }
    PG8_BAR;
    if constexpr (Epi::AFTER_DRAIN) { E.fused(acc, cur, wr, wc, fr, fq, lds, wid, lane); }
#undef PG8_SA
#undef PG8_SB
#undef PG8_STAGE
#undef PG8_LDA
#undef PG8_LDB
#undef PG8_MMA
#undef PG8_WAIT_V
#undef PG8_WAIT_L
#undef PG8_BAR
#undef PG8_SCHED
}
}

#define GAS __attribute__((address_space(1)))
#define LAS __attribute__((address_space(3)))
typedef unsigned short bf16;
typedef short bf16x8 __attribute__((ext_vector_type(8)));
typedef short s16x4 __attribute__((ext_vector_type(4)));
typedef float f32x4 __attribute__((ext_vector_type(4)));
typedef float f32x2 __attribute__((ext_vector_type(2)));
typedef unsigned u32x4 __attribute__((ext_vector_type(4)));
typedef unsigned u32x2 __attribute__((ext_vector_type(2)));
typedef GAS unsigned gu32;

constexpr int D = 2048, M = 9216, NP = 8192, SEQ = 4096, NS = 128, TS = 8, FF = 8192;
constexpr int AB_IN = 3584, RET_IN = 12288, MEMW = 512;
constexpr float EPS = 1e-6f;
constexpr int NWAVES = 8, NTHR = 512;

__device__ __forceinline__ float bf2f(unsigned short b) { return __uint_as_float((unsigned)b << 16); }
__device__ __forceinline__ unsigned f2bf(float f) { unsigned u = __float_as_uint(f); return (u + 0x7fffu + ((u >> 16) & 1u)) >> 16; }
__device__ __forceinline__ unsigned pk2(float lo, float hi) { return pg8::cvt_pk_bf16(lo, hi); }
__device__ __forceinline__ float wave_sum(float v) {
#pragma unroll
    for (int o = 1; o < 64; o <<= 1) v += __shfl_xor(v, o);
    return v;
}
__device__ __forceinline__ f32x4 mfma16(bf16x8 a, bf16x8 b, f32x4 c) { return __builtin_amdgcn_mfma_f32_16x16x32_bf16(a, b, c, 0, 0, 0); }
__device__ __forceinline__ bf16x8 frag_nat(const LAS bf16* base, int stride, int row0, int k0, int lane) {
    return *(const LAS bf16x8*)(base + (row0 + (lane & 15)) * stride + k0 + 8 * (lane >> 4));
}
__device__ __forceinline__ s16x4 tr4(const LAS bf16* p) { return __builtin_amdgcn_ds_read_tr16_b64_v4i16((LAS s16x4*)p); }
__device__ __forceinline__ bf16x8 frag_tr(const LAS bf16* base, int stride, int k0, int r0, int lane) {
    const LAS bf16* a = base + (k0 + 8 * (lane >> 4) + ((lane & 15) >> 2)) * stride + r0 + 4 * (lane & 3);
    const s16x4 lo = tr4(a), hi = tr4(a + 4 * stride);
    return (bf16x8){lo[0], lo[1], lo[2], lo[3], hi[0], hi[1], hi[2], hi[3]};
}
__device__ __forceinline__ bf16x8 frag_tr_perm(const LAS bf16* base, int stride, int k0, int r0, int lane) {
    const LAS bf16* a = base + (k0 + 4 * (lane >> 4) + ((lane & 15) >> 2)) * stride + r0 + 4 * (lane & 3);
    const s16x4 lo = tr4(a), hi = tr4(a + 16 * stride);
    return (bf16x8){lo[0], lo[1], lo[2], lo[3], hi[0], hi[1], hi[2], hi[3]};
}
__device__ __forceinline__ bf16x8 pack_p(const f32x4& a, const f32x4& b) {
    u32x4 w; w.x = pk2(a[0], a[1]); w.y = pk2(a[2], a[3]); w.z = pk2(b[0], b[1]); w.w = pk2(b[2], b[3]);
    return __builtin_bit_cast(bf16x8, w);
}
#define WG_SYNC() __syncthreads()

struct Frame {
    LAS unsigned char* lds;
    int tid, lane, wave, vcu, G;
};

struct f32x8 { f32x4 lo, hi; };
__device__ __forceinline__ f32x8 bf8_to_f32(const u32x4 r) { f32x8 o; o.lo = (f32x4){__uint_as_float(r.x << 16), __uint_as_float(r.x & 0xffff0000u), __uint_as_float(r.y << 16), __uint_as_float(r.y & 0xffff0000u)};
    o.hi = (f32x4){__uint_as_float(r.z << 16), __uint_as_float(r.z & 0xffff0000u), __uint_as_float(r.w << 16), __uint_as_float(r.w & 0xffff0000u)}; return o; }
__device__ __forceinline__ u32x4 f32_to_bf8(const f32x8& v) { u32x4 w; w.x = pk2(v.lo[0], v.lo[1]); w.y = pk2(v.lo[2], v.lo[3]); w.z = pk2(v.hi[0], v.hi[1]); w.w = pk2(v.hi[2], v.hi[3]); return w; }
__device__ __forceinline__ float sumsq8(const f32x8& v) { return ((v.lo[0] * v.lo[0] + v.lo[1] * v.lo[1]) + (v.lo[2] * v.lo[2] + v.lo[3] * v.lo[3])) + ((v.hi[0] * v.hi[0] + v.hi[1] * v.hi[1]) + (v.hi[2] * v.hi[2] + v.hi[3] * v.hi[3])); }
template <bool HAS_Y, int NR>
__device__ __forceinline__ void norm_rows(const Frame& F, const float* xin_p, const float* xin_s, const bf16* xin_b, const bf16* Y0, const bf16* P, int splits, const float* gpost, float* rs_out, float* xout, bf16* xout_b) {
    const int gw = F.vcu * NWAVES + F.wave, NGW = F.G * NWAVES, lane = F.lane;
    for (int base = gw; base < NP; base += NR * NGW) {
        u32x4 xr[NR][4], yr[NR][4]; f32x8 xf[NR][4];
#pragma unroll
        for (int r = 0; r < NR; ++r) { const int row = base + r * NGW, rw = row < NP ? row : base;
            if (xin_b) {
#pragma unroll
                for (int j = 0; j < 4; ++j) xr[r][j] = __builtin_nontemporal_load((const u32x4*)(xin_b + (size_t)rw * D) + lane + 64 * j);
            } else {
#pragma unroll
                for (int j = 0; j < 4; ++j) { xf[r][j].lo = __builtin_nontemporal_load((const f32x4*)(xin_p + (size_t)rw * D) + 2 * (lane + 64 * j)); xf[r][j].hi = __builtin_nontemporal_load((const f32x4*)(xin_p + (size_t)rw * D) + 2 * (lane + 64 * j) + 1); }
            }
            if (HAS_Y) {
#pragma unroll
                for (int j = 0; j < 4; ++j) yr[r][j] = __builtin_nontemporal_load((const u32x4*)(Y0 + (size_t)rw * D) + lane + 64 * j); } }
#pragma unroll
        for (int r = 0; r < NR; ++r) { const int row = base + r * NGW; const bool ok = row < NP;
            f32x8 x[4];
#pragma unroll
            for (int j = 0; j < 4; ++j) x[j] = xin_b ? bf8_to_f32(xr[r][j]) : xf[r][j];
            if (HAS_Y) {
                f32x8 y[4]; float ss = 0.f;
#pragma unroll
                for (int j = 0; j < 4; ++j) { y[j] = bf8_to_f32(yr[r][j]); ss += sumsq8(y[j]); }
                const float rs = 1.0f / sqrtf(wave_sum(ss) * (1.0f / D) + EPS);
#pragma unroll
                for (int j = 0; j < 4; ++j) { const f32x4 g0 = ((const f32x4*)gpost)[2 * (lane + 64 * j)], g1 = ((const f32x4*)gpost)[2 * (lane + 64 * j) + 1];
                    x[j].lo += y[j].lo * rs * g0; x[j].hi += y[j].hi * rs * g1;
                    if (xout && ok) { __builtin_nontemporal_store(x[j].lo, (f32x4*)(xout + (size_t)row * D) + 2 * (lane + 64 * j)); __builtin_nontemporal_store(x[j].hi, (f32x4*)(xout + (size_t)row * D) + 2 * (lane + 64 * j) + 1); } }
            }
            if (xout_b) {
#pragma unroll
                for (int j = 0; j < 4; ++j) { const u32x4 w = f32_to_bf8(x[j]); if (ok) ((u32x4*)(xout_b + (size_t)row * D))[lane + 64 * j] = w; x[j] = bf8_to_f32(w); } }
            if (rs_out) { float ss = 0.f;
#pragma unroll
                for (int j = 0; j < 4; ++j) ss += sumsq8(x[j]);
                const float rs = 1.0f / sqrtf(wave_sum(ss) * (1.0f / D) + EPS);
                if (lane == 0 && ok) rs_out[row] = rs; }
        }
    }
    for (int row = NP + gw; row < M; row += NGW) {
        f32x8 x[4];
        if (xin_b) {
#pragma unroll
            for (int j = 0; j < 4; ++j) x[j] = bf8_to_f32(__builtin_nontemporal_load((const u32x4*)(xin_b + (size_t)row * D) + lane + 64 * j));
        } else {
#pragma unroll
            for (int j = 0; j < 4; ++j) { x[j].lo = __builtin_nontemporal_load((const f32x4*)(xin_s + (size_t)(row - NP) * D) + 2 * (lane + 64 * j)); x[j].hi = __builtin_nontemporal_load((const f32x4*)(xin_s + (size_t)(row - NP) * D) + 2 * (lane + 64 * j) + 1); }
        }
        if (HAS_Y) {
            f32x8 y[4];
#pragma unroll
            for (int j = 0; j < 4; ++j) { y[j].lo = (f32x4){0.f, 0.f, 0.f, 0.f}; y[j].hi = y[j].lo; }
            if (splits == 8) {
#pragma unroll
                for (int s = 0; s < 8; ++s)
#pragma unroll
                    for (int j = 0; j < 4; ++j) { const f32x8 v = bf8_to_f32(__builtin_nontemporal_load((const u32x4*)(P + ((size_t)s * 1024 + (row - NP)) * D) + lane + 64 * j)); y[j].lo += v.lo; y[j].hi += v.hi; }
            } else {
                for (int s = 0; s < splits; ++s)
#pragma unroll
                    for (int j = 0; j < 4; ++j) { const f32x8 v = bf8_to_f32(__builtin_nontemporal_load((const u32x4*)(P + ((size_t)s * 1024 + (row - NP)) * D) + lane + 64 * j)); y[j].lo += v.lo; y[j].hi += v.hi; }
            }
            float ss = 0.f;
#pragma unroll
            for (int j = 0; j < 4; ++j) ss += sumsq8(y[j]);
            const float rs = 1.0f / sqrtf(wave_sum(ss) * (1.0f / D) + EPS);
#pragma unroll
            for (int j = 0; j < 4; ++j) { const f32x4 g0 = ((const f32x4*)gpost)[2 * (lane + 64 * j)], g1 = ((const f32x4*)gpost)[2 * (lane + 64 * j) + 1];
                x[j].lo += y[j].lo * rs * g0; x[j].hi += y[j].hi * rs * g1;
                if (xout) { __builtin_nontemporal_store(x[j].lo, (f32x4*)(xout + (size_t)row * D) + 2 * (lane + 64 * j)); __builtin_nontemporal_store(x[j].hi, (f32x4*)(xout + (size_t)row * D) + 2 * (lane + 64 * j) + 1); } }
        }
        if (xout_b) {
#pragma unroll
            for (int j = 0; j < 4; ++j) { const u32x4 w = f32_to_bf8(x[j]); ((u32x4*)(xout_b + (size_t)row * D))[lane + 64 * j] = w; x[j] = bf8_to_f32(w); } }
        if (rs_out) { float ss = 0.f;
#pragma unroll
            for (int j = 0; j < 4; ++j) ss += sumsq8(x[j]);
            const float rs = 1.0f / sqrtf(wave_sum(ss) * (1.0f / D) + EPS);
            if (lane == 0) rs_out[row] = rs; }
    }
}

__device__ __forceinline__ void transpose_item(const float* W, int K, int N, bf16* WT, LAS float* scr, int item, int lane, const float* gain = nullptr, int ldw = 0) {
    const int nblk = N / 64, kb = item / nblk, nb = item % nblk, k0 = 64 * kb, n0 = 64 * nb;
    f32x4 v[16];
#pragma unroll
    for (int i = 0; i < 16; ++i) v[i] = __builtin_nontemporal_load((const f32x4*)(W + (size_t)(k0 + 4 * i + (lane >> 4)) * N + n0 + 4 * (lane & 15)));
#pragma unroll
    for (int i = 0; i < 16; ++i) { LAS float* s = scr + (4 * i + (lane >> 4)) * 65 + 4 * (lane & 15); const float gk = gain ? gain[k0 + 4 * i + (lane >> 4)] : 1.0f; s[0] = v[i][0] * gk; s[1] = v[i][1] * gk; s[2] = v[i][2] * gk; s[3] = v[i][3] * gk; }
    asm volatile("s_waitcnt lgkmcnt(0)" ::: "memory");
    const int c = lane & 7;
#pragma unroll
    for (int j = 0; j < 8; ++j) { const int n = (lane >> 3) + 8 * j; const LAS float* s = scr + (8 * c) * 65 + n;
        u32x4 o; o.x = pk2(s[0 * 65], s[1 * 65]); o.y = pk2(s[2 * 65], s[3 * 65]); o.z = pk2(s[4 * 65], s[5 * 65]); o.w = pk2(s[6 * 65], s[7 * 65]);
        *(u32x4*)(WT + (size_t)(n0 + n) * (ldw ? ldw : K) + k0 + 8 * c) = o; }
    asm volatile("s_waitcnt lgkmcnt(0)" ::: "memory");
}
__device__ __forceinline__ void transpose_strided(const float* W, int K, int N, bf16* WT, LAS float* scr, int it0, int stride, int nit, int lane, const float* gain = nullptr, int ldw = 0) {
    const int nblk = N / 64, ldo = ldw ? ldw : K;
#define TR_LOAD(v, item) do { const int kb_ = (item) / nblk, nb_ = (item) - kb_ * nblk; _Pragma("unroll") for (int i = 0; i < 16; ++i) v[i] = __builtin_nontemporal_load((const f32x4*)(W + (size_t)(64 * kb_ + 4 * i + (lane >> 4)) * N + 64 * nb_ + 4 * (lane & 15))); } while (0)
#define TR_STORE(v, item) do { const int kb_ = (item) / nblk, nb_ = (item) - kb_ * nblk, k0 = 64 * kb_, n0 = 64 * nb_; \
        _Pragma("unroll") for (int i = 0; i < 16; ++i) { LAS float* s = scr + (4 * i + (lane >> 4)) * 65 + 4 * (lane & 15); const float gk = gain ? gain[k0 + 4 * i + (lane >> 4)] : 1.0f; s[0] = v[i][0] * gk; s[1] = v[i][1] * gk; s[2] = v[i][2] * gk; s[3] = v[i][3] * gk; } \
        asm volatile("s_waitcnt lgkmcnt(0)" ::: "memory"); \
        _Pragma("unroll") for (int j = 0; j < 8; ++j) { const int n = (lane >> 3) + 8 * j, c = lane & 7; const LAS float* s = scr + (8 * c) * 65 + n; \
            u32x4 o; o.x = pk2(s[0 * 65], s[1 * 65]); o.y = pk2(s[2 * 65], s[3 * 65]); o.z = pk2(s[4 * 65], s[5 * 65]); o.w = pk2(s[6 * 65], s[7 * 65]); \
            *(u32x4*)(WT + (size_t)(n0 + n) * ldo + k0 + 8 * c) = o; } \
        asm volatile("s_waitcnt lgkmcnt(0)" ::: "memory"); } while (0)
    int it = it0; if (it >= nit) return;
    f32x4 va[16], vb[16];
    TR_LOAD(va, it);
    for (;;) {
        int itn = it + stride; bool hn = itn < nit;
        if (hn) TR_LOAD(vb, itn);
        TR_STORE(va, it);
        if (!hn) break;
        it = itn; itn = it + stride; hn = itn < nit;
        if (hn) TR_LOAD(va, itn);
        TR_STORE(vb, it);
        if (!hn) break;
        it = itn;
    }
#undef TR_LOAD
#undef TR_STORE
}
struct WJob { const float* W; bf16* WT; int K, N; };
constexpr float LOG2E = 1.4426950408889634f;
__device__ __forceinline__ void swa_prompt_unit(const Frame& F, int b, int c, int kh, const bf16* Q, const bf16* K, const bf16* V, const float* sinks, bf16* CAT) {
    LAS bf16* Ks = (LAS bf16*)F.lds; LAS bf16* Vs = Ks + 256 * 72;
    const int lane = F.lane, kg = lane >> 4, w = F.wave;
    const int rowbase = b * SEQ + (c - 1) * 128;
#pragma unroll
    for (int i = 0; i < 4; ++i) { const int idx = F.tid + NTHR * i, r = idx >> 3, ch = idx & 7;
        u32x4 kv = (u32x4){0u, 0u, 0u, 0u}, vv = kv;
        if (c > 0 || r >= 128) { kv = *(const u32x4*)(K + (size_t)(rowbase + r) * 256 + kh * 64 + ch * 8); vv = *(const u32x4*)(V + (size_t)(rowbase + r) * 256 + kh * 64 + ch * 8); }
        *(LAS u32x4*)(Ks + r * 72 + ch * 8) = kv; *(LAS u32x4*)(Vs + r * 72 + ch * 8) = vv; }
    WG_SYNC();
    const int hq = kh * 4 + (w >> 1);
    const float sink2 = sinks[hq] * LOG2E;
    for (int mb = 0; mb < 4; ++mb) {
        const int i0 = (w & 1) * 64 + mb * 16, qrow = b * SEQ + c * 128 + i0 + (lane & 15), tb = 2 * (i0 >> 5), tq = i0 + (lane & 15);
        bf16x8 bq[2];
#pragma unroll
        for (int ks = 0; ks < 2; ++ks) bq[ks] = *(const bf16x8*)(Q + (size_t)qrow * 1024 + hq * 64 + ks * 32 + 8 * kg);
        f32x4 st[10]; float mx = -1e30f;
#pragma unroll
        for (int t = 0; t < 10; ++t) { f32x4 a = (f32x4){0.f, 0.f, 0.f, 0.f};
#pragma unroll
            for (int ks = 0; ks < 2; ++ks) a = mfma16(frag_nat(Ks, 72, (tb + t) * 16, ks * 32, lane), bq[ks], a);
#pragma unroll
            for (int r = 0; r < 4; ++r) { const int j = (tb + t) * 16 + 4 * kg + r; const bool ok = (j > tq) && (j <= tq + 128) && (c > 0 || j >= 128);
                a[r] = ok ? a[r] * (0.125f * LOG2E) : -1e30f; mx = fmaxf(mx, a[r]); }
            st[t] = a; }
        mx = fmaxf(mx, __shfl_xor(mx, 16)); mx = fmaxf(mx, __shfl_xor(mx, 32)); mx = fmaxf(mx, sink2);
        float sum = 0.f;
#pragma unroll
        for (int t = 0; t < 10; ++t)
#pragma unroll
            for (int r = 0; r < 4; ++r) { const float p = __builtin_amdgcn_exp2f(st[t][r] - mx); st[t][r] = p; sum += p; }
        sum += __shfl_xor(sum, 16); sum += __shfl_xor(sum, 32);
        const float inv = 1.0f / (sum + __builtin_amdgcn_exp2f(sink2 - mx));
        f32x4 o[4];
#pragma unroll
        for (int dt = 0; dt < 4; ++dt) o[dt] = (f32x4){0.f, 0.f, 0.f, 0.f};
#pragma unroll
        for (int s = 0; s < 5; ++s) { const bf16x8 pb = pack_p(st[2 * s], st[2 * s + 1]);
#pragma unroll
            for (int dt = 0; dt < 4; ++dt) o[dt] = mfma16(frag_tr_perm(Vs, 72, (tb + 2 * s) * 16, dt * 16, lane), pb, o[dt]); }
#pragma unroll
        for (int dt = 0; dt < 4; ++dt) { u32x2 wv; wv.x = pk2(o[dt][0] * inv, o[dt][1] * inv); wv.y = pk2(o[dt][2] * inv, o[dt][3] * inv);
            *(u32x2*)(CAT + (size_t)qrow * 2048 + hq * 64 + dt * 16 + 4 * kg) = wv; }
    }
    WG_SYNC();
}
__device__ __forceinline__ void gate_prompt_unit(const Frame& F, int b, int c, int g, const bf16* ZU, const bf16* ZV, const long long* zvstat, const float* lng, const float* lnb, const float* w_s, const float* b_s, bf16* CAT) {
    LAS bf16* Ws = (LAS bf16*)F.lds; LAS bf16* Zs = Ws + 128 * 136;
    const int lane = F.lane, kg = lane >> 4, w = F.wave;
#pragma unroll
    for (int i = 0; i < 8; ++i) { const int idx = F.tid + NTHR * i, r = idx >> 5, j4 = (idx & 31) * 4;
        f32x4 v = *(const f32x4*)(w_s + ((size_t)g * 128 + r) * 128 + j4);
#pragma unroll
        for (int e = 0; e < 4; ++e) if (j4 + e > r) v[e] = 0.f;
        u32x2 wv; wv.x = pk2(v[0], v[1]); wv.y = pk2(v[2], v[3]); *(LAS u32x2*)(Ws + r * 136 + j4) = wv; }
#pragma unroll
    for (int i = 0; i < 8; ++i) { const int idx = F.tid + NTHR * i, r = idx >> 5, ch = idx & 31, col = g * 256 + ch * 8, row = b * SEQ + c * 128 + r;
        const u32x4 raw = *(const u32x4*)(ZV + (size_t)row * 1024 + col);
        const float mean = (float)zvstat[2 * row] * (1.0f / (1024.0f * 16777216.0f)), var = (float)zvstat[2 * row + 1] * (1.0f / (1024.0f * 16777216.0f)) - mean * mean, rstd = 1.0f / sqrtf(fmaxf(var, 0.f) + EPS);
        const f32x4 g0 = *(const f32x4*)(lng + col), g1 = *(const f32x4*)(lng + col + 4), b0 = *(const f32x4*)(lnb + col), b1 = *(const f32x4*)(lnb + col + 4);
        float z[8];
#pragma unroll
        for (int e = 0; e < 4; ++e) { z[2 * e] = __uint_as_float(raw[e] << 16); z[2 * e + 1] = __uint_as_float(raw[e] & 0xffff0000u); }
        u32x4 o;
        o.x = pk2((z[0] - mean) * rstd * g0[0] + b0[0], (z[1] - mean) * rstd * g0[1] + b0[1]); o.y = pk2((z[2] - mean) * rstd * g0[2] + b0[2], (z[3] - mean) * rstd * g0[3] + b0[3]);
        o.z = pk2((z[4] - mean) * rstd * g1[0] + b1[0], (z[5] - mean) * rstd * g1[1] + b1[1]); o.w = pk2((z[6] - mean) * rstd * g1[2] + b1[2], (z[7] - mean) * rstd * g1[3] + b1[3]);
        *(LAS u32x4*)(Zs + r * 264 + ch * 8) = o; }
    WG_SYNC();
    const int i0 = 16 * w, nst = (w >> 1) + 1;
    f32x4 acc[16];
#pragma unroll
    for (int dt = 0; dt < 16; ++dt) acc[dt] = (f32x4){0.f, 0.f, 0.f, 0.f};
    for (int s = 0; s < nst; ++s) { const bf16x8 bw = frag_nat(Ws, 136, i0, 32 * s, lane);
#pragma unroll
        for (int dt = 0; dt < 16; ++dt) acc[dt] = mfma16(frag_tr(Zs, 264, 32 * s, dt * 16, lane), bw, acc[dt]); }
    const int row = b * SEQ + c * 128 + i0 + (lane & 15); const float bs = b_s[g * 128 + i0 + (lane & 15)];
#pragma unroll
    for (int dt = 0; dt < 16; ++dt) { const int col = g * 256 + dt * 16 + 4 * kg; const u32x2 zu = *(const u32x2*)(ZU + (size_t)row * 1024 + col);
        u32x2 wv; wv.x = pk2(__uint_as_float(zu.x << 16) * (acc[dt][0] + bs), __uint_as_float(zu.x & 0xffff0000u) * (acc[dt][1] + bs));
        wv.y = pk2(__uint_as_float(zu.y << 16) * (acc[dt][2] + bs), __uint_as_float(zu.y & 0xffff0000u) * (acc[dt][3] + bs));
        *(u32x2*)(CAT + (size_t)row * 2048 + 1024 + col) = wv; }
    WG_SYNC();
}
__device__ __forceinline__ void gate_sample_unit(const Frame& F, int n, const bf16* ZU, const bf16* ZV, const long long* zvstat, const float* lng, const float* lnb, const float* w_s, const float* b_s, bf16* CAT, float* ogv) {
#pragma unroll
    for (int cc = 0; cc < 2; ++cc) { const int col = F.tid + NTHR * cc, g = col >> 8; const float lg = lng[col], lb = lnb[col];
        float z[8];
#pragma unroll
        for (int j = 0; j < 8; ++j) { const int row = NP + n * 8 + j;
            const float mean = (float)zvstat[2 * row] * (1.0f / (1024.0f * 16777216.0f)), var = (float)zvstat[2 * row + 1] * (1.0f / (1024.0f * 16777216.0f)) - mean * mean, rstd = 1.0f / sqrtf(fmaxf(var, 0.f) + EPS);
            z[j] = (bf2f(ZV[(size_t)row * 1024 + col]) - mean) * rstd * lg + lb; ogv[(size_t)(n * 8 + j) * 1024 + col] = z[j]; }
#pragma unroll
        for (int i = 0; i < 8; ++i) { float mixed = b_s[g * 128 + i];
#pragma unroll
            for (int j = 0; j <= i; ++j) mixed += w_s[((size_t)g * 128 + i) * 128 + j] * z[j];
            const int row = NP + n * 8 + i; CAT[(size_t)row * 2048 + 1024 + col] = (bf16)f2bf(bf2f(ZU[(size_t)row * 1024 + col]) * mixed); } }
}
__device__ __forceinline__ void swa_sample_unit(const Frame& F, int n, int khp, const bf16* Q, const bf16* K, const bf16* V, const float* ck, const float* cv, const float* sinks, bf16* CAT, float* oks, float* ovs) {
    LAS bf16* Ks = (LAS bf16*)F.lds; LAS bf16* Vs = Ks + 2 * 144 * 72;
    const int lane = F.lane, kg = lane >> 4, w = F.wave;
#pragma unroll
    for (int i = 0; i < 8; ++i) { const int idx = F.tid + NTHR * i, j = idx >> 5, f4 = idx & 31, khl = f4 >> 4, d = (f4 & 15) * 4;
        const size_t off = (((size_t)n * 128 + j) * 4 + 2 * khp) * 64 + f4 * 4;
        const f32x4 kv = *(const f32x4*)(ck + off), vv = *(const f32x4*)(cv + off);
        u32x2 a; a.x = pk2(kv[0], kv[1]); a.y = pk2(kv[2], kv[3]); *(LAS u32x2*)(Ks + (khl * 144 + j) * 72 + d) = a;
        u32x2 c2; c2.x = pk2(vv[0], vv[1]); c2.y = pk2(vv[2], vv[3]); *(LAS u32x2*)(Vs + (khl * 160 + j) * 72 + d) = c2;
        if (j >= 8) { const size_t oo = (((size_t)n * 128 + j - 8) * 4 + 2 * khp) * 64 + f4 * 4; *(f32x4*)(oks + oo) = kv; *(f32x4*)(ovs + oo) = vv; } }
    if (F.tid < 128) { const int t = F.tid >> 4, khl = (F.tid >> 3) & 1, ch = F.tid & 7; const size_t off = (size_t)(NP + n * 8 + t) * 256 + (2 * khp + khl) * 64 + ch * 8;
        *(LAS u32x4*)(Ks + (khl * 144 + 128 + t) * 72 + ch * 8) = *(const u32x4*)(K + off); *(LAS u32x4*)(Vs + (khl * 160 + 128 + t) * 72 + ch * 8) = *(const u32x4*)(V + off); }
    else if (F.tid < 128 + 64 * 2) { const int x = F.tid - 128, khl = x >> 6, r = 136 + ((x & 63) >> 3), ch = x & 7; *(LAS u32x4*)(Ks + (khl * 144 + r) * 72 + ch * 8) = (u32x4){0u, 0u, 0u, 0u}; }
    for (int x = F.tid; x < 2 * 24 * 8; x += NTHR) { const int khl = x / 192, r = 136 + ((x % 192) >> 3), ch = x & 7; *(LAS u32x4*)(Vs + (khl * 160 + r) * 72 + ch * 8) = (u32x4){0u, 0u, 0u, 0u}; }
    WG_SYNC();
    if (w < 4) {
        const int khl = w >> 1, kh = 2 * khp + khl, t = lane & 7, head = kh * 4 + 2 * (w & 1) + ((lane & 15) >> 3), qrow = NP + n * 8 + t;
        const LAS bf16* Kh = Ks + khl * 144 * 72; const LAS bf16* Vh = Vs + khl * 160 * 72;
        const float sink2 = sinks[head] * LOG2E;
        bf16x8 bq[2];
#pragma unroll
        for (int ks = 0; ks < 2; ++ks) bq[ks] = *(const bf16x8*)(Q + (size_t)qrow * 1024 + head * 64 + ks * 32 + 8 * kg);
        f32x4 st[10]; float mx = -1e30f;
#pragma unroll
        for (int tt = 0; tt < 9; ++tt) { f32x4 a = (f32x4){0.f, 0.f, 0.f, 0.f};
#pragma unroll
            for (int ks = 0; ks < 2; ++ks) a = mfma16(frag_nat(Kh, 72, tt * 16, ks * 32, lane), bq[ks], a);
#pragma unroll
            for (int r = 0; r < 4; ++r) { const int j = tt * 16 + 4 * kg + r; const bool ok = (j > t) && (j <= t + 128);
                a[r] = ok ? a[r] * (0.125f * LOG2E) : -1e30f; mx = fmaxf(mx, a[r]); }
            st[tt] = a; }
        st[9] = (f32x4){-1e30f, -1e30f, -1e30f, -1e30f};
        mx = fmaxf(mx, __shfl_xor(mx, 16)); mx = fmaxf(mx, __shfl_xor(mx, 32)); mx = fmaxf(mx, sink2);
        float sum = 0.f;
#pragma unroll
        for (int tt = 0; tt < 10; ++tt)
#pragma unroll
            for (int r = 0; r < 4; ++r) { const float p = __builtin_amdgcn_exp2f(st[tt][r] - mx); st[tt][r] = p; sum += p; }
        sum += __shfl_xor(sum, 16); sum += __shfl_xor(sum, 32);
        const float inv = 1.0f / (sum + __builtin_amdgcn_exp2f(sink2 - mx));
        f32x4 o[4];
#pragma unroll
        for (int dt = 0; dt < 4; ++dt) o[dt] = (f32x4){0.f, 0.f, 0.f, 0.f};
#pragma unroll
        for (int s = 0; s < 5; ++s) { const bf16x8 pb = pack_p(st[2 * s], st[2 * s + 1]);
#pragma unroll
            for (int dt = 0; dt < 4; ++dt) o[dt] = mfma16(frag_tr_perm(Vh, 72, 32 * s, dt * 16, lane), pb, o[dt]); }
#pragma unroll
        for (int dt = 0; dt < 4; ++dt) { u32x2 wv; wv.x = pk2(o[dt][0] * inv, o[dt][1] * inv); wv.y = pk2(o[dt][2] * inv, o[dt][3] * inv);
            *(u32x2*)(CAT + (size_t)qrow * 2048 + head * 64 + dt * 16 + 4 * kg) = wv; }
    }
    WG_SYNC();
}

constexpr size_t QSEG = (size_t)132 * 1024 * 1024 / 2;
__device__ __forceinline__ bf16x8 ldq2(const bf16* p) {
    const u32x4 a = *(const u32x4*)p, b = *(const u32x4*)(p + QSEG); u32x4 o;
#pragma unroll
    for (int e = 0; e < 4; ++e) o[e] = pk2(__uint_as_float(a[e] << 16) + __uint_as_float(b[e] << 16), __uint_as_float(a[e] & 0xffff0000u) + __uint_as_float(b[e] & 0xffff0000u));
    return __builtin_bit_cast(bf16x8, o);
}
__device__ __forceinline__ void mem_attn_wave(const LAS bf16* Ks, const LAS bf16* Vs, const bf16* qptr  , bf16* optr, bool store, int lane) {
    const int kg = lane >> 4;
    bf16x8 bq[4];
#pragma unroll
    for (int ks = 0; ks < 4; ++ks) bq[ks] = ldq2(qptr + ks * 32 + 8 * kg);
    f32x4 st[16]; float mx = -1e30f;
#pragma unroll
    for (int t = 0; t < 16; ++t) { f32x4 a = (f32x4){0.f, 0.f, 0.f, 0.f};
#pragma unroll
        for (int ks = 0; ks < 4; ++ks) a = mfma16(frag_nat(Ks, 136, t * 16, ks * 32, lane), bq[ks], a);
#pragma unroll
        for (int r = 0; r < 4; ++r) { a[r] *= (0.08838834764831845f * LOG2E); mx = fmaxf(mx, a[r]); }
        st[t] = a; }
    mx = fmaxf(mx, __shfl_xor(mx, 16)); mx = fmaxf(mx, __shfl_xor(mx, 32));
    float sum = 0.f;
#pragma unroll
    for (int t = 0; t < 16; ++t)
#pragma unroll
        for (int r = 0; r < 4; ++r) { const float p = __builtin_amdgcn_exp2f(st[t][r] - mx); st[t][r] = p; sum += p; }
    sum += __shfl_xor(sum, 16); sum += __shfl_xor(sum, 32);
    const float inv = 1.0f / sum;
    f32x4 o[8];
#pragma unroll
    for (int dt = 0; dt < 8; ++dt) o[dt] = (f32x4){0.f, 0.f, 0.f, 0.f};
#pragma unroll
    for (int s = 0; s < 8; ++s) { const bf16x8 pb = pack_p(st[2 * s], st[2 * s + 1]);
#pragma unroll
        for (int dt = 0; dt < 8; ++dt) o[dt] = mfma16(frag_tr_perm(Vs, 136, 32 * s, dt * 16, lane), pb, o[dt]); }
    if (store) {
#pragma unroll
        for (int dt = 0; dt < 8; ++dt) { u32x2 wv; wv.x = pk2(o[dt][0] * inv, o[dt][1] * inv); wv.y = pk2(o[dt][2] * inv, o[dt][3] * inv); *(u32x2*)(optr + dt * 16 + 4 * kg) = wv; } }
}
__device__ __forceinline__ void mem_prompt_unit(const Frame& F, int b, int h, int qb, const bf16* QM, const bf16* KV, bf16* OM) {
    LAS bf16* Ks = (LAS bf16*)F.lds; LAS bf16* Vs = Ks + 256 * 136;
#pragma unroll
    for (int i = 0; i < 8; ++i) { const int idx = F.tid + NTHR * i, r = idx >> 4, ch = idx & 15; const size_t off = (size_t)(b * 256 + r) * 1024 + h * 128 + ch * 8;
        *(LAS u32x4*)(Ks + r * 136 + ch * 8) = *(const u32x4*)(KV + off); *(LAS u32x4*)(Vs + r * 136 + ch * 8) = *(const u32x4*)(KV + off + 512); }
    WG_SYNC();
    const size_t row = (size_t)b * SEQ + qb * 128 + F.wave * 16 + (F.lane & 15);
    mem_attn_wave(Ks, Vs, QM + row * 512 + h * 128, OM + row * 512 + h * 128, true, F.lane);
    WG_SYNC();
}
__device__ __forceinline__ void mem_sample_units(const Frame& F, int u0, int ustride, const bf16* QM, const float* ck, const float* cv, bf16* OM) {
    LAS bf16* Ks = (LAS bf16*)F.lds; LAS bf16* Vs = Ks + 256 * 136; LAS bf16* Pb = Vs + 256 * 136; LAS float* smax = (LAS float*)(Pb + 8 * 264); LAS float* ssum = smax + 64;
    const int lane = F.lane, kg = lane >> 4, w = F.wave, q = lane & 7;
    f32x4 kv[16], vv[16];
#define MS_LOAD(u_) do { const int n_ = (u_) >> 2, h_ = (u_) & 3; _Pragma("unroll") for (int i = 0; i < 16; ++i) { const int idx = F.tid + NTHR * i, r = idx >> 5, f4 = idx & 31; const size_t off = (((size_t)n_ * 256 + r) * 4 + h_) * 128 + f4 * 4; \
            kv[i] = __builtin_nontemporal_load((const f32x4*)(ck + off)); vv[i] = __builtin_nontemporal_load((const f32x4*)(cv + off)); } } while (0)
    if (u0 < 512) MS_LOAD(u0);
    for (int u = u0; u < 512; u += ustride) {
        const int n = u >> 2, h = u & 3;
#pragma unroll
        for (int i = 0; i < 16; ++i) { const int idx = F.tid + NTHR * i, r = idx >> 5, f4 = idx & 31;
            u32x2 a; a.x = pk2(kv[i][0], kv[i][1]); a.y = pk2(kv[i][2], kv[i][3]); *(LAS u32x2*)(Ks + r * 136 + f4 * 4) = a;
            u32x2 c2; c2.x = pk2(vv[i][0], vv[i][1]); c2.y = pk2(vv[i][2], vv[i][3]); *(LAS u32x2*)(Vs + r * 136 + f4 * 4) = c2; }
        if (u + ustride < 512) MS_LOAD(u + ustride);
        const size_t row = (size_t)NP + n * 8 + q;
        bf16x8 bq[4];
#pragma unroll
        for (int ks = 0; ks < 4; ++ks) bq[ks] = ldq2(QM + row * 512 + h * 128 + ks * 32 + 8 * kg);
        WG_SYNC();
        f32x4 st[2]; float mx = -1e30f;
#pragma unroll
        for (int t = 0; t < 2; ++t) { f32x4 a = (f32x4){0.f, 0.f, 0.f, 0.f};
#pragma unroll
            for (int ks = 0; ks < 4; ++ks) a = mfma16(frag_nat(Ks, 136, (2 * w + t) * 16, ks * 32, lane), bq[ks], a);
#pragma unroll
            for (int r = 0; r < 4; ++r) { a[r] *= (0.08838834764831845f * LOG2E); mx = fmaxf(mx, a[r]); }
            st[t] = a; }
        mx = fmaxf(mx, __shfl_xor(mx, 16)); mx = fmaxf(mx, __shfl_xor(mx, 32));
        if (lane < 8) smax[w * 8 + lane] = mx;
        WG_SYNC();
        float gm = smax[q];
#pragma unroll
        for (int ww = 1; ww < 8; ++ww) gm = fmaxf(gm, smax[ww * 8 + q]);
        float sum = 0.f;
#pragma unroll
        for (int t = 0; t < 2; ++t)
#pragma unroll
            for (int r = 0; r < 4; ++r) { const float p = __builtin_amdgcn_exp2f(st[t][r] - gm); sum += p; if ((lane & 15) < 8) Pb[q * 264 + (2 * w + t) * 16 + 4 * kg + r] = (bf16)f2bf(p); }
        sum += __shfl_xor(sum, 16); sum += __shfl_xor(sum, 32);
        if (lane < 8) ssum[w * 8 + lane] = sum;
        WG_SYNC();
        float tot = ssum[q];
#pragma unroll
        for (int ww = 1; ww < 8; ++ww) tot += ssum[ww * 8 + q];
        f32x4 o = (f32x4){0.f, 0.f, 0.f, 0.f};
#pragma unroll
        for (int s2 = 0; s2 < 8; ++s2) o = mfma16(frag_tr(Vs, 136, 32 * s2, w * 16, lane), *(const LAS bf16x8*)(Pb + q * 264 + 32 * s2 + 8 * kg), o);
        if ((lane & 15) < 8) { const float inv = 1.0f / tot; u32x2 wv; wv.x = pk2(o[0] * inv, o[1] * inv); wv.y = pk2(o[2] * inv, o[3] * inv); *(u32x2*)(OM + row * 512 + h * 128 + w * 16 + 4 * kg) = wv; }
        WG_SYNC();
    }
#undef MS_LOAD
}
constexpr int ES = 64, NE = ES / 16;
__device__ __forceinline__ float ret_lg2(int h) { return log2f(1.0f - exp2f(-5.0f - (float)h)); }
__device__ __forceinline__ void ret_prompt_scan(const Frame& F, int b, int h, int es, const bf16* ZR, bf16* OR, unsigned long long* SS, float* ostate) {
    constexpr int VST = ES + 8, NV = ES / 32;
    LAS bf16* Ks = (LAS bf16*)F.lds; LAS bf16* Vs = Ks + 128 * 264; LAS bf16* Vd = Vs + 128 * VST; LAS bf16* Ss = Vd + 128 * VST;
    const int lane = F.lane, kg = lane >> 4, w = F.wave, tid = F.tid;
    const int it = (w < 4) ? w : 11 - w;
    const float lg2 = ret_lg2(h);
    const int e0 = es * ES;
    bf16x8 qf[8]; u32x4 kpre[8], vpre[NV];
    const size_t rb = (size_t)b * SEQ;
#define RET_LOAD_KV(c_, tid) do { \
        const unsigned kl_off = (unsigned)(((tid) >> 5) * RET_IN + ((tid) & 31) * 8) * 2u; \
        const char* kb_ = (const char*)(ZR + (rb + (size_t)(c_) * 128) * RET_IN + 2048 + h * 256); \
        _Pragma("unroll") for (int i = 0; i < 8; ++i) kpre[i] = *(const u32x4*)(kb_ + (size_t)i * (16 * RET_IN * 2) + kl_off); \
        _Pragma("unroll") for (int i = 0; i < NV; ++i) { const int idx = tid + NTHR * i, r = idx / (ES / 8), ch = idx % (ES / 8); vpre[i] = *(const u32x4*)(ZR + (rb + (c_) * 128 + r) * RET_IN + 4096 + h * 512 + e0 + ch * 8); } } while (0)
#define RET_LOAD_Q(c_, lane) do { const unsigned q_off = (unsigned)((16 * it + ((lane) & 15)) * RET_IN + 8 * ((lane) >> 4)) * 2u; const char* qb_ = (const char*)(ZR + (rb + (size_t)(c_) * 128) * RET_IN + h * 256); \
        _Pragma("unroll") for (int ks = 0; ks < 8; ++ks) qf[ks] = *(const bf16x8*)(qb_ + ks * 64 + q_off); } while (0)
#define RET_STORE_KV(tid) do { \
        const unsigned kl_lds = (unsigned)(((tid) >> 5) * 264 + ((tid) & 31) * 8) * 2u; \
        _Pragma("unroll") for (int i = 0; i < 8; ++i) *(LAS u32x4*)((LAS char*)Ks + kl_lds + i * (16 * 264 * 2)) = kpre[i]; \
        _Pragma("unroll") for (int i = 0; i < NV; ++i) { const int idx = tid + NTHR * i, r = idx / (ES / 8), ch = idx % (ES / 8); *(LAS u32x4*)(Vs + r * VST + ch * 8) = vpre[i]; \
          const float dk = __builtin_amdgcn_exp2f(lg2 * (float)(127 - r)); u32x4 o; \
          _Pragma("unroll") for (int e = 0; e < 4; ++e) o[e] = pk2(__uint_as_float(vpre[i][e] << 16) * dk, __uint_as_float(vpre[i][e] & 0xffff0000u) * dk); \
          *(LAS u32x4*)(Vd + r * VST + ch * 8) = o; } } while (0)
    for (int x = tid; x < 256 * VST / 8; x += NTHR) *(LAS u32x4*)(Ss + x * 8) = (u32x4){0u, 0u, 0u, 0u};
    f32x4 sacc[2][NE];
#pragma unroll
    for (int a = 0; a < 2; ++a)
#pragma unroll
        for (int e = 0; e < NE; ++e) sacc[a][e] = (f32x4){0.f, 0.f, 0.f, 0.f};
    const float g128 = __builtin_amdgcn_exp2f(lg2 * 128.0f);
    RET_LOAD_KV(0, tid); RET_LOAD_Q(0, lane); RET_STORE_KV(tid);
    WG_SYNC();
    for (int c = 0; c < 32; ++c) {
        int ln = lane, tc = tid; asm volatile("" : "+v"(ln), "+v"(tc));
        const int kg = ln >> 4, iq = 16 * it + (ln & 15);
        const float giq = __builtin_amdgcn_exp2f(lg2 * (float)iq);
        float gkr[4];
#pragma unroll
        for (int r = 0; r < 4; ++r) gkr[r] = __builtin_amdgcn_exp2f(lg2 * (float)(-(4 * kg + r)));
        f32x4 oi[NE];
#pragma unroll
        for (int e = 0; e < NE; ++e) oi[e] = (f32x4){0.f, 0.f, 0.f, 0.f};
#pragma unroll
        for (int ks = 0; ks < 8; ++ks) { if ((ks & 1) == 0) asm volatile("" ::: "memory");
#pragma unroll
            for (int e = 0; e < NE; ++e) oi[e] = mfma16(frag_tr(Ss, VST, 32 * ks, e * 16, ln), qf[ks], oi[e]); }
        { const float qd = __builtin_amdgcn_exp2f(lg2 * (float)(iq + 1));
#pragma unroll
          for (int e = 0; e < NE; ++e) oi[e] *= qd; }
        if (c + 1 < 32) RET_LOAD_KV(c + 1, tc);
        u32x2 sgv[NE];
#pragma unroll
        for (int e = 0; e < NE; ++e) sgv[e] = *(const u32x2*)(ZR + (rb + c * 128 + iq) * RET_IN + 8192 + h * 512 + e0 + e * 16 + 4 * kg);
#pragma unroll
        for (int s = 0; s < 4; ++s) if (2 * s <= it) { asm volatile("" ::: "memory");
            f32x4 a2[2];
#pragma unroll
            for (int hh = 0; hh < 2; ++hh) { const int jt = 2 * s + hh; f32x4 a = (f32x4){0.f, 0.f, 0.f, 0.f};
                if (jt <= it) {
#pragma unroll
                    for (int ks = 0; ks < 8; ++ks) a = mfma16(frag_nat(Ks, 264, jt * 16, ks * 32, ln), qf[ks], a);
                    const float gj = giq * __builtin_amdgcn_exp2f(lg2 * (float)(-16 * jt));
#pragma unroll
                    for (int r = 0; r < 4; ++r) a[r] *= gj * gkr[r];
                    if (jt == it) {
#pragma unroll
                        for (int r = 0; r < 4; ++r) if (4 * kg + r > (ln & 15)) a[r] = 0.f; } }
                a2[hh] = a; }
            const bf16x8 pb = pack_p(a2[0], a2[1]);
#pragma unroll
            for (int e = 0; e < NE; ++e) oi[e] = mfma16(frag_tr_perm(Vs, VST, 32 * s, e * 16, ln), pb, oi[e]); }
        const size_t orow = rb + c * 128 + iq; float ssq = 0.f;
#pragma unroll
        for (int e = 0; e < NE; ++e) { const f32x4 o = oi[e]; ssq += (o[0] * o[0] + o[1] * o[1]) + (o[2] * o[2] + o[3] * o[3]);
            u32x2 wv; wv.x = pk2(o[0] * __uint_as_float(sgv[e].x << 16), o[1] * __uint_as_float(sgv[e].x & 0xffff0000u)); wv.y = pk2(o[2] * __uint_as_float(sgv[e].y << 16), o[3] * __uint_as_float(sgv[e].y & 0xffff0000u));
            *(u32x2*)(OR + orow * 4096 + h * 512 + e0 + e * 16 + 4 * kg) = wv; }
        ssq += __shfl_xor(ssq, 16); ssq += __shfl_xor(ssq, 32);
        if (kg == 0) atomicAdd(SS + orow * 8 + h, (unsigned long long)__float2ll_rn(ssq * 16777216.0f));
        WG_SYNC();
        if (c + 1 < 32) RET_LOAD_Q(c + 1, ln);
#pragma unroll
        for (int a = 0; a < 2; ++a)
#pragma unroll
            for (int e = 0; e < NE; ++e) sacc[a][e] *= g128;
#pragma unroll
        for (int s = 0; s < 4; ++s) { asm volatile("" ::: "memory");
            bf16x8 vf[NE];
#pragma unroll
            for (int e = 0; e < NE; ++e) vf[e] = frag_tr(Vd, VST, 32 * s, e * 16, ln);
#pragma unroll
            for (int a = 0; a < 2; ++a) { const bf16x8 kf = frag_tr(Ks, 264, 32 * s, (2 * w + a) * 16, ln);
#pragma unroll
                for (int e = 0; e < NE; ++e) sacc[a][e] = mfma16(kf, vf[e], sacc[a][e]); } }
#pragma unroll
        for (int a = 0; a < 2; ++a)
#pragma unroll
            for (int e = 0; e < NE; ++e)
#pragma unroll
                for (int r = 0; r < 4; ++r) Ss[((2 * w + a) * 16 + 4 * kg + r) * VST + e * 16 + (ln & 15)] = (bf16)f2bf(sacc[a][e][r]);
        WG_SYNC();
        if (c + 1 < 32) RET_STORE_KV(tc);
        WG_SYNC();
    }
#undef RET_LOAD_KV
#undef RET_LOAD_Q
#undef RET_STORE_KV
#pragma unroll
    for (int a = 0; a < 2; ++a)
#pragma unroll
        for (int e = 0; e < NE; ++e)
#pragma unroll
            for (int r = 0; r < 4; ++r) ostate[(((size_t)b * 8 + h) * 256 + (2 * w + a) * 16 + 4 * kg + r) * 512 + e0 + e * 16 + (lane & 15)] = sacc[a][e][r];
}
__device__ __forceinline__ void ret_sample_pass(const Frame& F, int unit0, const bf16* ZR, const float* state, float* ostate, bf16* OR, unsigned long long* SS) {
    const int grp = F.wave >> 2, dq = (F.wave >> 1) & 1, t = (F.wave & 1) * 64 + F.lane, t256 = dq * 128 + t, unit = unit0 + grp, n = unit >> 3, h = unit & 7;
    LAS float* qk = (LAS float*)F.lds + grp * (256 * 16 + 64 + 8 * 128 * 4); LAS float* sc = qk + 256 * 16; LAS f32x4* red = (LAS f32x4*)(sc + 64);
    const float lg2 = ret_lg2(h);
    const size_t r0 = (size_t)NP + n * 8;
#pragma unroll 4
    for (int x = t256; x < 8 * 256; x += 256) { const int i = x >> 8, d = x & 255;
        qk[d * 16 + i] = bf2f(ZR[(r0 + i) * RET_IN + h * 256 + d]);
        qk[d * 16 + 8 + i] = bf2f(ZR[(r0 + i) * RET_IN + 2048 + h * 256 + d]) * __builtin_amdgcn_exp2f(lg2 * (float)(7 - i)); }
    float v[8][4];
#pragma unroll
    for (int j = 0; j < 8; ++j) { const u32x2 raw = *(const u32x2*)(ZR + (r0 + j) * RET_IN + 4096 + h * 512 + 4 * t);
        v[j][0] = __uint_as_float(raw.x << 16); v[j][1] = __uint_as_float(raw.x & 0xffff0000u); v[j][2] = __uint_as_float(raw.y << 16); v[j][3] = __uint_as_float(raw.y & 0xffff0000u); }
    WG_SYNC();
    const float g8 = __builtin_amdgcn_exp2f(lg2 * 8.0f);
    const __amdgpu_buffer_rsrc_t rs_in = __builtin_amdgcn_make_buffer_rsrc((void*)(state + ((size_t)n * 8 + h) * 256 * 512), 0, 256 * 2048, 0x00020000);
    const __amdgpu_buffer_rsrc_t rs_out = __builtin_amdgcn_make_buffer_rsrc((void*)(ostate + ((size_t)n * 8 + h) * 256 * 512), 0, 256 * 2048, 0x00020000);
    const int loff = t * 16, dbase = dq * 128;
    f32x4 acc[8];
#pragma unroll
    for (int i = 0; i < 8; ++i) acc[i] = (f32x4){0.f, 0.f, 0.f, 0.f};
    constexpr int RB = 4;
    f32x4 bufA[RB], bufB[RB];
#define RS_LD(buf, d0_) do { _Pragma("unroll") for (int u = 0; u < RB; ++u) buf[u] = __builtin_bit_cast(f32x4, __builtin_amdgcn_raw_buffer_load_b128(rs_in, loff, (dbase + (d0_) + u) * 2048, 2)); } while (0)
#define RS_CP(buf, d0_) do { _Pragma("unroll") for (int u = 0; u < RB; ++u) { __builtin_amdgcn_sched_barrier(0); const LAS f32x4* qp = (const LAS f32x4*)(qk + (dbase + (d0_) + u) * 16); const f32x4 q0 = qp[0], q1 = qp[1], k0 = qp[2], k1 = qp[3]; \
            const f32x4 sv = buf[u]; f32x4 s1 = sv * g8; \
            _Pragma("unroll") for (int e = 0; e < 4; ++e) { \
                s1[e] += k0[0] * v[0][e] + k0[1] * v[1][e] + k0[2] * v[2][e] + k0[3] * v[3][e] + k1[0] * v[4][e] + k1[1] * v[5][e] + k1[2] * v[6][e] + k1[3] * v[7][e]; \
                acc[0][e] += q0[0] * sv[e]; acc[1][e] += q0[1] * sv[e]; acc[2][e] += q0[2] * sv[e]; acc[3][e] += q0[3] * sv[e]; \
                acc[4][e] += q1[0] * sv[e]; acc[5][e] += q1[1] * sv[e]; acc[6][e] += q1[2] * sv[e]; acc[7][e] += q1[3] * sv[e]; } \
            __builtin_amdgcn_raw_buffer_store_b128(__builtin_bit_cast(u32x4, s1), rs_out, loff, (dbase + (d0_) + u) * 2048, 2); } } while (0)
    RS_LD(bufA, 0);
#pragma unroll 1
    for (int d0 = 0; d0 < 128; d0 += 2 * RB) {
        RS_LD(bufB, d0 + RB);
        RS_CP(bufA, d0);
        if (d0 + 2 * RB < 128) RS_LD(bufA, d0 + 2 * RB);
        RS_CP(bufB, d0 + RB);
    }
#undef RS_LD
#undef RS_CP
    { int t3 = t256; asm volatile("" : "+v"(t3)); const int pr = t3 >> 2, i = pr >> 3, j = pr & 7, qd = t3 & 3; float s = 0.f;
      for (int d = qd * 64; d < qd * 64 + 64; ++d) s += qk[d * 16 + i] * qk[d * 16 + 8 + j];
      s += __shfl_xor(s, 1); s += __shfl_xor(s, 2);
      if (qd == 0) sc[i * 8 + j] = (j <= i) ? s * __builtin_amdgcn_exp2f(lg2 * (float)((i - j) - (7 - j))) : 0.f; }
    int t2 = t; asm volatile("" : "+v"(t2));
    if (dq == 1) {
#pragma unroll
        for (int i = 0; i < 8; ++i) red[i * 128 + t2] = acc[i]; }
    WG_SYNC();
    if (dq == 0) {
#pragma unroll
        for (int i = 0; i < 8; ++i) { f32x4 o = (acc[i] + red[i * 128 + t2]) * __builtin_amdgcn_exp2f(lg2 * (float)(i + 1));
#pragma unroll
            for (int j = 0; j <= i; ++j) { const float s = sc[i * 8 + j];
#pragma unroll
                for (int e = 0; e < 4; ++e) o[e] += s * v[j][e]; }
            const u32x2 sg = *(const u32x2*)(ZR + (r0 + i) * RET_IN + 8192 + h * 512 + 4 * t2);
            u32x2 wv; wv.x = pk2(o[0] * __uint_as_float(sg.x << 16), o[1] * __uint_as_float(sg.x & 0xffff0000u)); wv.y = pk2(o[2] * __uint_as_float(sg.y << 16), o[3] * __uint_as_float(sg.y & 0xffff0000u)); *(u32x2*)(OR + (r0 + i) * 4096 + h * 512 + 4 * t2) = wv;
            float ssq = (o[0] * o[0] + o[1] * o[1]) + (o[2] * o[2] + o[3] * o[3]); ssq = wave_sum(ssq);
            if ((t2 & 63) == 0) atomicAdd(SS + (r0 + i) * 8 + h, (unsigned long long)__float2ll_rn(ssq * 16777216.0f)); } }
    WG_SYNC();
}
template <int NR>
__device__ __forceinline__ void ret_norm_rows(const Frame& F, const bf16* OR, const unsigned long long* SS, bf16* YG) {
    const int gw = F.vcu * NWAVES + F.wave, NGW = F.G * NWAVES, lane = F.lane;
    for (int base = gw; base < M; base += NR * NGW) {
        u32x4 o[NR][8];
#pragma unroll
        for (int r = 0; r < NR; ++r) { const int row = base + r * NGW, rw = row < M ? row : base;
#pragma unroll
            for (int j = 0; j < 8; ++j) o[r][j] = __builtin_nontemporal_load((const u32x4*)(OR + (size_t)rw * 4096 + (lane + 64 * j) * 8)); }
#pragma unroll
        for (int r = 0; r < NR; ++r) { const int row = base + r * NGW; if (row >= M) break;
#pragma unroll
            for (int j = 0; j < 8; ++j) { const int col = (lane + 64 * j) * 8, h = col >> 9; const float rs = 1.0f / sqrtf((float)SS[(size_t)row * 8 + h] * (1.0f / (512.0f * 16777216.0f)) + EPS); u32x4 y;
#pragma unroll
                for (int e = 0; e < 4; ++e) y[e] = pk2(__uint_as_float(o[r][j][e] << 16) * rs, __uint_as_float(o[r][j][e] & 0xffff0000u) * rs);
                *(u32x4*)(YG + (size_t)row * 4096 + col) = y; } }
    }
}
constexpr size_t MiB = 1u << 20;
constexpr size_t WS_CTL = 0, CTL_ZERO_BYTES = 32 * 1024;
constexpr size_t CTL_QUEUE = 1024, CTL_TQ = 2048, CTL_ZVSTAT = 256 * 1024, CTL_SS = 512 * 1024, CTL_BAR = 8 * 1024;
constexpr size_t WS_ROPE_A = 2 * MiB, WS_ROPE_R = 3 * MiB;
constexpr size_t WS_WT = 8 * MiB;
constexpr size_t WT_ABIN = WS_WT, WT_ABOUT = WT_ABIN + 14 * MiB, WT_RETIN = WT_ABOUT + 8 * MiB, WT_RETOUT = WT_RETIN + 48 * MiB, WT_MEMQ = WT_RETOUT + 16 * MiB,
                 WT_MEMKV = WT_MEMQ + 4 * MiB, WT_MEMO = WT_MEMKV + 8 * MiB, WT_UP = WT_MEMO + 4 * MiB, WT_DOWN = WT_UP + 64 * MiB, WT_END = WT_DOWN + 64 * MiB;
constexpr size_t WS_H = 240 * MiB, WS_Y0 = 276 * MiB, WS_Y1 = 348 * MiB, WS_BIG = 420 * MiB, WS_CAT = 636 * MiB, WS_OR = 708 * MiB, WS_QM = 780 * MiB, WS_OM = 789 * MiB, WS_HM = 798 * MiB, WS_MKV = 802 * MiB, WS_XB = 804 * MiB, WS_RS = 840 * MiB, WS_WTD = 842 * MiB, WS_QM2 = 912 * MiB, WS_END = 922 * MiB;
static_assert((WS_QM2 - WS_QM) / 2 == QSEG, "q partial distance");
static_assert(WT_END <= WS_H, "weights fit");
constexpr size_t BIG_Q = 0, BIG_K = 18 * MiB, BIG_V = BIG_K + 9216 * 256 * 2, BIG_ZU = 27 * MiB, BIG_ZV = 45 * MiB;
constexpr size_t O_X = 0, O_SKP = 18874368, O_SVP = 18939904, O_SKS = 19005440, O_SVS = 23199744, O_GV = 27394048, O_RP = 28442624, O_RS = 30539776, O_MK = 164757504, O_MV = 165281792, O_END = 165806080;
constexpr int LDFF = FF + 64;
constexpr int LDS_BYTES = 147456, MISC_OFF = LDS_BYTES - 512;

#define XB_TMO      128
#define XB_XCNT(j)  (256  + 64 * (j))
#define XB_XSUB(j)  (1280 + 64 * (j))
#define XB_XGEN(j)  (2304 + 64 * (j))
#define XB_TOP      3328
#define XB_TOPGEN   3392
#define XCD_BAR_WORDS 3456
#define XB_SPIN_CAP (1u << 18)

__device__ __forceinline__ unsigned xb_ld(unsigned* p)              { return __hip_atomic_load(p, __ATOMIC_RELAXED, __HIP_MEMORY_SCOPE_AGENT); }
__device__ __forceinline__ unsigned xb_add(unsigned* p, unsigned v) { return __hip_atomic_fetch_add(p, v, __ATOMIC_RELAXED, __HIP_MEMORY_SCOPE_AGENT); }
__device__ __forceinline__ unsigned xb_xcc_id() { return (unsigned)__builtin_amdgcn_s_getreg((3 << 11) | 20) & 0xFu; }
#define XB_SPIN(cond, bar) do { unsigned _sp = 0; while (cond) { __builtin_amdgcn_s_sleep(1); \
    if ((++_sp & 255u) == 0u) { if (xb_ld(&(bar)[XB_TMO])) break; if (_sp > XB_SPIN_CAP) { atomicAdd(&(bar)[XB_TMO], 1u); break; } } } } while (0)

struct XcdBarrier {
    unsigned* bar; unsigned x;
    volatile LAS unsigned* st;
};

__device__ __forceinline__ XcdBarrier xcd_barrier_post(unsigned* bar, volatile LAS unsigned* st) {
    XcdBarrier b; b.bar = bar; b.x = xb_xcc_id(); b.st = st;
    if (threadIdx.x == 0) (void)xb_add(&bar[XB_XCNT(b.x)], 1u);
    return b;
}
__device__ __forceinline__ void xcd_barrier_complete(unsigned* bar, unsigned x, unsigned& nloc, unsigned& nx) {
    const unsigned G = gridDim.x * gridDim.y * gridDim.z;
    unsigned sum, cnt, mine, sp = 0u;
    for (;;) {
        sum = 0u; cnt = 0u; mine = 0u;
#pragma unroll
        for (unsigned j = 0; j < 16; ++j) { const unsigned c = xb_ld(&bar[XB_XCNT(j)]); sum += c; cnt += (c > 0u) ? 1u : 0u; mine = (j == x) ? c : mine; }
        if (sum == G) break;
        __builtin_amdgcn_s_sleep(1);
        if ((++sp & 255u) == 0u) { if (xb_ld(&bar[XB_TMO])) break; if (sp > XB_SPIN_CAP) { atomicAdd(&bar[XB_TMO], 1u); break; } }
    }
    nloc = mine > 0u ? mine : 1u; nx = cnt > 0u ? cnt : 1u;
}

__device__ __forceinline__ void xcd_barrier(const XcdBarrier& b) {
    asm volatile("s_waitcnt vmcnt(0)" ::: "memory");
    __syncthreads();
    if (threadIdx.x == 0) {
        unsigned* bar = b.bar;
        __builtin_amdgcn_s_waitcnt(0);
        unsigned nloc = b.st[0], nx = b.st[1];
        if (nloc == 0u) { xcd_barrier_complete(bar, b.x, nloc, nx); b.st[0] = nloc; b.st[1] = nx; }
        const unsigned old = xb_add(&bar[XB_XSUB(b.x)], 1u);
        const unsigned gen = old / nloc;
        if (old + 1u == (gen + 1u) * nloc) {
            __builtin_amdgcn_fence(__ATOMIC_RELEASE, "agent");
            asm volatile("s_waitcnt vmcnt(0)" ::: "memory");
            const unsigned og = xb_add(&bar[XB_TOP], 1u);
            const unsigned tg = og / nx;
            if (og + 1u == (tg + 1u) * nx) xb_add(&bar[XB_TOPGEN], 1u);
            else XB_SPIN(xb_ld(&bar[XB_TOPGEN]) == tg, bar);
            __builtin_amdgcn_fence(__ATOMIC_ACQUIRE, "agent");
            xb_add(&bar[XB_XGEN(b.x)], 1u);
            asm volatile("s_waitcnt vmcnt(0)" ::: "memory");
        } else {
            XB_SPIN(xb_ld(&bar[XB_XGEN(b.x)]) == gen, bar);
            __builtin_amdgcn_fence(__ATOMIC_ACQUIRE, "agent");
            asm volatile("s_waitcnt vmcnt(0)" ::: "memory");
        }
    }
    __syncthreads();
}

struct Args {
    const float *x_prompt, *x_sample, *cache_swa_k, *cache_swa_v, *state_ret, *cache_mem_k, *cache_mem_v, *mem_prompt;
    const float *norm_mix_pre, *norm_mix_post, *norm_mem, *norm_x_pre, *norm_x_post, *norm_ffn_pre, *norm_ffn_post;
    const float *w_ab_in, *w_ab_out, *swa_sinks, *gmlp_ln_g, *gmlp_ln_b, *gmlp_w_s, *gmlp_b_s, *w_ret_in, *w_ret_out, *w_mem_q, *w_mem_k, *w_mem_v, *w_mem_o, *w_ffn_up, *w_ffn_down;
    float* out; unsigned char* ws; int ph_lo, ph_hi, li, pad;
};
#ifndef PHASE_MASK
#define PHASE_MASK 0xFFFFFFFFu
#endif
#define EN(b) (((PHASE_MASK) >> (b)) & 1u)
#ifndef DUPMASK
#define DUPMASK 0u
#endif
#define REPS(b) ((((DUPMASK) >> (b)) & 1u) ? 2 : 1)
#define DUMMY(ptr_t, p_) (dup_ ? (ptr_t)(ws + WS_END + 64 * MiB) : (p_))
constexpr int N_PHASES = 25;

#define CAS __attribute__((address_space(4)))
#define KARGS ((const CAS Args*)__builtin_amdgcn_kernarg_segment_ptr())
#define ARG(f) (*(const float* const volatile CAS*)&(KARGS->f))
#define ARGI(f) (*(const int volatile CAS*)&(KARGS->f))
#define ARG_OUT() (*(float* const volatile CAS*)&(KARGS->out))
#define ARG_WS() (*(unsigned char* const volatile CAS*)&(KARGS->ws))
__global__ void __launch_bounds__(NTHR, 2) fwd(Args a_unused) {
    extern __shared__ __attribute__((aligned(16))) unsigned char lds_raw[];
    Frame F0; F0.lds = (LAS unsigned char*)lds_raw; F0.tid = threadIdx.x; F0.lane = F0.tid & 63; F0.wave = __builtin_amdgcn_readfirstlane(F0.tid >> 6);
    F0.G = gridDim.x; { const int bx = blockIdx.x; F0.vcu = (F0.G % 8 == 0) ? (bx % 8) * (F0.G / 8) + bx / 8 : bx; }
    volatile LAS unsigned* MISC = (volatile LAS unsigned*)(F0.lds + MISC_OFF);
    if (F0.tid < 128) MISC[F0.tid] = 0u;
    __syncthreads();
    const XcdBarrier bar = xcd_barrier_post((unsigned*)(ARG_WS() + WS_CTL + CTL_BAR) + ARGI(li) * XCD_BAR_WORDS, MISC + 8);
    const int lo = ARGI(ph_lo), hi = ARGI(ph_hi);
#define IN(k) (lo <= (k) && (k) < hi)
#define SEAM(k) do { if (IN(k) && IN((k) + 1)) xcd_barrier(bar); } while (0)
#define GW (F.vcu * NWAVES + F.wave)
#define NGW (F.G * NWAVES)
#define IDLE_TJOB(c0_, Wp, WTp, K_, N_, Gp, LDW) do { if ((int)blockIdx.x >= (c0_)) { const int nit_ = ((K_) / 64) * ((N_) / 64), nw_ = ((int)F.G - (c0_)) * NWAVES; const float* W_ = (Wp); bf16* WT_ = (bf16*)(WTp); \
        LAS float* scr_ = (LAS float*)(F.lds + F.wave * 16640); transpose_strided(W_, K_, N_, WT_, scr_, ((int)blockIdx.x - (c0_)) * NWAVES + F.wave, nw_, nit_, F.lane, (Gp), (LDW)); } } while (0)
#define PHASE_FRAME Frame P = F0; asm volatile("" : "+v"(P.tid), "+s"(P.wave), "+s"(P.vcu), "+s"(P.G)); P.lane = P.tid & 63

    if (EN(0) && IN(0)) { for (int rep_ = 0; rep_ < REPS(0); ++rep_) { PHASE_FRAME; const Frame& F = P; const bool dup_ = (rep_ != 0); (void)dup_; if (dup_) __syncthreads();
        unsigned char* ws = ARG_WS();
        LAS float* scr = (LAS float*)(F.lds + F.wave * 16640);
        const int gw = GW, ngw = NGW;
        { u32x4* z1 = (u32x4*)(ws + WS_CTL + CTL_ZVSTAT); u32x4* z2 = (u32x4*)(ws + WS_CTL + CTL_SS);
          for (int x = F.vcu * NTHR + F.tid; x < M * 2 * 8 / 16; x += F.G * NTHR) z1[x] = (u32x4){0u, 0u, 0u, 0u};
          for (int x = F.vcu * NTHR + F.tid; x < M * 8 * 8 / 16; x += F.G * NTHR) z2[x] = (u32x4){0u, 0u, 0u, 0u}; }
        int base = 0;
#define TJOB(Wp, WTp, K_, N_, Gp) do { const int nit = ((K_) / 64) * ((N_) / 64); int it = gw - (base % ngw); if (it < 0) it += ngw; const float* W_ = (Wp); bf16* WT_ = (bf16*)(WTp); \
            const float* G_ = (Gp); transpose_strided(W_, K_, N_, WT_, scr, it, ngw, nit, F.lane, G_, 0); base += nit; } while (0)
        TJOB(ARG(w_ab_in), ws + WT_ABIN, D, AB_IN, ARG(norm_mix_pre));
        TJOB(ARG(w_ab_out), ws + WT_ABOUT, D, D, (const float*)nullptr);
#pragma unroll 1
        for (int l = 0; l < 2; ++l) {
            TJOB(ARG(w_mem_q) + (size_t)l * D * MEMW, ws + WT_MEMQ + (size_t)l * MEMW * D * 2, D, MEMW, ARG(norm_x_pre) + (size_t)l * D);
            TJOB(ARG(w_mem_k) + (size_t)l * D * MEMW, ws + WT_MEMKV + (size_t)(2 * l) * MEMW * D * 2, D, MEMW, (const float*)nullptr);
            TJOB(ARG(w_mem_v) + (size_t)l * D * MEMW, ws + WT_MEMKV + (size_t)(2 * l + 1) * MEMW * D * 2, D, MEMW, (const float*)nullptr);
            TJOB(ARG(w_mem_o) + (size_t)l * MEMW * D, ws + WT_MEMO + (size_t)l * D * MEMW * 2, MEMW, D, (const float*)nullptr);
        }
#undef TJOB
        norm_rows<false, 4>(F, ARG(x_prompt), ARG(x_sample), nullptr, nullptr, nullptr, 0, nullptr, (float*)(ws + WS_RS), nullptr, (bf16*)(ws + WS_XB));
        { const float* memp = ARG(mem_prompt); const float* nmem = ARG(norm_mem); bf16* HM = (bf16*)(ws + WS_HM);
        for (int r2 = gw; r2 < 1024; r2 += ngw) { const int l = r2 >> 9, row = r2 & 511; const float* xr = memp + (size_t)row * D; const float* g = nmem + (size_t)l * D;
            f32x4 xv[8]; float ss = 0.f;
#pragma unroll
            for (int j = 0; j < 8; ++j) { xv[j] = ((const f32x4*)xr)[F.lane + 64 * j]; ss += (xv[j][0] * xv[j][0] + xv[j][1] * xv[j][1]) + (xv[j][2] * xv[j][2] + xv[j][3] * xv[j][3]); }
            const float rs = 1.0f / sqrtf(wave_sum(ss) * (1.0f / D) + EPS);
#pragma unroll
            for (int j = 0; j < 8; ++j) { const f32x4 gg = ((const f32x4*)g)[F.lane + 64 * j]; const f32x4 h = xv[j] * rs * gg; u32x2 w; w.x = pk2(h[0], h[1]); w.y = pk2(h[2], h[3]);
                ((u32x2*)(HM + (size_t)r2 * D))[F.lane + 64 * j] = w; } } }
    } }
    SEAM(0);

#pragma unroll 1
    for (int layer = 0; layer < 2; ++layer) {
        const int pb = 1 + 12 * layer;
        if (layer == 0) {
            if (EN(1) && IN(pb + 0)) { for (int rep_ = 0; rep_ < REPS(1); ++rep_) { PHASE_FRAME; const Frame& F = P; const bool dup_ = (rep_ != 0); (void)dup_; if (dup_) __syncthreads();
                unsigned char* ws = ARG_WS(); float* out = ARG_OUT(); bf16* BIG = (bf16*)(ws + WS_BIG);
                pg8::Gemm g{(const bf16*)(ws + WS_XB), (const bf16*)(ws + WT_ABIN), M, AB_IN, D}; pg8::StaticOrder S; S.init(M, AB_IN, D, F.G, (int)blockIdx.x);
                pg8::EpiAbIn E{BIG, out, (const float*)(ws + WS_RS), DUMMY(unsigned long long*, (unsigned long long*)(ws + WS_CTL + CTL_ZVSTAT))};
                static_assert(pg8::EpiAbIn::OK == BIG_K / 2 && pg8::EpiAbIn::OV == BIG_V / 2 && pg8::EpiAbIn::OZU == BIG_ZU / 2 && pg8::EpiAbIn::OZV == BIG_ZV / 2 && pg8::EpiAbIn::OKP == O_SKP && pg8::EpiAbIn::OVS == O_SVS, "maps");
                pg8::gemm_phase<pg8::EpiAbIn, pg8::StaticOrder, true, true>(F.lds, g, S, E);
            } }
            SEAM(pb + 0);
            if (IN(pb + 1)) {
                const bool sample_first = ((blockIdx.x >> 3) & 1) != 0;
#pragma unroll 1
                for (int step = 0; step < 2; ++step) {
                  if ((step == 0) != sample_first) {
                if (EN(2)) { for (int rep_ = 0; rep_ < REPS(2); ++rep_) { PHASE_FRAME; const Frame& F = P; const bool dup_ = (rep_ != 0); (void)dup_; if (dup_) __syncthreads();     unsigned char* ws = ARG_WS(); const bf16* BIG = (const bf16*)(ws + WS_BIG); const float* sinks = ARG(swa_sinks);
                    for (int u = F.vcu; u < 256; u += F.G) swa_prompt_unit(F, u >> 7, (u >> 2) & 31, u & 3, BIG + BIG_Q / 2, BIG + BIG_K / 2, BIG + BIG_V / 2, sinks, (bf16*)(ws + WS_CAT)); } }
                if (EN(3)) { for (int rep_ = 0; rep_ < REPS(3); ++rep_) { PHASE_FRAME; const Frame& F = P; const bool dup_ = (rep_ != 0); (void)dup_; if (dup_) __syncthreads();     unsigned char* ws = ARG_WS(); const bf16* BIG = (const bf16*)(ws + WS_BIG);
                    const float *lng = ARG(gmlp_ln_g), *lnb = ARG(gmlp_ln_b), *wsp = ARG(gmlp_w_s), *bsp = ARG(gmlp_b_s);
                    for (int u = F.vcu; u < 256; u += F.G) gate_prompt_unit(F, u >> 7, (u >> 2) & 31, u & 3, BIG + BIG_ZU / 2, BIG + BIG_ZV / 2, (const long long*)(ws + WS_CTL + CTL_ZVSTAT), lng, lnb, wsp, bsp, (bf16*)(ws + WS_CAT)); } }
                  } else {
                if (EN(4)) { for (int rep_ = 0; rep_ < REPS(4); ++rep_) { PHASE_FRAME; const Frame& F = P; const bool dup_ = (rep_ != 0); (void)dup_; if (dup_) __syncthreads();     unsigned char* ws = ARG_WS(); float* out = ARG_OUT(); const bf16* BIG = (const bf16*)(ws + WS_BIG); const float *ck = ARG(cache_swa_k), *cv = ARG(cache_swa_v), *sinks = ARG(swa_sinks);
                    for (int u = F.vcu; u < 256; u += F.G) swa_sample_unit(F, u >> 1, u & 1, BIG + BIG_Q / 2, BIG + BIG_K / 2, BIG + BIG_V / 2, ck, cv, sinks, (bf16*)(ws + WS_CAT), out + O_SKS, out + O_SVS); } }
                if (EN(5)) { for (int rep_ = 0; rep_ < REPS(5); ++rep_) { PHASE_FRAME; const Frame& F = P; const bool dup_ = (rep_ != 0); (void)dup_; if (dup_) __syncthreads();     unsigned char* ws = ARG_WS(); float* out = ARG_OUT(); const bf16* BIG = (const bf16*)(ws + WS_BIG);
                    const float *lng = ARG(gmlp_ln_g), *lnb = ARG(gmlp_ln_b), *wsp = ARG(gmlp_w_s), *bsp = ARG(gmlp_b_s);
                    for (int u = F.vcu; u < 128; u += F.G) gate_sample_unit(F, u, BIG + BIG_ZU / 2, BIG + BIG_ZV / 2, (const long long*)(ws + WS_CTL + CTL_ZVSTAT), lng, lnb, wsp, bsp, (bf16*)(ws + WS_CAT), out + O_GV); } }
                  }
                }
            }
            SEAM(pb + 1);
            if (EN(6) && IN(pb + 3)) { for (int rep_ = 0; rep_ < REPS(6); ++rep_) { PHASE_FRAME; const Frame& F = P; const bool dup_ = (rep_ != 0); (void)dup_; if (dup_) __syncthreads();
                unsigned char* ws = ARG_WS();
                pg8::Gemm g{(const bf16*)(ws + WS_CAT), (const bf16*)(ws + WT_ABOUT), M, D, D}; pg8::PanelK S; S.init(D, F.G, F.vcu);
                pg8::EpiPart E{(bf16*)(ws + WS_Y0), (bf16*)(ws + WS_Y1)};
                pg8::gemm_phase<pg8::EpiPart, pg8::PanelK, true, true>(F.lds, g, S, E);
            } }
        } else {
            if (EN(7) && IN(pb + 0)) { for (int rep_ = 0; rep_ < REPS(7); ++rep_) { PHASE_FRAME; const Frame& F = P; const bool dup_ = (rep_ != 0); (void)dup_; if (dup_) __syncthreads();
                unsigned char* ws = ARG_WS();
                pg8::Gemm g{(const bf16*)(ws + WS_XB), (const bf16*)(ws + WT_RETIN), M, RET_IN, D}; pg8::StaticOrder S; S.init(M, RET_IN, D, F.G, (int)blockIdx.x);
                pg8::EpiRetIn E{(bf16*)(ws + WS_BIG), (const float*)(ws + WS_RS)};
                pg8::gemm_phase<pg8::EpiRetIn, pg8::StaticOrder, true, true>(F.lds, g, S, E);
            } }
            SEAM(pb + 0);
            if (IN(pb + 1)) {
                const int bx = blockIdx.x; const bool halves = (F0.G % 16 == 0);
                const int role = halves ? ((bx >> 3) & 1) : 0, rank = halves ? ((bx & 7) + 8 * (bx >> 4)) : bx, nrole0 = halves ? F0.G / 2 : F0.G;
                if (EN(9) && role == 0) { for (int rep_ = 0; rep_ < REPS(9); ++rep_) { PHASE_FRAME; const Frame& F = P; const bool dup_ = (rep_ != 0); (void)dup_; if (dup_) __syncthreads();     unsigned char* ws = ARG_WS(); float* out = ARG_OUT();
                    for (int u = rank; u < 128; u += nrole0) ret_prompt_scan(F, u >> 6, (u >> 3) & 7, u & 7, (const bf16*)(ws + WS_BIG), (bf16*)(ws + WS_OR), DUMMY(unsigned long long*, (unsigned long long*)(ws + WS_CTL + CTL_SS)), out + O_RP); } }
                if (EN(8)) { for (int rep_ = 0; rep_ < REPS(8); ++rep_) { PHASE_FRAME; const Frame& F = P; const bool dup_ = (rep_ != 0); (void)dup_; if (dup_) __syncthreads();     unsigned char* ws = ARG_WS(); float* out = ARG_OUT(); const float* st = ARG(state_ret);
                    unsigned* qctr = (unsigned*)(ws + WS_CTL + CTL_QUEUE) + (dup_ ? 64 : 0); volatile LAS unsigned* qw = (volatile LAS unsigned*)(F.lds + MISC_OFF + 64);
                    for (;;) {
                        if (F.tid == 0) qw[0] = atomicAdd(qctr, 1u);
                        __syncthreads();
                        const unsigned pss = (unsigned)__builtin_amdgcn_readfirstlane((int)qw[0]);
                        __syncthreads();
                        if (pss >= 512u) break;
                        ret_sample_pass(F, (int)pss * 2, (const bf16*)(ws + WS_BIG), st, out + O_RS, (bf16*)(ws + WS_OR), DUMMY(unsigned long long*, (unsigned long long*)(ws + WS_CTL + CTL_SS))); } } }
            }
            SEAM(pb + 1);
            if (EN(10) && IN(pb + 2)) { for (int rep_ = 0; rep_ < REPS(10); ++rep_) { PHASE_FRAME; const Frame& F = P; const bool dup_ = (rep_ != 0); (void)dup_; if (dup_) __syncthreads();     unsigned char* ws = ARG_WS(); ret_norm_rows<5>(F, (const bf16*)(ws + WS_OR), (const unsigned long long*)(ws + WS_CTL + CTL_SS), (bf16*)(ws + WS_CAT)); } }
            SEAM(pb + 2);
            if (EN(11) && IN(pb + 3)) { for (int rep_ = 0; rep_ < REPS(11); ++rep_) { PHASE_FRAME; const Frame& F = P; const bool dup_ = (rep_ != 0); (void)dup_; if (dup_) __syncthreads();
                unsigned char* ws = ARG_WS();
                pg8::Gemm g{(const bf16*)(ws + WS_CAT), (const bf16*)(ws + WT_RETOUT), M, D, 4096}; pg8::PanelK S; S.init(4096, F.G, F.vcu);
                pg8::EpiPart E{(bf16*)(ws + WS_Y0), (bf16*)(ws + WS_Y1)};
                pg8::gemm_phase<pg8::EpiPart, pg8::PanelK, true, true>(F.lds, g, S, E);
            } }
        }
        SEAM(pb + 3);
        if (EN(12) && IN(pb + 4)) { for (int rep_ = 0; rep_ < REPS(12); ++rep_) { PHASE_FRAME; const Frame& F = P; const bool dup_ = (rep_ != 0); (void)dup_; if (dup_) __syncthreads();
            unsigned char* ws = ARG_WS(); float* X = ARG_OUT() + O_X;
            pg8::PanelK S; S.init(layer == 0 ? D : 4096, F.G, 0);
            bf16* XB = (bf16*)(ws + WS_XB); (void)X;
            norm_rows<true, 4>(F, nullptr, nullptr, XB, (const bf16*)(ws + WS_Y0), (const bf16*)(ws + WS_Y1), S.splits, ARG(norm_mix_post) + (size_t)layer * D, DUMMY(float*, (float*)(ws + WS_RS)), nullptr, DUMMY(bf16*, XB));
        } }
        SEAM(pb + 4);
        if (IN(pb + 5)) {
            if (EN(13)) { for (int rep_ = 0; rep_ < REPS(13); ++rep_) { PHASE_FRAME; const Frame& F = P; const bool dup_ = (rep_ != 0); (void)dup_; if (dup_) __syncthreads();     unsigned char* ws = ARG_WS();
              pg8::Gemm g{(const bf16*)(ws + WS_XB), (const bf16*)(ws + WT_MEMQ) + (size_t)layer * MEMW * D, M, MEMW, D}; pg8::SplitK2 S; S.init(D, F.G, (int)blockIdx.x);
              pg8::EpiBf16<0> E{(bf16*)(ws + WS_QM), MEMW, (const float*)(ws + WS_RS), QSEG};
              pg8::gemm_phase<pg8::EpiBf16<0>, pg8::SplitK2, true, true>(F.lds, g, S, E); } }
            if (EN(14) && layer == 0) { for (int rep_ = 0; rep_ < REPS(14); ++rep_) { PHASE_FRAME; const Frame& F = P; const bool dup_ = (rep_ != 0); (void)dup_; if (dup_) __syncthreads();     unsigned char* ws = ARG_WS(); float* out = ARG_OUT();
                pg8::Gemm g{(const bf16*)(ws + WS_HM), (const bf16*)(ws + WT_MEMKV), 1024, 2048, D}; pg8::MemKVOrder S{F.G, (int)((blockIdx.x + F.G - (144 % F.G)) % F.G)};
                pg8::EpiMemKV E{out + O_MK, out + O_MV, (bf16*)(ws + WS_MKV)};
                pg8::gemm_phase<pg8::EpiMemKV, pg8::MemKVOrder, true, true>(F.lds, g, S, E);
            } }
            if (EN(22)) { for (int rep_ = 0; rep_ < REPS(22); ++rep_) { PHASE_FRAME; const Frame& F = P; const bool dup_ = (rep_ != 0); if (dup_) __syncthreads(); unsigned char* ws = ARG_WS();
                unsigned* tq = (unsigned*)(ws + WS_CTL + CTL_TQ) + layer * 64 + (dup_ ? 128 : 0); LAS float* scr = (LAS float*)(F.lds + F.wave * 16640);
                const int n_up = (D / 64) * (FF / 64), n_dn = (layer == 0) ? n_up : 0, n_ro = (layer == 0) ? (4096 / 64) * (D / 64) : 0, n_all = n_up + n_dn + n_ro;
                const float* w_up = ARG(w_ffn_up) + (size_t)layer * D * FF; const float* w_dn = ARG(w_ffn_down) + (size_t)layer * FF * D; const float* w_ro = ARG(w_ret_out); const float* g_up = ARG(norm_ffn_pre) + (size_t)layer * D;
                volatile LAS unsigned* tqw = (volatile LAS unsigned*)(F.lds + MISC_OFF + 96);
#define TQ_RUN(qi, Wp, K_, N_, WTp, Gp, LDW, NIT) do { const int nit_ = (NIT); const float* W_ = (Wp); bf16* WT_ = (bf16*)(WTp); const float* G_ = (Gp); \
                    for (;;) { if (F.tid == 0) tqw[0] = atomicAdd(tq + (qi) * 16, 64u); __syncthreads(); const int base = __builtin_amdgcn_readfirstlane((int)tqw[0]); __syncthreads(); if (base >= nit_) break; \
                        transpose_strided(W_, K_, N_, WT_, scr, base + F.wave, 8, (base + 64 < nit_) ? base + 64 : nit_, F.lane, G_, (LDW)); } } while (0)
                TQ_RUN(0, w_up, D, FF, ws + WT_UP + (size_t)layer * FF * D * 2, g_up, 0, n_up);
                if (layer == 0) { TQ_RUN(1, w_dn, FF, D, ws + WS_WTD, (const float*)nullptr, LDFF, n_dn); TQ_RUN(2, w_ro, 4096, D, ws + WT_RETOUT, (const float*)nullptr, 0, n_ro); }
#undef TQ_RUN
                (void)n_all; } }
        }
        SEAM(pb + 5);
        if (IN(pb + 6)) {
            { const bool sample_first = ((blockIdx.x >> 3) & 1) != 0;
#pragma unroll 1
              for (int step = 0; step < 2; ++step) {
                  if ((step == 0) != sample_first) { if (EN(15)) { PHASE_FRAME; const Frame& F = P; unsigned char* ws = ARG_WS();
                      for (int u = F.vcu; u < 256; u += F.G) mem_prompt_unit(F, u >> 7, (u >> 5) & 3, u & 31, (const bf16*)(ws + WS_QM), (const bf16*)(ws + WS_MKV) + (size_t)layer * 512 * 1024, (bf16*)(ws + WS_OM)); } }
                  else { if (EN(16)) { PHASE_FRAME; const Frame& F = P; unsigned char* ws = ARG_WS(); const float* ck = ARG(cache_mem_k) + (size_t)layer * NS * 256 * 512; const float* cv = ARG(cache_mem_v) + (size_t)layer * NS * 256 * 512;
                      mem_sample_units(F, F.vcu, F.G, (const bf16*)(ws + WS_QM), ck, cv, (bf16*)(ws + WS_OM)); } } } }
        }
        SEAM(pb + 6);
        if (EN(17) && IN(pb + 7)) { for (int rep_ = 0; rep_ < REPS(17); ++rep_) { PHASE_FRAME; const Frame& F = P; const bool dup_ = (rep_ != 0); (void)dup_; if (dup_) __syncthreads();
            unsigned char* ws = ARG_WS();
            pg8::Gemm g{(const bf16*)(ws + WS_OM), (const bf16*)(ws + WT_MEMO) + (size_t)layer * D * MEMW, M, D, MEMW}; pg8::PanelK S; S.init(MEMW, F.G, F.vcu);
            pg8::EpiPart E{(bf16*)(ws + WS_Y0), (bf16*)(ws + WS_Y1)};
            pg8::gemm_phase<pg8::EpiPart, pg8::PanelK, true, true>(F.lds, g, S, E);
        } }
        SEAM(pb + 7);
        if (EN(18) && IN(pb + 8)) { for (int rep_ = 0; rep_ < REPS(18); ++rep_) { PHASE_FRAME; const Frame& F = P; const bool dup_ = (rep_ != 0); (void)dup_; if (dup_) __syncthreads();     unsigned char* ws = ARG_WS(); float* X = ARG_OUT() + O_X;
            bf16* XB = (bf16*)(ws + WS_XB); (void)X;
            norm_rows<true, 4>(F, nullptr, nullptr, XB, (const bf16*)(ws + WS_Y0), (const bf16*)(ws + WS_Y1), 4, ARG(norm_x_post) + (size_t)layer * D, DUMMY(float*, (float*)(ws + WS_RS)), nullptr, DUMMY(bf16*, XB)); } }
        SEAM(pb + 8);
        if (EN(19) && IN(pb + 9)) { for (int rep_ = 0; rep_ < REPS(19); ++rep_) { PHASE_FRAME; const Frame& F = P; const bool dup_ = (rep_ != 0); (void)dup_; if (dup_) __syncthreads();
            unsigned char* ws = ARG_WS();
            pg8::Gemm g{(const bf16*)(ws + WS_XB), (const bf16*)(ws + WT_UP) + (size_t)layer * FF * D, M, FF, D}; pg8::StaticOrder S; S.init(M, FF, D, F.G, (int)blockIdx.x);
            pg8::EpiBf16<2> E{(bf16*)(ws + WS_BIG), LDFF, (const float*)(ws + WS_RS)};
            pg8::gemm_phase<pg8::EpiBf16<2>, pg8::StaticOrder, true, true>(F.lds, g, S, E);
            { const int c0 = (F.G > 128) ? 128 : 0;
              if (layer == 0) IDLE_TJOB(c0, ARG(w_ret_in), ws + WT_RETIN, D, RET_IN, ARG(norm_mix_pre) + D, 0);
              else IDLE_TJOB(c0, ARG(w_ffn_down) + (size_t)FF * D, ws + WS_WTD + (size_t)D * LDFF * 2, FF, D, (const float*)nullptr, LDFF); }
        } }
        SEAM(pb + 9);
        if (EN(20) && IN(pb + 10)) { for (int rep_ = 0; rep_ < REPS(20); ++rep_) { PHASE_FRAME; const Frame& F = P; const bool dup_ = (rep_ != 0); (void)dup_; if (dup_) __syncthreads();
            unsigned char* ws = ARG_WS();
            pg8::Gemm g{(const bf16*)(ws + WS_BIG), (const bf16*)(ws + WS_WTD) + (size_t)layer * D * LDFF, M, D, FF, LDFF, LDFF}; pg8::PanelK S; S.init(FF, F.G, F.vcu);
            pg8::EpiPart E{(bf16*)(ws + WS_Y0), (bf16*)(ws + WS_Y1)};
            pg8::gemm_phase<pg8::EpiPart, pg8::PanelK, true, true>(F.lds, g, S, E);
        } }
        SEAM(pb + 10);
        if (EN(21) && IN(pb + 11)) { for (int rep_ = 0; rep_ < REPS(21); ++rep_) { PHASE_FRAME; const Frame& F = P; const bool dup_ = (rep_ != 0); (void)dup_; if (dup_) __syncthreads();     unsigned char* ws = ARG_WS(); float* X = ARG_OUT() + O_X;
            pg8::PanelK S; S.init(FF, F.G, 0);
            bf16* XB = (bf16*)(ws + WS_XB);
            norm_rows<true, 4>(F, nullptr, nullptr, XB, (const bf16*)(ws + WS_Y0), (const bf16*)(ws + WS_Y1), S.splits, ARG(norm_ffn_post) + (size_t)layer * D, layer == 0 ? DUMMY(float*, (float*)(ws + WS_RS)) : (float*)nullptr,
                            layer == 0 ? (float*)nullptr : DUMMY(float*, X), layer == 0 ? DUMMY(bf16*, XB) : (bf16*)nullptr); } }
        if (layer == 0) SEAM(pb + 11);
    }
#undef IN
#undef SEAM
}

#ifndef MK_N_LAUNCHES
#define MK_N_LAUNCHES 1
#endif
extern "C" void kernel_launch(void* const* d_in, const int* in_sizes, int n_in, void* d_out, int out_size, void* d_ws, size_t ws_size, hipStream_t stream) {
    static int grid = 0;
    if (grid == 0) {
        if (n_in != 30 || out_size != (int)O_END || ws_size < WS_END) { fprintf(stderr, "kernel_launch: unexpected shapes (n_in %d, out %d, ws %zu)\n", n_in, out_size, ws_size); grid = -1; return; }
        int dev = 0, cus = 0, per_cu = 0;
        if (hipGetDevice(&dev) != hipSuccess || hipDeviceGetAttribute(&cus, hipDeviceAttributeMultiprocessorCount, dev) != hipSuccess) { grid = -1; return; }
        if (hipFuncSetAttribute((const void*)fwd, hipFuncAttributeMaxDynamicSharedMemorySize, LDS_BYTES) != hipSuccess) { fprintf(stderr, "kernel_launch: hipFuncSetAttribute failed\n"); grid = -1; return; }
        if (hipOccupancyMaxActiveBlocksPerMultiprocessor(&per_cu, (const void*)fwd, NTHR, LDS_BYTES) != hipSuccess || per_cu < 1) fprintf(stderr, "kernel_launch: occupancy query says %d\n", per_cu);
        (void)hipGetLastError();
        grid = cus;
    }
    if (grid < 0) return;
    (void)hipMemsetAsync((char*)d_ws + WS_CTL, 0, CTL_ZERO_BYTES, stream);
    Args a{};
    const float** p = (const float**)&a;
    for (int i = 0; i < 30; ++i) p[i] = (const float*)d_in[i];
    a.out = (float*)d_out; a.ws = (unsigned char*)d_ws; a.pad = 0;
    for (int li = 0; li < MK_N_LAUNCHES; ++li) {
        a.ph_lo = (MK_N_LAUNCHES == 1) ? 0 : li; a.ph_hi = (MK_N_LAUNCHES == 1) ? N_PHASES : li + 1; a.li = li;
        hipLaunchKernelGGL(fwd, dim3(grid), dim3(NTHR), LDS_BYTES, stream, a);
    }
}
```

```cpp
#include <hip/hip_runtime.h>
#include <cstdio>
#include <cstdint>

namespace pg8 {
#define PG8_LAS __attribute__((address_space(3)))
typedef unsigned short bf16_t;
typedef short bf16x8 __attribute__((ext_vector_type(8)));
typedef float f32x4 __attribute__((ext_vector_type(4)));
typedef unsigned u32x4 __attribute__((ext_vector_type(4)));
typedef unsigned u32x2 __attribute__((ext_vector_type(2)));
constexpr int BM = 256, BK = 64, HALF = 128, HTB = HALF * BK * 2  , STAGE_BYTES = 8 * HTB, NXCD = 8, WGM = 8;

__host__ __device__ __forceinline__ int lds_byte(int r, int c) { const int st = (r >> 4) * 2 + (c >> 5), rr = r & 15, cc = c & 31, ob = rr * 64 + cc * 2; return st * 1024 + (ob ^ (((ob >> 9) & 1) << 5)); }
__host__ __device__ __forceinline__ void stage_rc(int b, int& R, int& C) { const int st = b / 1024, sb = b % 1024, swz = sb ^ (((sb >> 9) & 1) << 5); R = (st >> 1) * 16 + swz / 64; C = (st & 1) * 32 + (swz % 64) / 2; }
__host__ __device__ __forceinline__ int perm32(int rho) { const int n = rho >> 4, i = rho & 15; return 8 * (i >> 2) + 4 * n + (i & 3); }

struct Unit { int pm, pn, kt0, nkt; };
struct Gemm { const bf16_t* A; const bf16_t* Bt; int M, N, K; int lda = 0, ldb = 0; };

struct StaticOrder {
    int nM, nN, nwg, G, c, nkt;
    __device__ void init(int M, int N, int K, int G_, int c_) { nM = M / BM; nN = N / BM; nwg = nM * nN; G = G_; c = c_; nkt = K / BK; }
    __device__ bool next(int i, Unit& u) const {
        const int L = i * G + c; if (L >= nwg) return false;
        int wgid = L; { const int q = nwg >> 3, r = nwg & 7, xcd = wgid & 7, off = wgid >> 3; wgid = (xcd < r ? xcd * (q + 1) : r * (q + 1) + (xcd - r) * q) + off; }
        const int nig = WGM * nN, gid = wgid / nig, rem = wgid - gid * nig, fm = gid * WGM; const bool full = (nM - fm) >= WGM;
        u.pm = fm + (full ? (rem & 7) : (rem & 3)); u.pn = full ? (rem >> 3) : (rem >> 2); u.kt0 = 0; u.nkt = nkt; return true;
    }
};
struct StreamK {
    int dpu, nN, w; long S, total;
    __device__ void init(int M, int N, int K, int G_, int w_) { dpu = K / (2 * BK); nN = N / BM; total = (long)(M / BM) * nN * dpu; S = (total + G_ - 1) / G_; w = w_; }
    __device__ bool next(int i, Unit& u) const {
        long pos = (long)w * S; long end = pos + S; if (end > total) end = total;
        for (int k = 0;; ++k) {
            if (pos >= end) return false;
            const int un = (int)(pos / dpu), off = (int)(pos % dpu); long len = dpu - off; if (len > end - pos) len = end - pos;
            if (k == i) { u.pm = un / nN; u.pn = un % nN; u.kt0 = 2 * off; u.nkt = 2 * (int)len; return true; }
            pos += len;
        }
    }
    __device__ static bool split(int pm, int pn, int nN_, int dpu_, long S_) { const long a = (long)(pm * nN_ + pn) * dpu_; return (a / S_) != ((a + dpu_ - 1) / S_); }
};

struct SplitK2 {
    int G, c, nkt;
    __device__ void init(int K, int G_, int c_) { G = G_; c = c_; nkt = K / BK; }
    __device__ bool next(int i, Unit& u) const { const int idx = i * G + c; if (idx >= 144) return false; const int un = idx >> 1; u.pm = un >> 1; u.pn = un & 1; u.kt0 = (idx & 1) * (nkt >> 1); u.nkt = nkt >> 1; return true; }
};
struct PanelK {
    int w, G, nkt, ls;
    int splits;
    __device__ void init(int K, int G_, int w_) { w = w_; G = G_; nkt = K / BK; ls = (nkt >= 16) ? 3 : 2; splits = 1 << ls; }
    __device__ bool next(int i, Unit& u) const {
        int np = 0; for (int x = w; x < 256; x += G) ++np;
        if (i < np) { const int un = w + i * G; u.pm = un >> 3; u.pn = un & 7; u.kt0 = 0; u.nkt = nkt; return true; }
        const int idx = w + (i - np) * G; if (idx >= (32 << ls)) return false;
        const int ns = nkt >> ls, seg = (idx >> 3) & (splits - 1);
        u.pm = 32 + (idx >> (3 + ls)); u.pn = idx & 7; u.kt0 = seg * ns; u.nkt = ns; return true;
    }
};

__device__ __forceinline__ unsigned cvt_pk_bf16(float lo, float hi) { unsigned r; asm volatile("v_cvt_pk_bf16_f32 %0, %1, %2" : "=v"(r) : "v"(lo), "v"(hi)); return r; }

constexpr int MROWS = 9216, NPROMPT = 8192, SEQ = 4096;
__device__ __forceinline__ float pos_of_row(int row) { return (float)(row < NPROMPT ? (row & (SEQ - 1)) : 8192 + ((row - NPROMPT) & 7)); }
__device__ __forceinline__ float rope_inv_turns(int i, float inv_half_log2theta) { return __builtin_amdgcn_exp2f(-(float)i * inv_half_log2theta) * 0.15915494309189535f; }
__device__ __forceinline__ void sincos_turns(float t, float& sn, float& cs) { const float f = __builtin_amdgcn_fractf(t); sn = __builtin_amdgcn_sinf(f); cs = __builtin_amdgcn_cosf(f); }
__device__ __forceinline__ float gelu_tanh(float x) {
    const float u = 0.7978845608028654f * (x + 0.044715f * x * x * x);
    return x * __builtin_amdgcn_rcpf(1.0f + __builtin_amdgcn_exp2f(-2.885390081777927f * u));
}
__device__ __forceinline__ float silu_f(float x) { return x * __builtin_amdgcn_rcpf(1.0f + __builtin_amdgcn_exp2f(-1.4426950408889634f * x)); }
__device__ __forceinline__ u32x4 pack8(const f32x4& a, const f32x4& b) { u32x4 w; w.x = cvt_pk_bf16(a[0], a[1]); w.y = cvt_pk_bf16(a[2], a[3]); w.z = cvt_pk_bf16(b[0], b[1]); w.w = cvt_pk_bf16(b[2], b[3]); return w; }

struct EpiPart {
    static constexpr bool PERM = true, AFTER_DRAIN = false;
    bf16_t* Y; bf16_t* P;
    __device__ __forceinline__ void operator()(const f32x4 (&acc)[2][2][4][2], const Unit& u, int wr, int wc, int fr, int fq) const {
        bf16_t* base = (u.pm < 32) ? Y + (size_t)u.pm * BM * 2048 : P + ((size_t)(u.kt0 >> __builtin_ctz(u.nkt)) * 1024 + (size_t)(u.pm - 32) * BM) * 2048;
        const int col0 = u.pn * BM + wc * 32 + 8 * fq;
#pragma unroll
        for (int ai = 0; ai < 2; ++ai)
#pragma unroll
            for (int m = 0; m < 4; ++m) { bf16_t* rowp = base + (size_t)(ai * HALF + wr * 64 + m * 16 + fr) * 2048 + col0;
#pragma unroll
                for (int bj = 0; bj < 2; ++bj) *(u32x4*)(rowp + bj * HALF) = pack8(acc[ai][bj][m][0], acc[ai][bj][m][1]);
                asm volatile("" ::: "memory"); }
    }
};
template <int ACT> struct EpiBf16 {
    static constexpr bool PERM = true, AFTER_DRAIN = false;
    bf16_t* O; int ldc; const float* rs;
    size_t seg_stride = 0;
    __device__ __forceinline__ void operator()(const f32x4 (&acc)[2][2][4][2], const Unit& u, int wr, int wc, int fr, int fq) const {
        const int col0 = u.pn * BM + wc * 32 + 8 * fq;
        float rsv[2][4];
#pragma unroll
        for (int ai = 0; ai < 2; ++ai)
#pragma unroll
            for (int m = 0; m < 4; ++m) rsv[ai][m] = rs[u.pm * BM + ai * HALF + wr * 64 + m * 16 + fr];
#pragma unroll
        for (int ai = 0; ai < 2; ++ai)
#pragma unroll
            for (int m = 0; m < 4; ++m) { const int row = u.pm * BM + ai * HALF + wr * 64 + m * 16 + fr; const float scale = rsv[ai][m]; bf16_t* rowp = O + (u.kt0 ? seg_stride : 0) + (size_t)row * ldc + col0;
#pragma unroll
                for (int bj = 0; bj < 2; ++bj) { f32x4 v0 = acc[ai][bj][m][0], v1 = acc[ai][bj][m][1];
                    if (ACT == 2) {
#pragma unroll
                        for (int e = 0; e < 4; ++e) { const float a = fmaxf(v0[e] * scale, 0.f), b = fmaxf(v1[e] * scale, 0.f); v0[e] = a * a; v1[e] = b * b; } }
                    else { v0 = v0 * scale; v1 = v1 * scale; }
                    *(u32x4*)(rowp + bj * HALF) = pack8(v0, v1); }
                asm volatile("" ::: "memory"); }
    }
};
struct EpiAbIn {
    static constexpr bool PERM = true, AFTER_DRAIN = false;
    bf16_t* big; float* out;
    const float* rs;
    unsigned long long* zvstat;
    static constexpr size_t OQ = 0, OK = 9437184, OV = OK + 2359296, OZU = 14155776, OZV = 23592960;
    static constexpr size_t OKP = 18874368, OVP = 18939904, OKS = 19005440, OVS = 23199744;
    __device__ __forceinline__ void operator()(const f32x4 (&acc)[2][2][4][2], const Unit& u, int wr, int wc, int fr, int fq) const {
        const int pn = u.pn;
        bf16_t* const Q = big + OQ; bf16_t* const K = big + OK; bf16_t* const V = big + OV; bf16_t* const ZU = big + OZU; bf16_t* const ZV = big + OZV;
        float* const okp = out + OKP; float* const ovp = out + OVP; float* const oks = out + OKS; float* const ovs = out + OVS;
        float rsv[2][4];
#pragma unroll
        for (int ai = 0; ai < 2; ++ai)
#pragma unroll
            for (int m = 0; m < 4; ++m) rsv[ai][m] = rs[u.pm * BM + ai * HALF + wr * 64 + m * 16 + fr];
#pragma unroll
        for (int ai = 0; ai < 2; ++ai)
#pragma unroll
            for (int m = 0; m < 4; ++m) {
                const int row = u.pm * BM + ai * HALF + wr * 64 + m * 16 + fr; const float rsc = rsv[ai][m];
                if (pn < 5) {
                    const float pos = pos_of_row(row);
#pragma unroll
                    for (int bj = 0; bj < 2; ++bj) { f32x4 v0 = acc[ai][bj][m][0] * rsc, v1 = acc[ai][bj][m][1] * rsc;
                        if ((wc & 1) == 0) {
                            const float sg = (fq == 0) ? -1.f : 1.f;
#pragma unroll
                            for (int e = 0; e < 4; ++e) { const float p0 = __shfl_xor(v0[e], 16), p1 = __shfl_xor(v1[e], 16); float sn, cs;
                                sincos_turns(pos * rope_inv_turns(e, 2.3664460f), sn, cs); const float r0 = v0[e] * cs + sg * p0 * sn;
                                sincos_turns(pos * rope_inv_turns(4 + e, 2.3664460f), sn, cs); const float r1 = v1[e] * cs + sg * p1 * sn;
                                if (fq < 2) { v0[e] = r0; v1[e] = r1; } }
                        }
                        const int c = bj * HALF + wc * 32 + 8 * fq;
                        if (pn < 4) *(u32x4*)(Q + (size_t)row * 1024 + pn * BM + c) = pack8(v0, v1);
                        else { *(u32x4*)(K + (size_t)row * 256 + c) = pack8(v0, v1);
                            float* o = nullptr;
                            if (row < NPROMPT) { const int s = row & (SEQ - 1); if (s >= SEQ - 128) o = okp + ((size_t)(row >> 12) * 128 + (s - (SEQ - 128))) * 256 + c; }
                            else { const int r = row - NPROMPT; o = oks + ((size_t)(r >> 3) * 128 + 120 + (r & 7)) * 256 + c; }
                            if (o) { *(f32x4*)o = v0; *(f32x4*)(o + 4) = v1; } }
                    }
                } else if (pn == 5) {
#pragma unroll
                    for (int bj = 0; bj < 2; ++bj) { const f32x4 v0 = acc[ai][bj][m][0] * rsc, v1 = acc[ai][bj][m][1] * rsc; const int c = bj * HALF + wc * 32 + 8 * fq;
                        *(u32x4*)(V + (size_t)row * 256 + c) = pack8(v0, v1);
                        float* o = nullptr;
                        if (row < NPROMPT) { const int s = row & (SEQ - 1); if (s >= SEQ - 128) o = ovp + ((size_t)(row >> 12) * 128 + (s - (SEQ - 128))) * 256 + c; }
                        else { const int r = row - NPROMPT; o = ovs + ((size_t)(r >> 3) * 128 + 120 + (r & 7)) * 256 + c; }
                        if (o) { *(f32x4*)o = v0; *(f32x4*)(o + 4) = v1; } }
                } else {
                    float s1 = 0.f, s2 = 0.f;
#pragma unroll
                    for (int bj = 0; bj < 2; ++bj) { f32x4 v0 = acc[ai][bj][m][0] * rsc, v1 = acc[ai][bj][m][1] * rsc;
#pragma unroll
                        for (int e = 0; e < 4; ++e) { v0[e] = gelu_tanh(v0[e]); v1[e] = gelu_tanh(v1[e]); s1 += v0[e] + v1[e]; s2 += v0[e] * v0[e] + v1[e] * v1[e]; }
                        const int c = bj * HALF + wc * 32 + 8 * fq;
                        if (pn < 10) *(u32x4*)(ZU + (size_t)row * 1024 + (pn - 6) * BM + c) = pack8(v0, v1);
                        else *(u32x4*)(ZV + (size_t)row * 1024 + (pn - 10) * BM + c) = pack8(v0, v1); }
                    if (pn >= 10) { s1 += __shfl_xor(s1, 16); s1 += __shfl_xor(s1, 32); s2 += __shfl_xor(s2, 16); s2 += __shfl_xor(s2, 32);
                        if (fq == 0) { atomicAdd(zvstat + 2 * row, (unsigned long long)(long long)__float2ll_rn(s1 * 16777216.0f)); atomicAdd(zvstat + 2 * row + 1, (unsigned long long)(long long)__float2ll_rn(s2 * 16777216.0f)); } }
                }
                asm volatile("" ::: "memory");
            }
    }
};
struct EpiRetIn {
    static constexpr bool PERM = true, AFTER_DRAIN = false;
    bf16_t* Z; const float* rs;
    __device__ __forceinline__ void operator()(const f32x4 (&acc)[2][2][4][2], const Unit& u, int wr, int wc, int fr, int fq) const {
        const int pn = u.pn;
        float rsv[2][4];
#pragma unroll
        for (int ai = 0; ai < 2; ++ai)
#pragma unroll
            for (int m = 0; m < 4; ++m) rsv[ai][m] = rs[u.pm * BM + ai * HALF + wr * 64 + m * 16 + fr];
#pragma unroll
        for (int ai = 0; ai < 2; ++ai)
#pragma unroll
            for (int m = 0; m < 4; ++m) {
                const int row = u.pm * BM + ai * HALF + wr * 64 + m * 16 + fr;
                bf16_t* rowp = Z + (size_t)row * 12288 + pn * BM + wc * 32 + 8 * fq;
                if (pn < 16) {
                    const float pos = pos_of_row(row); const int ib = wc * 32 + 8 * fq;
                    f32x4 cs[4];
#pragma unroll
                    for (int t = 0; t < 4; ++t) { float s0, c0, s1, c1; sincos_turns(pos * rope_inv_turns(ib + 2 * t, 0.10381025f), s0, c0); sincos_turns(pos * rope_inv_turns(ib + 2 * t + 1, 0.10381025f), s1, c1); cs[t] = (f32x4){c0, s0, c1, s1}; }
                    const float sc = ((pn >= 8) ? 0.0625f : 1.0f) * rsv[ai][m];
                    f32x4 a0 = acc[ai][0][m][0], a1 = acc[ai][0][m][1], b0 = acc[ai][1][m][0], b1 = acc[ai][1][m][1], r0, r1, q0, q1;
                    r0[0] = a0[0] * cs[0][0] - b0[0] * cs[0][1]; q0[0] = b0[0] * cs[0][0] + a0[0] * cs[0][1];
                    r0[1] = a0[1] * cs[0][2] - b0[1] * cs[0][3]; q0[1] = b0[1] * cs[0][2] + a0[1] * cs[0][3];
                    r0[2] = a0[2] * cs[1][0] - b0[2] * cs[1][1]; q0[2] = b0[2] * cs[1][0] + a0[2] * cs[1][1];
                    r0[3] = a0[3] * cs[1][2] - b0[3] * cs[1][3]; q0[3] = b0[3] * cs[1][2] + a0[3] * cs[1][3];
                    r1[0] = a1[0] * cs[2][0] - b1[0] * cs[2][1]; q1[0] = b1[0] * cs[2][0] + a1[0] * cs[2][1];
                    r1[1] = a1[1] * cs[2][2] - b1[1] * cs[2][3]; q1[1] = b1[1] * cs[2][2] + a1[1] * cs[2][3];
                    r1[2] = a1[2] * cs[3][0] - b1[2] * cs[3][1]; q1[2] = b1[2] * cs[3][0] + a1[2] * cs[3][1];
                    r1[3] = a1[3] * cs[3][2] - b1[3] * cs[3][3]; q1[3] = b1[3] * cs[3][2] + a1[3] * cs[3][3];
                    *(u32x4*)(rowp) = pack8(r0 * sc, r1 * sc); *(u32x4*)(rowp + HALF) = pack8(q0 * sc, q1 * sc);
                } else {
                    const float rsc = rsv[ai][m];
#pragma unroll
                    for (int bj = 0; bj < 2; ++bj) { f32x4 v0 = acc[ai][bj][m][0] * rsc, v1 = acc[ai][bj][m][1] * rsc;
                        if (pn >= 32) {
#pragma unroll
                            for (int e = 0; e < 4; ++e) { v0[e] = silu_f(v0[e]); v1[e] = silu_f(v1[e]); } }
                        *(u32x4*)(rowp + bj * HALF) = pack8(v0, v1); }
                }
                asm volatile("" ::: "memory");
            }
    }
};
struct MemKVOrder {
    int G, c;
    __device__ bool next(int i, Unit& u) const { const int idx = i * G + c; if (idx >= 16) return false; u.pm = idx >> 2; u.pn = (u.pm >> 1) * 4 + (idx & 3); u.kt0 = 0; u.nkt = 32; return true; }
};
struct EpiMemKV {
    static constexpr bool PERM = false, AFTER_DRAIN = false;
    float* ok; float* ov; bf16_t* KV;
    __device__ __forceinline__ void operator()(const f32x4 (&acc)[2][2][4][2], const Unit& u, int wr, int wc, int fr, int fq) const {
        const int layer = u.pm >> 1, pn = u.pn & 3;
        const int col0 = pn * BM + wc * 32 + 4 * fq;
        float* o = ((pn < 2) ? ok : ov) + (size_t)layer * 512 * 512; const int cb = (pn < 2) ? col0 : col0 - 512;
        bf16_t* kv = KV + (size_t)layer * 512 * 1024;
#pragma unroll
        for (int ai = 0; ai < 2; ++ai)
#pragma unroll
            for (int m = 0; m < 4; ++m) { const int row = (u.pm & 1) * BM + ai * HALF + wr * 64 + m * 16 + fr;
#pragma unroll
                for (int bj = 0; bj < 2; ++bj)
#pragma unroll
                    for (int n = 0; n < 2; ++n) { const f32x4 v = acc[ai][bj][m][n]; const int c = bj * HALF + n * 16;
                        *(f32x4*)(o + (size_t)row * 512 + cb + c) = v;
                        u32x2 w; w.x = cvt_pk_bf16(v[0], v[1]); w.y = cvt_pk_bf16(v[2], v[3]); *(u32x2*)(kv + (size_t)row * 1024 + col0 + c) = w; }
                asm volatile("" ::: "memory"); }
    }
};

template <class Epi, class Sched, bool ALIGN_EPI = false, bool SP2 = false>
__device__ __forceinline__ void gemm_phase(PG8_LAS unsigned char* lds, const Gemm g, const Sched& S, const Epi& E) {
    int tid_ = threadIdx.x; asm volatile("" : "+v"(tid_));
    const int tid = tid_, wid = __builtin_amdgcn_readfirstlane(tid >> 6), lane = tid & 63, wr = wid >> 2, wc = wid & 3, fr = lane & 15, fq = lane >> 4;
    const int K = g.K, lda = g.lda ? g.lda : K, ldb = g.ldb ? g.ldb : K; int nt; (void)K;
    unsigned voffA[2], voffB[2];
#pragma unroll
    for (int i = 0; i < 2; ++i) { int R, C; stage_rc(tid * 16 + i * 8192, R, C); const int Rb = Epi::PERM ? ((R & ~31) + perm32(R & 31)) : R;
        voffA[i] = (unsigned)(R * lda + C) * 2u; voffB[i] = (unsigned)(Rb * ldb + C) * 2u; }
    const size_t kstep = (size_t)(BK * 2);
    const size_t hstepA = (size_t)HALF * lda * 2, hstepB = (size_t)HALF * ldb * 2;
    const size_t tstepA = 2 * hstepA, tstepB = 2 * hstepB;
    const unsigned ldsw = (unsigned)wid * 1024u;
    const int aoff = lds_byte(wr * 64 + fr, fq * 8), boff = lds_byte(wc * 32 + fr, fq * 8);
#define PG8_SA(b, h) (((b) * 2 + (h)) * HTB)
#define PG8_SB(b, h) ((4 + (b) * 2 + (h)) * HTB)
#define PG8_STAGE(bufoff, gbase, voff) do { _Pragma("unroll") for (int _i = 0; _i < 2; ++_i) \
        __builtin_amdgcn_global_load_lds((const unsigned*)((const char*)(gbase) + (voff)[_i]), (PG8_LAS unsigned*)(lds + (bufoff) + ldsw + _i * 8192), 16, 0, 0); } while (0)
#define PG8_LDA(dst, b, h) do { _Pragma("unroll") for (int m = 0; m < 4; ++m) _Pragma("unroll") for (int k = 0; k < 2; ++k) dst[m][k] = *(const PG8_LAS bf16x8*)(lds + PG8_SA(b, h) + aoff + m * 2048 + k * 1024); } while (0)
#define PG8_LDB(dst, b, h) do { _Pragma("unroll") for (int n = 0; n < 2; ++n) _Pragma("unroll") for (int k = 0; k < 2; ++k) dst[n][k] = *(const PG8_LAS bf16x8*)(lds + PG8_SB(b, h) + boff + n * 2048 + k * 1024); } while (0)
#define PG8_MMA(ai, bj, At, Bt) do { __builtin_amdgcn_s_setprio(1); _Pragma("unroll") for (int m = 0; m < 4; ++m) _Pragma("unroll") for (int n = 0; n < 2; ++n) _Pragma("unroll") for (int k = 0; k < 2; ++k) \
        acc[ai][bj][m][n] = __builtin_amdgcn_mfma_f32_16x16x32_bf16(Bt[n][k], At[m][k], acc[ai][bj][m][n], 0, 0, 0); __builtin_amdgcn_s_setprio(0); } while (0)
#define PG8_WAIT_V(n) asm volatile("s_waitcnt vmcnt(" #n ")" ::: "memory")
#define PG8_WAIT_L(n) asm volatile("s_waitcnt lgkmcnt(" #n ")" ::: "memory")
#define PG8_BAR __builtin_amdgcn_s_barrier()
#define PG8_SCHED __builtin_amdgcn_sched_barrier(0)
    Unit cur, nxt; int ui = 0;
    if (!S.next(0, cur)) return;
    f32x4 acc[2][2][4][2];
#pragma unroll
    for (int a = 0; a < 2; ++a)
#pragma unroll
        for (int b = 0; b < 2; ++b)
#pragma unroll
            for (int m = 0; m < 4; ++m)
#pragma unroll
                for (int n = 0; n < 2; ++n) acc[a][b][m][n] = (f32x4){0.f, 0.f, 0.f, 0.f};
    bf16x8 At[4][2], B0[2][2], B1[2][2];
    const char* cA = (const char*)g.A + (size_t)cur.pm * tstepA + (size_t)cur.kt0 * kstep; const char* cB = (const char*)g.Bt + (size_t)cur.pn * tstepB + (size_t)cur.kt0 * kstep; nt = cur.nkt;
    if constexpr (SP2) {
        PG8_STAGE(PG8_SB(0, 0), cB, voffB); PG8_STAGE(PG8_SB(0, 1), cB + hstepB, voffB); PG8_STAGE(PG8_SA(0, 0), cA, voffA); PG8_STAGE(PG8_SA(0, 1), cA + hstepA, voffA);
        if (wr == 1) PG8_BAR;
        PG8_WAIT_V(2); PG8_BAR;
        PG8_STAGE(PG8_SB(1, 0), cB + kstep, voffB); PG8_STAGE(PG8_SA(1, 0), cA + kstep, voffA); PG8_STAGE(PG8_SB(1, 1), cB + hstepB + kstep, voffB);
        PG8_WAIT_V(6); PG8_BAR;
    } else {
        PG8_STAGE(PG8_SB(0, 0), cB, voffB); PG8_STAGE(PG8_SA(0, 0), cA, voffA); PG8_STAGE(PG8_SB(0, 1), cB + hstepB, voffB); PG8_STAGE(PG8_SA(0, 1), cA + hstepA, voffA);
        if (wr == 1) PG8_BAR;
        PG8_WAIT_V(4); PG8_BAR;
        PG8_STAGE(PG8_SB(1, 0), cB + kstep, voffB); PG8_STAGE(PG8_SA(1, 0), cA + kstep, voffA); PG8_STAGE(PG8_SB(1, 1), cB + hstepB + kstep, voffB);
        PG8_WAIT_V(6); PG8_BAR;
    }
    for (;;) {
        const bool has_next = S.next(ui + 1, nxt);
        const char* nA = has_next ? (const char*)g.A + (size_t)nxt.pm * tstepA + (size_t)nxt.kt0 * kstep : cA; const char* nB = has_next ? (const char*)g.Bt + (size_t)nxt.pn * tstepB + (size_t)nxt.kt0 * kstep : cB;
        for (int t = 0; t < nt; t += 2) {
            const bool last = (t == nt - 2);
            const char* a1 = cA + (size_t)(t + 1) * kstep;
            const char* a2 = last ? nA : cA + (size_t)(t + 2) * kstep; const char* b2 = last ? nB : cB + (size_t)(t + 2) * kstep;
            const char* a3 = a2 + kstep; const char* b3 = b2 + kstep;
            if constexpr (SP2) {
            PG8_LDB(B0, 0, 0); PG8_LDB(B1, 0, 1); PG8_SCHED; PG8_LDA(At, 0, 0); PG8_STAGE(PG8_SA(1, 1), a1 + hstepA, voffA);
            PG8_WAIT_V(8); PG8_WAIT_L(0); PG8_BAR; PG8_MMA(0, 0, At, B0); PG8_MMA(0, 1, At, B1); PG8_BAR; PG8_SCHED;
            PG8_LDA(At, 0, 1); PG8_STAGE(PG8_SB(0, 0), b2, voffB); PG8_STAGE(PG8_SB(0, 1), b2 + hstepB, voffB); PG8_STAGE(PG8_SA(0, 0), a2, voffA);
            PG8_WAIT_V(8); PG8_WAIT_L(0); PG8_BAR; PG8_MMA(1, 0, At, B0); PG8_MMA(1, 1, At, B1); PG8_BAR; PG8_SCHED;
            PG8_LDB(B0, 1, 0); PG8_LDB(B1, 1, 1); PG8_SCHED; PG8_LDA(At, 1, 0); PG8_STAGE(PG8_SA(0, 1), a2 + hstepA, voffA);
            PG8_WAIT_V(8); PG8_WAIT_L(0); PG8_BAR; PG8_MMA(0, 0, At, B0); PG8_MMA(0, 1, At, B1); PG8_BAR; PG8_SCHED;
            PG8_LDA(At, 1, 1); PG8_STAGE(PG8_SB(1, 0), b3, voffB); PG8_STAGE(PG8_SB(1, 1), b3 + hstepB, voffB); PG8_STAGE(PG8_SA(1, 0), a3, voffA);
            PG8_WAIT_V(8); PG8_WAIT_L(0); PG8_BAR; PG8_MMA(1, 0, At, B0); PG8_MMA(1, 1, At, B1); PG8_BAR; PG8_SCHED;
            } else {
            PG8_LDB(B0, 0, 0); PG8_SCHED; PG8_LDA(At, 0, 0); PG8_STAGE(PG8_SA(1, 1), a1 + hstepA, voffA);
            PG8_WAIT_L(8); PG8_BAR; PG8_WAIT_L(0); PG8_MMA(0, 0, At, B0); PG8_BAR; PG8_SCHED;
            PG8_LDB(B1, 0, 1); PG8_STAGE(PG8_SB(0, 0), b2, voffB);
            PG8_BAR; PG8_WAIT_L(0); PG8_MMA(0, 1, At, B1); PG8_BAR;
            PG8_LDA(At, 0, 1); PG8_STAGE(PG8_SA(0, 0), a2, voffA);
            PG8_BAR; PG8_WAIT_L(0); PG8_MMA(1, 0, At, B0); PG8_BAR; PG8_SCHED;
            PG8_STAGE(PG8_SB(0, 1), b2 + hstepB, voffB);
            PG8_WAIT_V(6); PG8_BAR; PG8_MMA(1, 1, At, B1); PG8_BAR;
            PG8_LDB(B0, 1, 0); PG8_SCHED; PG8_LDA(At, 1, 0); PG8_STAGE(PG8_SA(0, 1), a2 + hstepA, voffA);
            PG8_WAIT_L(8); PG8_BAR; PG8_WAIT_L(0); PG8_MMA(0, 0, At, B0); PG8_BAR; PG8_SCHED;
            PG8_LDB(B1, 1, 1); PG8_STAGE(PG8_SB(1, 0), b3, voffB);
            PG8_BAR; PG8_WAIT_L(0); PG8_MMA(0, 1, At, B1); PG8_BAR;
            PG8_LDA(At, 1, 1); PG8_STAGE(PG8_SA(1, 0), a3, voffA);
            PG8_BAR; PG8_WAIT_L(0); PG8_MMA(1, 0, At, B0); PG8_BAR; PG8_SCHED;
            PG8_STAGE(PG8_SB(1, 1), b3 + hstepB, voffB);
            PG8_WAIT_V(6); PG8_BAR; PG8_MMA(1, 1, At, B1); PG8_BAR;
            }
        }
        if constexpr (ALIGN_EPI) { if (wr == 0) PG8_BAR; }
        if constexpr (!Epi::AFTER_DRAIN) { E(acc, cur, wr, wc, fr, fq); }
        if (!has_next) break;
#pragma unroll
        for (int a = 0; a < 2; ++a)
#pragma unroll
            for (int b = 0; b < 2; ++b)
#pragma unroll
                for (int m = 0; m < 4; ++m)
#pragma unroll
                    for (int n = 0; n < 2; ++n) acc[a][b][m][n] = (f32x4){0.f, 0.f, 0.f, 0.f};
        cur = nxt; cA = nA; cB = nB; ++ui; nt = cur.nkt;
        if constexpr (ALIGN_EPI) { if (wr == 1) PG8_BAR; }
    }
    PG8_WAIT_V(0);
    if constexpr (!ALIGN_EPI) { if (wr == 0) PG8_BAR; }
    PG8_BAR;
    if constexpr (Epi::AFTER_DRAIN) { E.fused(acc, cur, wr, wc, fr, fq, lds, wid, lane); }
#undef PG8_SA
#undef PG8_SB
#undef PG8_STAGE
#undef PG8_LDA
#undef PG8_LDB
#undef PG8_MMA
#undef PG8_WAIT_V
#undef PG8_WAIT_L
#undef PG8_BAR
#undef PG8_SCHED
}
}

#define GAS __attribute__((address_space(1)))
#define LAS __attribute__((address_space(3)))
typedef unsigned short bf16;
typedef short bf16x8 __attribute__((ext_vector_type(8)));
typedef short s16x4 __attribute__((ext_vector_type(4)));
typedef float f32x4 __attribute__((ext_vector_type(4)));
typedef float f32x2 __attribute__((ext_vector_type(2)));
typedef unsigned u32x4 __attribute__((ext_vector_type(4)));
typedef unsigned u32x2 __attribute__((ext_vector_type(2)));
typedef GAS unsigned gu32;

constexpr int D = 2048, M = 9216, NP = 8192, SEQ = 4096, NS = 128, TS = 8, FF = 8192;
constexpr int AB_IN = 3584, RET_IN = 12288, MEMW = 512;
constexpr float EPS = 1e-6f;
constexpr int NWAVES = 8, NTHR = 512;

__device__ __forceinline__ float bf2f(unsigned short b) { return __uint_as_float((unsigned)b << 16); }
__device__ __forceinline__ unsigned f2bf(float f) { unsigned u = __float_as_uint(f); return (u + 0x7fffu + ((u >> 16) & 1u)) >> 16; }
__device__ __forceinline__ unsigned pk2(float lo, float hi) { return pg8::cvt_pk_bf16(lo, hi); }
__device__ __forceinline__ float wave_sum(float v) {
#pragma unroll
    for (int o = 1; o < 64; o <<= 1) v += __shfl_xor(v, o);
    return v;
}
__device__ __forceinline__ f32x4 mfma16(bf16x8 a, bf16x8 b, f32x4 c) { return __builtin_amdgcn_mfma_f32_16x16x32_bf16(a, b, c, 0, 0, 0); }
__device__ __forceinline__ bf16x8 frag_nat(const LAS bf16* base, int stride, int row0, int k0, int lane) {
    return *(const LAS bf16x8*)(base + (row0 + (lane & 15)) * stride + k0 + 8 * (lane >> 4));
}
__device__ __forceinline__ s16x4 tr4(const LAS bf16* p) { return __builtin_amdgcn_ds_read_tr16_b64_v4i16((LAS s16x4*)p); }
__device__ __forceinline__ bf16x8 frag_tr(const LAS bf16* base, int stride, int k0, int r0, int lane) {
    const LAS bf16* a = base + (k0 + 8 * (lane >> 4) + ((lane & 15) >> 2)) * stride + r0 + 4 * (lane & 3);
    const s16x4 lo = tr4(a), hi = tr4(a + 4 * stride);
    return (bf16x8){lo[0], lo[1], lo[2], lo[3], hi[0], hi[1], hi[2], hi[3]};
}
__device__ __forceinline__ bf16x8 frag_tr_perm(const LAS bf16* base, int stride, int k0, int r0, int lane) {
    const LAS bf16* a = base + (k0 + 4 * (lane >> 4) + ((lane & 15) >> 2)) * stride + r0 + 4 * (lane & 3);
    const s16x4 lo = tr4(a), hi = tr4(a + 16 * stride);
    return (bf16x8){lo[0], lo[1], lo[2], lo[3], hi[0], hi[1], hi[2], hi[3]};
}
__device__ __forceinline__ bf16x8 pack_p(const f32x4& a, const f32x4& b) {
    u32x4 w; w.x = pk2(a[0], a[1]); w.y = pk2(a[2], a[3]); w.z = pk2(b[0], b[1]); w.w = pk2(b[2], b[3]);
    return __builtin_bit_cast(bf16x8, w);
}
#define WG_SYNC() __syncthreads()

struct Frame {
    LAS unsigned char* lds;
    int tid, lane, wave, vcu, G;
};

struct f32x8 { f32x4 lo, hi; };
__device__ __forceinline__ f32x8 bf8_to_f32(const u32x4 r) { f32x8 o; o.lo = (f32x4){__uint_as_float(r.x << 16), __uint_as_float(r.x & 0xffff0000u), __uint_as_float(r.y << 16), __uint_as_float(r.y & 0xffff0000u)};
    o.hi = (f32x4){__uint_as_float(r.z << 16), __uint_as_float(r.z & 0xffff0000u), __uint_as_float(r.w << 16), __uint_as_float(r.w & 0xffff0000u)}; return o; }
__device__ __forceinline__ u32x4 f32_to_bf8(const f32x8& v) { u32x4 w; w.x = pk2(v.lo[0], v.lo[1]); w.y = pk2(v.lo[2], v.lo[3]); w.z = pk2(v.hi[0], v.hi[1]); w.w = pk2(v.hi[2], v.hi[3]); return w; }
__device__ __forceinline__ float sumsq8(const f32x8& v) { return ((v.lo[0] * v.lo[0] + v.lo[1] * v.lo[1]) + (v.lo[2] * v.lo[2] + v.lo[3] * v.lo[3])) + ((v.hi[0] * v.hi[0] + v.hi[1] * v.hi[1]) + (v.hi[2] * v.hi[2] + v.hi[3] * v.hi[3])); }
template <bool HAS_Y, int NR>
__device__ __forceinline__ void norm_rows(const Frame& F, const float* xin_p, const float* xin_s, const bf16* xin_b, const bf16* Y0, const bf16* P, int splits, const float* gpost, float* rs_out, float* xout, bf16* xout_b) {
    const int gw = F.vcu * NWAVES + F.wave, NGW = F.G * NWAVES, lane = F.lane;
    for (int base = gw; base < NP; base += NR * NGW) {
        u32x4 xr[NR][4], yr[NR][4]; f32x8 xf[NR][4];
#pragma unroll
        for (int r = 0; r < NR; ++r) { const int row = base + r * NGW, rw = row < NP ? row : base;
            if (xin_b) {
#pragma unroll
                for (int j = 0; j < 4; ++j) xr[r][j] = __builtin_nontemporal_load((const u32x4*)(xin_b + (size_t)rw * D) + lane + 64 * j);
            } else {
#pragma unroll
                for (int j = 0; j < 4; ++j) { xf[r][j].lo = __builtin_nontemporal_load((const f32x4*)(xin_p + (size_t)rw * D) + 2 * (lane + 64 * j)); xf[r][j].hi = __builtin_nontemporal_load((const f32x4*)(xin_p + (size_t)rw * D) + 2 * (lane + 64 * j) + 1); }
            }
            if (HAS_Y) {
#pragma unroll
                for (int j = 0; j < 4; ++j) yr[r][j] = __builtin_nontemporal_load((const u32x4*)(Y0 + (size_t)rw * D) + lane + 64 * j); } }
#pragma unroll
        for (int r = 0; r < NR; ++r) { const int row = base + r * NGW; const bool ok = row < NP;
            f32x8 x[4];
#pragma unroll
            for (int j = 0; j < 4; ++j) x[j] = xin_b ? bf8_to_f32(xr[r][j]) : xf[r][j];
            if (HAS_Y) {
                f32x8 y[4]; float ss = 0.f;
#pragma unroll
                for (int j = 0; j < 4; ++j) { y[j] = bf8_to_f32(yr[r][j]); ss += sumsq8(y[j]); }
                const float rs = 1.0f / sqrtf(wave_sum(ss) * (1.0f / D) + EPS);
#pragma unroll
                for (int j = 0; j < 4; ++j) { const f32x4 g0 = ((const f32x4*)gpost)[2 * (lane + 64 * j)], g1 = ((const f32x4*)gpost)[2 * (lane + 64 * j) + 1];
                    x[j].lo += y[j].lo * rs * g0; x[j].hi += y[j].hi * rs * g1;
                    if (xout && ok) { __builtin_nontemporal_store(x[j].lo, (f32x4*)(xout + (size_t)row * D) + 2 * (lane + 64 * j)); __builtin_nontemporal_store(x[j].hi, (f32x4*)(xout + (size_t)row * D) + 2 * (lane + 64 * j) + 1); } }
            }
            if (xout_b) {
#pragma unroll
                for (int j = 0; j < 4; ++j) { const u32x4 w = f32_to_bf8(x[j]); if (ok) ((u32x4*)(xout_b + (size_t)row * D))[lane + 64 * j] = w; x[j] = bf8_to_f32(w); } }
            if (rs_out) { float ss = 0.f;
#pragma unroll
                for (int j = 0; j < 4; ++j) ss += sumsq8(x[j]);
                const float rs = 1.0f / sqrtf(wave_sum(ss) * (1.0f / D) + EPS);
                if (lane == 0 && ok) rs_out[row] = rs; }
        }
    }
    for (int row = NP + gw; row < M; row += NGW) {
        f32x8 x[4];
        if (xin_b) {
#pragma unroll
            for (int j = 0; j < 4; ++j) x[j] = bf8_to_f32(__builtin_nontemporal_load((const u32x4*)(xin_b + (size_t)row * D) + lane + 64 * j));
        } else {
#pragma unroll
            for (int j = 0; j < 4; ++j) { x[j].lo = __builtin_nontemporal_load((const f32x4*)(xin_s + (size_t)(row - NP) * D) + 2 * (lane + 64 * j)); x[j].hi = __builtin_nontemporal_load((const f32x4*)(xin_s + (size_t)(row - NP) * D) + 2 * (lane + 64 * j) + 1); }
        }
        if (HAS_Y) {
            f32x8 y[4];
#pragma unroll
            for (int j = 0; j < 4; ++j) { y[j].lo = (f32x4){0.f, 0.f, 0.f, 0.f}; y[j].hi = y[j].lo; }
            if (splits == 8) {
#pragma unroll
                for (int s = 0; s < 8; ++s)
#pragma unroll
                    for (int j = 0; j < 4; ++j) { const f32x8 v = bf8_to_f32(__builtin_nontemporal_load((const u32x4*)(P + ((size_t)s * 1024 + (row - NP)) * D) + lane + 64 * j)); y[j].lo += v.lo; y[j].hi += v.hi; }
            } else {
                for (int s = 0; s < splits; ++s)
#pragma unroll
                    for (int j = 0; j < 4; ++j) { const f32x8 v = bf8_to_f32(__builtin_nontemporal_load((const u32x4*)(P + ((size_t)s * 1024 + (row - NP)) * D) + lane + 64 * j)); y[j].lo += v.lo; y[j].hi += v.hi; }
            }
            float ss = 0.f;
#pragma unroll
            for (int j = 0; j < 4; ++j) ss += sumsq8(y[j]);
            const float rs = 1.0f / sqrtf(wave_sum(ss) * (1.0f / D) + EPS);
#pragma unroll
            for (int j = 0; j < 4; ++j) { const f32x4 g0 = ((const f32x4*)gpost)[2 * (lane + 64 * j)], g1 = ((const f32x4*)gpost)[2 * (lane + 64 * j) + 1];
                x[j].lo += y[j].lo * rs * g0; x[j].hi += y[j].hi * rs * g1;
                if (xout) { __builtin_nontemporal_store(x[j].lo, (f32x4*)(xout + (size_t)row * D) + 2 * (lane + 64 * j)); __builtin_nontemporal_store(x[j].hi, (f32x4*)(xout + (size_t)row * D) + 2 * (lane + 64 * j) + 1); } }
        }
        if (xout_b) {
#pragma unroll
            for (int j = 0; j < 4; ++j) { const u32x4 w = f32_to_bf8(x[j]); ((u32x4*)(xout_b + (size_t)row * D))[lane + 64 * j] = w; x[j] = bf8_to_f32(w); } }
        if (rs_out) { float ss = 0.f;
#pragma unroll
            for (int j = 0; j < 4; ++j) ss += sumsq8(x[j]);
            const float rs = 1.0f / sqrtf(wave_sum(ss) * (1.0f / D) + EPS);
            if (lane == 0) rs_out[row] = rs; }
    }
}

__device__ __forceinline__ void transpose_item(const float* W, int K, int N, bf16* WT, LAS float* scr, int item, int lane, const float* gain = nullptr, int ldw = 0) {
    const int nblk = N / 64, kb = item / nblk, nb = item % nblk, k0 = 64 * kb, n0 = 64 * nb;
    f32x4 v[16];
#pragma unroll
    for (int i = 0; i < 16; ++i) v[i] = __builtin_nontemporal_load((const f32x4*)(W + (size_t)(k0 + 4 * i + (lane >> 4)) * N + n0 + 4 * (lane & 15)));
#pragma unroll
    for (int i = 0; i < 16; ++i) { LAS float* s = scr + (4 * i + (lane >> 4)) * 65 + 4 * (lane & 15); const float gk = gain ? gain[k0 + 4 * i + (lane >> 4)] : 1.0f; s[0] = v[i][0] * gk; s[1] = v[i][1] * gk; s[2] = v[i][2] * gk; s[3] = v[i][3] * gk; }
    asm volatile("s_waitcnt lgkmcnt(0)" ::: "memory");
    const int c = lane & 7;
#pragma unroll
    for (int j = 0; j < 8; ++j) { const int n = (lane >> 3) + 8 * j; const LAS float* s = scr + (8 * c) * 65 + n;
        u32x4 o; o.x = pk2(s[0 * 65], s[1 * 65]); o.y = pk2(s[2 * 65], s[3 * 65]); o.z = pk2(s[4 * 65], s[5 * 65]); o.w = pk2(s[6 * 65], s[7 * 65]);
        *(u32x4*)(WT + (size_t)(n0 + n) * (ldw ? ldw : K) + k0 + 8 * c) = o; }
    asm volatile("s_waitcnt lgkmcnt(0)" ::: "memory");
}
__device__ __forceinline__ void transpose_strided(const float* W, int K, int N, bf16* WT, LAS float* scr, int it0, int stride, int nit, int lane, const float* gain = nullptr, int ldw = 0) {
    const int nblk = N / 64, ldo = ldw ? ldw : K;
#define TR_LOAD(v, item) do { const int kb_ = (item) / nblk, nb_ = (item) - kb_ * nblk; _Pragma("unroll") for (int i = 0; i < 16; ++i) v[i] = __builtin_nontemporal_load((const f32x4*)(W + (size_t)(64 * kb_ + 4 * i + (lane >> 4)) * N + 64 * nb_ + 4 * (lane & 15))); } while (0)
#define TR_STORE(v, item) do { const int kb_ = (item) / nblk, nb_ = (item) - kb_ * nblk, k0 = 64 * kb_, n0 = 64 * nb_; \
        _Pragma("unroll") for (int i = 0; i < 16; ++i) { LAS float* s = scr + (4 * i + (lane >> 4)) * 65 + 4 * (lane & 15); const float gk = gain ? gain[k0 + 4 * i + (lane >> 4)] : 1.0f; s[0] = v[i][0] * gk; s[1] = v[i][1] * gk; s[2] = v[i][2] * gk; s[3] = v[i][3] * gk; } \
        asm volatile("s_waitcnt lgkmcnt(0)" ::: "memory"); \
        _Pragma("unroll") for (int j = 0; j < 8; ++j) { const int n = (lane >> 3) + 8 * j, c = lane & 7; const LAS float* s = scr + (8 * c) * 65 + n; \
            u32x4 o; o.x = pk2(s[0 * 65], s[1 * 65]); o.y = pk2(s[2 * 65], s[3 * 65]); o.z = pk2(s[4 * 65], s[5 * 65]); o.w = pk2(s[6 * 65], s[7 * 65]); \
            *(u32x4*)(WT + (size_t)(n0 + n) * ldo + k0 + 8 * c) = o; } \
        asm volatile("s_waitcnt lgkmcnt(0)" ::: "memory"); } while (0)
    int it = it0; if (it >= nit) return;
    f32x4 va[16], vb[16];
    TR_LOAD(va, it);
    for (;;) {
        int itn = it + stride; bool hn = itn < nit;
        if (hn) TR_LOAD(vb, itn);
        TR_STORE(va, it);
        if (!hn) break;
        it = itn; itn = it + stride; hn = itn < nit;
        if (hn) TR_LOAD(va, itn);
        TR_STORE(vb, it);
        if (!hn) break;
        it = itn;
    }
#undef TR_LOAD
#undef TR_STORE
}
struct WJob { const float* W; bf16* WT; int K, N; };
constexpr float LOG2E = 1.4426950408889634f;
__device__ __forceinline__ void swa_prompt_unit(const Frame& F, int b, int c, int kh, const bf16* Q, const bf16* K, const bf16* V, const float* sinks, bf16* CAT) {
    LAS bf16* Ks = (LAS bf16*)F.lds; LAS bf16* Vs = Ks + 256 * 72;
    const int lane = F.lane, kg = lane >> 4, w = F.wave;
    const int rowbase = b * SEQ + (c - 1) * 128;
#pragma unroll
    for (int i = 0; i < 4; ++i) { const int idx = F.tid + NTHR * i, r = idx >> 3, ch = idx & 7;
        u32x4 kv = (u32x4){0u, 0u, 0u, 0u}, vv = kv;
        if (c > 0 || r >= 128) { kv = *(const u32x4*)(K + (size_t)(rowbase + r) * 256 + kh * 64 + ch * 8); vv = *(const u32x4*)(V + (size_t)(rowbase + r) * 256 + kh * 64 + ch * 8); }
        *(LAS u32x4*)(Ks + r * 72 + ch * 8) = kv; *(LAS u32x4*)(Vs + r * 72 + ch * 8) = vv; }
    WG_SYNC();
    const int hq = kh * 4 + (w >> 1);
    const float sink2 = sinks[hq] * LOG2E;
    for (int mb = 0; mb < 4; ++mb) {
        const int i0 = (w & 1) * 64 + mb * 16, qrow = b * SEQ + c * 128 + i0 + (lane & 15), tb = 2 * (i0 >> 5), tq = i0 + (lane & 15);
        bf16x8 bq[2];
#pragma unroll
        for (int ks = 0; ks < 2; ++ks) bq[ks] = *(const bf16x8*)(Q + (size_t)qrow * 1024 + hq * 64 + ks * 32 + 8 * kg);
        f32x4 st[10]; float mx = -1e30f;
#pragma unroll
        for (int t = 0; t < 10; ++t) { f32x4 a = (f32x4){0.f, 0.f, 0.f, 0.f};
#pragma unroll
            for (int ks = 0; ks < 2; ++ks) a = mfma16(frag_nat(Ks, 72, (tb + t) * 16, ks * 32, lane), bq[ks], a);
#pragma unroll
            for (int r = 0; r < 4; ++r) { const int j = (tb + t) * 16 + 4 * kg + r; const bool ok = (j > tq) && (j <= tq + 128) && (c > 0 || j >= 128);
                a[r] = ok ? a[r] * (0.125f * LOG2E) : -1e30f; mx = fmaxf(mx, a[r]); }
            st[t] = a; }
        mx = fmaxf(mx, __shfl_xor(mx, 16)); mx = fmaxf(mx, __shfl_xor(mx, 32)); mx = fmaxf(mx, sink2);
        float sum = 0.f;
#pragma unroll
        for (int t = 0; t < 10; ++t)
#pragma unroll
            for (int r = 0; r < 4; ++r) { const float p = __builtin_amdgcn_exp2f(st[t][r] - mx); st[t][r] = p; sum += p; }
        sum += __shfl_xor(sum, 16); sum += __shfl_xor(sum, 32);
        const float inv = 1.0f / (sum + __builtin_amdgcn_exp2f(sink2 - mx));
        f32x4 o[4];
#pragma unroll
        for (int dt = 0; dt < 4; ++dt) o[dt] = (f32x4){0.f, 0.f, 0.f, 0.f};
#pragma unroll
        for (int s = 0; s < 5; ++s) { const bf16x8 pb = pack_p(st[2 * s], st[2 * s + 1]);
#pragma unroll
            for (int dt = 0; dt < 4; ++dt) o[dt] = mfma16(frag_tr_perm(Vs, 72, (tb + 2 * s) * 16, dt * 16, lane), pb, o[dt]); }
#pragma unroll
        for (int dt = 0; dt < 4; ++dt) { u32x2 wv; wv.x = pk2(o[dt][0] * inv, o[dt][1] * inv); wv.y = pk2(o[dt][2] * inv, o[dt][3] * inv);
            *(u32x2*)(CAT + (size_t)qrow * 2048 + hq * 64 + dt * 16 + 4 * kg) = wv; }
    }
    WG_SYNC();
}
__device__ __forceinline__ void gate_prompt_unit(const Frame& F, int b, int c, int g, const bf16* ZU, const bf16* ZV, const long long* zvstat, const float* lng, const float* lnb, const float* w_s, const float* b_s, bf16* CAT) {
    LAS bf16* Ws = (LAS bf16*)F.lds; LAS bf16* Zs = Ws + 128 * 136;
    const int lane = F.lane, kg = lane >> 4, w = F.wave;
#pragma unroll
    for (int i = 0; i < 8; ++i) { const int idx = F.tid + NTHR * i, r = idx >> 5, j4 = (idx & 31) * 4;
        f32x4 v = *(const f32x4*)(w_s + ((size_t)g * 128 + r) * 128 + j4);
#pragma unroll
        for (int e = 0; e < 4; ++e) if (j4 + e > r) v[e] = 0.f;
        u32x2 wv; wv.x = pk2(v[0], v[1]); wv.y = pk2(v[2], v[3]); *(LAS u32x2*)(Ws + r * 136 + j4) = wv; }
#pragma unroll
    for (int i = 0; i < 8; ++i) { const int idx = F.tid + NTHR * i, r = idx >> 5, ch = idx & 31, col = g * 256 + ch * 8, row = b * SEQ + c * 128 + r;
        const u32x4 raw = *(const u32x4*)(ZV + (size_t)row * 1024 + col);
        const float mean = (float)zvstat[2 * row] * (1.0f / (1024.0f * 16777216.0f)), var = (float)zvstat[2 * row + 1] * (1.0f / (1024.0f * 16777216.0f)) - mean * mean, rstd = 1.0f / sqrtf(fmaxf(var, 0.f) + EPS);
        const f32x4 g0 = *(const f32x4*)(lng + col), g1 = *(const f32x4*)(lng + col + 4), b0 = *(const f32x4*)(lnb + col), b1 = *(const f32x4*)(lnb + col + 4);
        float z[8];
#pragma unroll
        for (int e = 0; e < 4; ++e) { z[2 * e] = __uint_as_float(raw[e] << 16); z[2 * e + 1] = __uint_as_float(raw[e] & 0xffff0000u); }
        u32x4 o;
        o.x = pk2((z[0] - mean) * rstd * g0[0] + b0[0], (z[1] - mean) * rstd * g0[1] + b0[1]); o.y = pk2((z[2] - mean) * rstd * g0[2] + b0[2], (z[3] - mean) * rstd * g0[3] + b0[3]);
        o.z = pk2((z[4] - mean) * rstd * g1[0] + b1[0], (z[5] - mean) * rstd * g1[1] + b1[1]); o.w = pk2((z[6] - mean) * rstd * g1[2] + b1[2], (z[7] - mean) * rstd * g1[3] + b1[3]);
        *(LAS u32x4*)(Zs + r * 264 + ch * 8) = o; }
    WG_SYNC();
    const int i0 = 16 * w, nst = (w >> 1) + 1;
    f32x4 acc[16];
#pragma unroll
    for (int dt = 0; dt < 16; ++dt) acc[dt] = (f32x4){0.f, 0.f, 0.f, 0.f};
    for (int s = 0; s < nst; ++s) { const bf16x8 bw = frag_nat(Ws, 136, i0, 32 * s, lane);
#pragma unroll
        for (int dt = 0; dt < 16; ++dt) acc[dt] = mfma16(frag_tr(Zs, 264, 32 * s, dt * 16, lane), bw, acc[dt]); }
    const int row = b * SEQ + c * 128 + i0 + (lane & 15); const float bs = b_s[g * 128 + i0 + (lane & 15)];
#pragma unroll
    for (int dt = 0; dt < 16; ++dt) { const int col = g * 256 + dt * 16 + 4 * kg; const u32x2 zu = *(const u32x2*)(ZU + (size_t)row * 1024 + col);
        u32x2 wv; wv.x = pk2(__uint_as_float(zu.x << 16) * (acc[dt][0] + bs), __uint_as_float(zu.x & 0xffff0000u) * (acc[dt][1] + bs));
        wv.y = pk2(__uint_as_float(zu.y << 16) * (acc[dt][2] + bs), __uint_as_float(zu.y & 0xffff0000u) * (acc[dt][3] + bs));
        *(u32x2*)(CAT + (size_t)row * 2048 + 1024 + col) = wv; }
    WG_SYNC();
}
__device__ __forceinline__ void gate_sample_unit(const Frame& F, int n, const bf16* ZU, const bf16* ZV, const long long* zvstat, const float* lng, const float* lnb, const float* w_s, const float* b_s, bf16* CAT, float* ogv) {
#pragma unroll
    for (int cc = 0; cc < 2; ++cc) { const int col = F.tid + NTHR * cc, g = col >> 8; const float lg = lng[col], lb = lnb[col];
        float z[8];
#pragma unroll
        for (int j = 0; j < 8; ++j) { const int row = NP + n * 8 + j;
            const float mean = (float)zvstat[2 * row] * (1.0f / (1024.0f * 16777216.0f)), var = (float)zvstat[2 * row + 1] * (1.0f / (1024.0f * 16777216.0f)) - mean * mean, rstd = 1.0f / sqrtf(fmaxf(var, 0.f) + EPS);
            z[j] = (bf2f(ZV[(size_t)row * 1024 + col]) - mean) * rstd * lg + lb; ogv[(size_t)(n * 8 + j) * 1024 + col] = z[j]; }
#pragma unroll
        for (int i = 0; i < 8; ++i) { float mixed = b_s[g * 128 + i];
#pragma unroll
            for (int j = 0; j <= i; ++j) mixed += w_s[((size_t)g * 128 + i) * 128 + j] * z[j];
            const int row = NP + n * 8 + i; CAT[(size_t)row * 2048 + 1024 + col] = (bf16)f2bf(bf2f(ZU[(size_t)row * 1024 + col]) * mixed); } }
}
__device__ __forceinline__ void swa_sample_unit(const Frame& F, int n, int khp, const bf16* Q, const bf16* K, const bf16* V, const float* ck, const float* cv, const float* sinks, bf16* CAT, float* oks, float* ovs) {
    LAS bf16* Ks = (LAS bf16*)F.lds; LAS bf16* Vs = Ks + 2 * 144 * 72;
    const int lane = F.lane, kg = lane >> 4, w = F.wave;
#pragma unroll
    for (int i = 0; i < 8; ++i) { const int idx = F.tid + NTHR * i, j = idx >> 5, f4 = idx & 31, khl = f4 >> 4, d = (f4 & 15) * 4;
        const size_t off = (((size_t)n * 128 + j) * 4 + 2 * khp) * 64 + f4 * 4;
        const f32x4 kv = *(const f32x4*)(ck + off), vv = *(const f32x4*)(cv + off);
        u32x2 a; a.x = pk2(kv[0], kv[1]); a.y = pk2(kv[2], kv[3]); *(LAS u32x2*)(Ks + (khl * 144 + j) * 72 + d) = a;
        u32x2 c2; c2.x = pk2(vv[0], vv[1]); c2.y = pk2(vv[2], vv[3]); *(LAS u32x2*)(Vs + (khl * 160 + j) * 72 + d) = c2;
        if (j >= 8) { const size_t oo = (((size_t)n * 128 + j - 8) * 4 + 2 * khp) * 64 + f4 * 4; *(f32x4*)(oks + oo) = kv; *(f32x4*)(ovs + oo) = vv; } }
    if (F.tid < 128) { const int t = F.tid >> 4, khl = (F.tid >> 3) & 1, ch = F.tid & 7; const size_t off = (size_t)(NP + n * 8 + t) * 256 + (2 * khp + khl) * 64 + ch * 8;
        *(LAS u32x4*)(Ks + (khl * 144 + 128 + t) * 72 + ch * 8) = *(const u32x4*)(K + off); *(LAS u32x4*)(Vs + (khl * 160 + 128 + t) * 72 + ch * 8) = *(const u32x4*)(V + off); }
    else if (F.tid < 128 + 64 * 2) { const int x = F.tid - 128, khl = x >> 6, r = 136 + ((x & 63) >> 3), ch = x & 7; *(LAS u32x4*)(Ks + (khl * 144 + r) * 72 + ch * 8) = (u32x4){0u, 0u, 0u, 0u}; }
    for (int x = F.tid; x < 2 * 24 * 8; x += NTHR) { const int khl = x / 192, r = 136 + ((x % 192) >> 3), ch = x & 7; *(LAS u32x4*)(Vs + (khl * 160 + r) * 72 + ch * 8) = (u32x4){0u, 0u, 0u, 0u}; }
    WG_SYNC();
    if (w < 4) {
        const int khl = w >> 1, kh = 2 * khp + khl, t = lane & 7, head = kh * 4 + 2 * (w & 1) + ((lane & 15) >> 3), qrow = NP + n * 8 + t;
        const LAS bf16* Kh = Ks + khl * 144 * 72; const LAS bf16* Vh = Vs + khl * 160 * 72;
        const float sink2 = sinks[head] * LOG2E;
        bf16x8 bq[2];
#pragma unroll
        for (int ks = 0; ks < 2; ++ks) bq[ks] = *(const bf16x8*)(Q + (size_t)qrow * 1024 + head * 64 + ks * 32 + 8 * kg);
        f32x4 st[10]; float mx = -1e30f;
#pragma unroll
        for (int tt = 0; tt < 9; ++tt) { f32x4 a = (f32x4){0.f, 0.f, 0.f, 0.f};
#pragma unroll
            for (int ks = 0; ks < 2; ++ks) a = mfma16(frag_nat(Kh, 72, tt * 16, ks * 32, lane), bq[ks], a);
#pragma unroll
            for (int r = 0; r < 4; ++r) { const int j = tt * 16 + 4 * kg + r; const bool ok = (j > t) && (j <= t + 128);
                a[r] = ok ? a[r] * (0.125f * LOG2E) : -1e30f; mx = fmaxf(mx, a[r]); }
            st[tt] = a; }
        st[9] = (f32x4){-1e30f, -1e30f, -1e30f, -1e30f};
        mx = fmaxf(mx, __shfl_xor(mx, 16)); mx = fmaxf(mx, __shfl_xor(mx, 32)); mx = fmaxf(mx, sink2);
        float sum = 0.f;
#pragma unroll
        for (int tt = 0; tt < 10; ++tt)
#pragma unroll
            for (int r = 0; r < 4; ++r) { const float p = __builtin_amdgcn_exp2f(st[tt][r] - mx); st[tt][r] = p; sum += p; }
        sum += __shfl_xor(sum, 16); sum += __shfl_xor(sum, 32);
        const float inv = 1.0f / (sum + __builtin_amdgcn_exp2f(sink2 - mx));
        f32x4 o[4];
#pragma unroll
        for (int dt = 0; dt < 4; ++dt) o[dt] = (f32x4){0.f, 0.f, 0.f, 0.f};
#pragma unroll
        for (int s = 0; s < 5; ++s) { const bf16x8 pb = pack_p(st[2 * s], st[2 * s + 1]);
#pragma unroll
            for (int dt = 0; dt < 4; ++dt) o[dt] = mfma16(frag_tr_perm(Vh, 72, 32 * s, dt * 16, lane), pb, o[dt]); }
#pragma unroll
        for (int dt = 0; dt < 4; ++dt) { u32x2 wv; wv.x = pk2(o[dt][0] * inv, o[dt][1] * inv); wv.y = pk2(o[dt][2] * inv, o[dt][3] * inv);
            *(u32x2*)(CAT + (size_t)qrow * 2048 + head * 64 + dt * 16 + 4 * kg) = wv; }
    }
    WG_SYNC();
}

constexpr size_t QSEG = (size_t)132 * 1024 * 1024 / 2;
__device__ __forceinline__ bf16x8 ldq2(const bf16* p) {
    const u32x4 a = *(const u32x4*)p, b = *(const u32x4*)(p + QSEG); u32x4 o;
#pragma unroll
    for (int e = 0; e < 4; ++e) o[e] = pk2(__uint_as_float(a[e] << 16) + __uint_as_float(b[e] << 16), __uint_as_float(a[e] & 0xffff0000u) + __uint_as_float(b[e] & 0xffff0000u));
    return __builtin_bit_cast(bf16x8, o);
}
__device__ __forceinline__ void mem_attn_wave(const LAS bf16* Ks, const LAS bf16* Vs, const bf16* qptr  , bf16* optr, bool store, int lane) {
    const int kg = lane >> 4;
    bf16x8 bq[4];
#pragma unroll
    for (int ks = 0; ks < 4; ++ks) bq[ks] = ldq2(qptr + ks * 32 + 8 * kg);
    f32x4 st[16]; float mx = -1e30f;
#pragma unroll
    for (int t = 0; t < 16; ++t) { f32x4 a = (f32x4){0.f, 0.f, 0.f, 0.f};
#pragma unroll
        for (int ks = 0; ks < 4; ++ks) a = mfma16(frag_nat(Ks, 136, t * 16, ks * 32, lane), bq[ks], a);
#pragma unroll
        for (int r = 0; r < 4; ++r) { a[r] *= (0.08838834764831845f * LOG2E); mx = fmaxf(mx, a[r]); }
        st[t] = a; }
    mx = fmaxf(mx, __shfl_xor(mx, 16)); mx = fmaxf(mx, __shfl_xor(mx, 32));
    float sum = 0.f;
#pragma unroll
    for (int t = 0; t < 16; ++t)
#pragma unroll
        for (int r = 0; r < 4; ++r) { const float p = __builtin_amdgcn_exp2f(st[t][r] - mx); st[t][r] = p; sum += p; }
    sum += __shfl_xor(sum, 16); sum += __shfl_xor(sum, 32);
    const float inv = 1.0f / sum;
    f32x4 o[8];
#pragma unroll
    for (int dt = 0; dt < 8; ++dt) o[dt] = (f32x4){0.f, 0.f, 0.f, 0.f};
#pragma unroll
    for (int s = 0; s < 8; ++s) { const bf16x8 pb = pack_p(st[2 * s], st[2 * s + 1]);
#pragma unroll
        for (int dt = 0; dt < 8; ++dt) o[dt] = mfma16(frag_tr_perm(Vs, 136, 32 * s, dt * 16, lane), pb, o[dt]); }
    if (store) {
#pragma unroll
        for (int dt = 0; dt < 8; ++dt) { u32x2 wv; wv.x = pk2(o[dt][0] * inv, o[dt][1] * inv); wv.y = pk2(o[dt][2] * inv, o[dt][3] * inv); *(u32x2*)(optr + dt * 16 + 4 * kg) = wv; } }
}
__device__ __forceinline__ void mem_prompt_unit(const Frame& F, int b, int h, int qb, const bf16* QM, const bf16* KV, bf16* OM) {
    LAS bf16* Ks = (LAS bf16*)F.lds; LAS bf16* Vs = Ks + 256 * 136;
#pragma unroll
    for (int i = 0; i < 8; ++i) { const int idx = F.tid + NTHR * i, r = idx >> 4, ch = idx & 15; const size_t off = (size_t)(b * 256 + r) * 1024 + h * 128 + ch * 8;
        *(LAS u32x4*)(Ks + r * 136 + ch * 8) = *(const u32x4*)(KV + off); *(LAS u32x4*)(Vs + r * 136 + ch * 8) = *(const u32x4*)(KV + off + 512); }
    WG_SYNC();
    const size_t row = (size_t)b * SEQ + qb * 128 + F.wave * 16 + (F.lane & 15);
    mem_attn_wave(Ks, Vs, QM + row * 512 + h * 128, OM + row * 512 + h * 128, true, F.lane);
    WG_SYNC();
}
__device__ __forceinline__ void mem_sample_units(const Frame& F, int u0, int ustride, const bf16* QM, const float* ck, const float* cv, bf16* OM) {
    LAS bf16* Ks = (LAS bf16*)F.lds; LAS bf16* Vs = Ks + 256 * 136; LAS bf16* Pb = Vs + 256 * 136; LAS float* smax = (LAS float*)(Pb + 8 * 264); LAS float* ssum = smax + 64;
    const int lane = F.lane, kg = lane >> 4, w = F.wave, q = lane & 7;
    f32x4 kv[16], vv[16];
#define MS_LOAD(u_) do { const int n_ = (u_) >> 2, h_ = (u_) & 3; _Pragma("unroll") for (int i = 0; i < 16; ++i) { const int idx = F.tid + NTHR * i, r = idx >> 5, f4 = idx & 31; const size_t off = (((size_t)n_ * 256 + r) * 4 + h_) * 128 + f4 * 4; \
            kv[i] = __builtin_nontemporal_load((const f32x4*)(ck + off)); vv[i] = __builtin_nontemporal_load((const f32x4*)(cv + off)); } } while (0)
    if (u0 < 512) MS_LOAD(u0);
    for (int u = u0; u < 512; u += ustride) {
        const int n = u >> 2, h = u & 3;
#pragma unroll
        for (int i = 0; i < 16; ++i) { const int idx = F.tid + NTHR * i, r = idx >> 5, f4 = idx & 31;
            u32x2 a; a.x = pk2(kv[i][0], kv[i][1]); a.y = pk2(kv[i][2], kv[i][3]); *(LAS u32x2*)(Ks + r * 136 + f4 * 4) = a;
            u32x2 c2; c2.x = pk2(vv[i][0], vv[i][1]); c2.y = pk2(vv[i][2], vv[i][3]); *(LAS u32x2*)(Vs + r * 136 + f4 * 4) = c2; }
        if (u + ustride < 512) MS_LOAD(u + ustride);
        const size_t row = (size_t)NP + n * 8 + q;
        bf16x8 bq[4];
#pragma unroll
        for (int ks = 0; ks < 4; ++ks) bq[ks] = ldq2(QM + row * 512 + h * 128 + ks * 32 + 8 * kg);
        WG_SYNC();
        f32x4 st[2]; float mx = -1e30f;
#pragma unroll
        for (int t = 0; t < 2; ++t) { f32x4 a = (f32x4){0.f, 0.f, 0.f, 0.f};
#pragma unroll
            for (int ks = 0; ks < 4; ++ks) a = mfma16(frag_nat(Ks, 136, (2 * w + t) * 16, ks * 32, lane), bq[ks], a);
#pragma unroll
            for (int r = 0; r < 4; ++r) { a[r] *= (0.08838834764831845f * LOG2E); mx = fmaxf(mx, a[r]); }
            st[t] = a; }
        mx = fmaxf(mx, __shfl_xor(mx, 16)); mx = fmaxf(mx, __shfl_xor(mx, 32));
        if (lane < 8) smax[w * 8 + lane] = mx;
        WG_SYNC();
        float gm = smax[q];
#pragma unroll
        for (int ww = 1; ww < 8; ++ww) gm = fmaxf(gm, smax[ww * 8 + q]);
        float sum = 0.f;
#pragma unroll
        for (int t = 0; t < 2; ++t)
#pragma unroll
            for (int r = 0; r < 4; ++r) { const float p = __builtin_amdgcn_exp2f(st[t][r] - gm); sum += p; if ((lane & 15) < 8) Pb[q * 264 + (2 * w + t) * 16 + 4 * kg + r] = (bf16)f2bf(p); }
        sum += __shfl_xor(sum, 16); sum += __shfl_xor(sum, 32);
        if (lane < 8) ssum[w * 8 + lane] = sum;
        WG_SYNC();
        float tot = ssum[q];
#pragma unroll
        for (int ww = 1; ww < 8; ++ww) tot += ssum[ww * 8 + q];
        f32x4 o = (f32x4){0.f, 0.f, 0.f, 0.f};
#pragma unroll
        for (int s2 = 0; s2 < 8; ++s2) o = mfma16(frag_tr(Vs, 136, 32 * s2, w * 16, lane), *(const LAS bf16x8*)(Pb + q * 264 + 32 * s2 + 8 * kg), o);
        if ((lane & 15) < 8) { const float inv = 1.0f / tot; u32x2 wv; wv.x = pk2(o[0] * inv, o[1] * inv); wv.y = pk2(o[2] * inv, o[3] * inv); *(u32x2*)(OM + row * 512 + h * 128 + w * 16 + 4 * kg) = wv; }
        WG_SYNC();
    }
#undef MS_LOAD
}
constexpr int ES = 64, NE = ES / 16;
__device__ __forceinline__ float ret_lg2(int h) { return log2f(1.0f - exp2f(-5.0f - (float)h)); }
__device__ __forceinline__ void ret_prompt_scan(const Frame& F, int b, int h, int es, const bf16* ZR, bf16* OR, unsigned long long* SS, float* ostate) {
    constexpr int VST = ES + 8, NV = ES / 32;
    LAS bf16* Ks = (LAS bf16*)F.lds; LAS bf16* Vs = Ks + 128 * 264; LAS bf16* Vd = Vs + 128 * VST; LAS bf16* Ss = Vd + 128 * VST;
    const int lane = F.lane, kg = lane >> 4, w = F.wave, tid = F.tid;
    const int it = (w < 4) ? w : 11 - w;
    const float lg2 = ret_lg2(h);
    const int e0 = es * ES;
    bf16x8 qf[8]; u32x4 kpre[8], vpre[NV];
    const size_t rb = (size_t)b * SEQ;
#define RET_LOAD_KV(c_, tid) do { \
        const unsigned kl_off = (unsigned)(((tid) >> 5) * RET_IN + ((tid) & 31) * 8) * 2u; \
        const char* kb_ = (const char*)(ZR + (rb + (size_t)(c_) * 128) * RET_IN + 2048 + h * 256); \
        _Pragma("unroll") for (int i = 0; i < 8; ++i) kpre[i] = *(const u32x4*)(kb_ + (size_t)i * (16 * RET_IN * 2) + kl_off); \
        _Pragma("unroll") for (int i = 0; i < NV; ++i) { const int idx = tid + NTHR * i, r = idx / (ES / 8), ch = idx % (ES / 8); vpre[i] = *(const u32x4*)(ZR + (rb + (c_) * 128 + r) * RET_IN + 4096 + h * 512 + e0 + ch * 8); } } while (0)
#define RET_LOAD_Q(c_, lane) do { const unsigned q_off = (unsigned)((16 * it + ((lane) & 15)) * RET_IN + 8 * ((lane) >> 4)) * 2u; const char* qb_ = (const char*)(ZR + (rb + (size_t)(c_) * 128) * RET_IN + h * 256); \
        _Pragma("unroll") for (int ks = 0; ks < 8; ++ks) qf[ks] = *(const bf16x8*)(qb_ + ks * 64 + q_off); } while (0)
#define RET_STORE_KV(tid) do { \
        const unsigned kl_lds = (unsigned)(((tid) >> 5) * 264 + ((tid) & 31) * 8) * 2u; \
        _Pragma("unroll") for (int i = 0; i < 8; ++i) *(LAS u32x4*)((LAS char*)Ks + kl_lds + i * (16 * 264 * 2)) = kpre[i]; \
        _Pragma("unroll") for (int i = 0; i < NV; ++i) { const int idx = tid + NTHR * i, r = idx / (ES / 8), ch = idx % (ES / 8); *(LAS u32x4*)(Vs + r * VST + ch * 8) = vpre[i]; \
          const float dk = __builtin_amdgcn_exp2f(lg2 * (float)(127 - r)); u32x4 o; \
          _Pragma("unroll") for (int e = 0; e < 4; ++e) o[e] = pk2(__uint_as_float(vpre[i][e] << 16) * dk, __uint_as_float(vpre[i][e] & 0xffff0000u) * dk); \
          *(LAS u32x4*)(Vd + r * VST + ch * 8) = o; } } while (0)
    for (int x = tid; x < 256 * VST / 8; x += NTHR) *(LAS u32x4*)(Ss + x * 8) = (u32x4){0u, 0u, 0u, 0u};
    f32x4 sacc[2][NE];
#pragma unroll
    for (int a = 0; a < 2; ++a)
#pragma unroll
        for (int e = 0; e < NE; ++e) sacc[a][e] = (f32x4){0.f, 0.f, 0.f, 0.f};
    const float g128 = __builtin_amdgcn_exp2f(lg2 * 128.0f);
    RET_LOAD_KV(0, tid); RET_LOAD_Q(0, lane); RET_STORE_KV(tid);
    WG_SYNC();
    for (int c = 0; c < 32; ++c) {
        int ln = lane, tc = tid; asm volatile("" : "+v"(ln), "+v"(tc));
        const int kg = ln >> 4, iq = 16 * it + (ln & 15);
        const float giq = __builtin_amdgcn_exp2f(lg2 * (float)iq);
        float gkr[4];
#pragma unroll
        for (int r = 0; r < 4; ++r) gkr[r] = __builtin_amdgcn_exp2f(lg2 * (float)(-(4 * kg + r)));
        f32x4 oi[NE];
#pragma unroll
        for (int e = 0; e < NE; ++e) oi[e] = (f32x4){0.f, 0.f, 0.f, 0.f};
#pragma unroll
        for (int ks = 0; ks < 8; ++ks) { if ((ks & 1) == 0) asm volatile("" ::: "memory");
#pragma unroll
            for (int e = 0; e < NE; ++e) oi[e] = mfma16(frag_tr(Ss, VST, 32 * ks, e * 16, ln), qf[ks], oi[e]); }
        { const float qd = __builtin_amdgcn_exp2f(lg2 * (float)(iq + 1));
#pragma unroll
          for (int e = 0; e < NE; ++e) oi[e] *= qd; }
        if (c + 1 < 32) RET_LOAD_KV(c + 1, tc);
#pragma unroll
        for (int s = 0; s < 4; ++s) if (2 * s <= it) { asm volatile("" ::: "memory");
            f32x4 a2[2];
#pragma unroll
            for (int hh = 0; hh < 2; ++hh) { const int jt = 2 * s + hh; f32x4 a = (f32x4){0.f, 0.f, 0.f, 0.f};
                if (jt <= it) {
#pragma unroll
                    for (int ks = 0; ks < 8; ++ks) a = mfma16(frag_nat(Ks, 264, jt * 16, ks * 32, ln), qf[ks], a);
                    const float gj = giq * __builtin_amdgcn_exp2f(lg2 * (float)(-16 * jt));
#pragma unroll
                    for (int r = 0; r < 4; ++r) a[r] *= gj * gkr[r];
                    if (jt == it) {
#pragma unroll
                        for (int r = 0; r < 4; ++r) if (4 * kg + r > (ln & 15)) a[r] = 0.f; } }
                a2[hh] = a; }
            const bf16x8 pb = pack_p(a2[0], a2[1]);
#pragma unroll
            for (int e = 0; e < NE; ++e) oi[e] = mfma16(frag_tr_perm(Vs, VST, 32 * s, e * 16, ln), pb, oi[e]); }
        const size_t orow = rb + c * 128 + iq; float ssq = 0.f;
#pragma unroll
        for (int e = 0; e < NE; ++e) { const f32x4 o = oi[e]; ssq += (o[0] * o[0] + o[1] * o[1]) + (o[2] * o[2] + o[3] * o[3]);
            u32x2 wv; wv.x = pk2(o[0], o[1]); wv.y = pk2(o[2], o[3]); *(u32x2*)(OR + orow * 4096 + h * 512 + e0 + e * 16 + 4 * kg) = wv; }
        ssq += __shfl_xor(ssq, 16); ssq += __shfl_xor(ssq, 32);
        if (kg == 0) atomicAdd(SS + orow * 8 + h, (unsigned long long)__float2ll_rn(ssq * 16777216.0f));
        WG_SYNC();
        if (c + 1 < 32) RET_LOAD_Q(c + 1, ln);
#pragma unroll
        for (int a = 0; a < 2; ++a)
#pragma unroll
            for (int e = 0; e < NE; ++e) sacc[a][e] *= g128;
#pragma unroll
        for (int s = 0; s < 4; ++s) { asm volatile("" ::: "memory");
            bf16x8 vf[NE];
#pragma unroll
            for (int e = 0; e < NE; ++e) vf[e] = frag_tr(Vd, VST, 32 * s, e * 16, ln);
#pragma unroll
            for (int a = 0; a < 2; ++a) { const bf16x8 kf = frag_tr(Ks, 264, 32 * s, (2 * w + a) * 16, ln);
#pragma unroll
                for (int e = 0; e < NE; ++e) sacc[a][e] = mfma16(kf, vf[e], sacc[a][e]); } }
#pragma unroll
        for (int a = 0; a < 2; ++a)
#pragma unroll
            for (int e = 0; e < NE; ++e)
#pragma unroll
                for (int r = 0; r < 4; ++r) Ss[((2 * w + a) * 16 + 4 * kg + r) * VST + e * 16 + (ln & 15)] = (bf16)f2bf(sacc[a][e][r]);
        WG_SYNC();
        if (c + 1 < 32) RET_STORE_KV(tc);
        WG_SYNC();
    }
#undef RET_LOAD_KV
#undef RET_LOAD_Q
#undef RET_STORE_KV
#pragma unroll
    for (int a = 0; a < 2; ++a)
#pragma unroll
        for (int e = 0; e < NE; ++e)
#pragma unroll
            for (int r = 0; r < 4; ++r) ostate[(((size_t)b * 8 + h) * 256 + (2 * w + a) * 16 + 4 * kg + r) * 512 + e0 + e * 16 + (lane & 15)] = sacc[a][e][r];
}
__device__ __forceinline__ void ret_sample_pass(const Frame& F, int unit0, const bf16* ZR, const float* state, float* ostate, bf16* OR, unsigned long long* SS) {
    const int grp = F.wave >> 2, dq = (F.wave >> 1) & 1, t = (F.wave & 1) * 64 + F.lane, t256 = dq * 128 + t, unit = unit0 + grp, n = unit >> 3, h = unit & 7;
    LAS float* qk = (LAS float*)F.lds + grp * (256 * 16 + 64 + 8 * 128 * 4); LAS float* sc = qk + 256 * 16; LAS f32x4* red = (LAS f32x4*)(sc + 64);
    const float lg2 = ret_lg2(h);
    const size_t r0 = (size_t)NP + n * 8;
#pragma unroll 4
    for (int x = t256; x < 8 * 256; x += 256) { const int i = x >> 8, d = x & 255;
        qk[d * 16 + i] = bf2f(ZR[(r0 + i) * RET_IN + h * 256 + d]);
        qk[d * 16 + 8 + i] = bf2f(ZR[(r0 + i) * RET_IN + 2048 + h * 256 + d]) * __builtin_amdgcn_exp2f(lg2 * (float)(7 - i)); }
    float v[8][4];
#pragma unroll
    for (int j = 0; j < 8; ++j) { const u32x2 raw = *(const u32x2*)(ZR + (r0 + j) * RET_IN + 4096 + h * 512 + 4 * t);
        v[j][0] = __uint_as_float(raw.x << 16); v[j][1] = __uint_as_float(raw.x & 0xffff0000u); v[j][2] = __uint_as_float(raw.y << 16); v[j][3] = __uint_as_float(raw.y & 0xffff0000u); }
    WG_SYNC();
    const float g8 = __builtin_amdgcn_exp2f(lg2 * 8.0f);
    const __amdgpu_buffer_rsrc_t rs_in = __builtin_amdgcn_make_buffer_rsrc((void*)(state + ((size_t)n * 8 + h) * 256 * 512), 0, 256 * 2048, 0x00020000);
    const __amdgpu_buffer_rsrc_t rs_out = __builtin_amdgcn_make_buffer_rsrc((void*)(ostate + ((size_t)n * 8 + h) * 256 * 512), 0, 256 * 2048, 0x00020000);
    const int loff = t * 16, dbase = dq * 128;
    f32x4 acc[8];
#pragma unroll
    for (int i = 0; i < 8; ++i) acc[i] = (f32x4){0.f, 0.f, 0.f, 0.f};
    constexpr int RB = 4;
    f32x4 bufA[RB], bufB[RB];
#define RS_LD(buf, d0_) do { _Pragma("unroll") for (int u = 0; u < RB; ++u) buf[u] = __builtin_bit_cast(f32x4, __builtin_amdgcn_raw_buffer_load_b128(rs_in, loff, (dbase + (d0_) + u) * 2048, 2)); } while (0)
#define RS_CP(buf, d0_) do { _Pragma("unroll") for (int u = 0; u < RB; ++u) { __builtin_amdgcn_sched_barrier(0); const LAS f32x4* qp = (const LAS f32x4*)(qk + (dbase + (d0_) + u) * 16); const f32x4 q0 = qp[0], q1 = qp[1], k0 = qp[2], k1 = qp[3]; \
            const f32x4 sv = buf[u]; f32x4 s1 = sv * g8; \
            _Pragma("unroll") for (int e = 0; e < 4; ++e) { \
                s1[e] += k0[0] * v[0][e] + k0[1] * v[1][e] + k0[2] * v[2][e] + k0[3] * v[3][e] + k1[0] * v[4][e] + k1[1] * v[5][e] + k1[2] * v[6][e] + k1[3] * v[7][e]; \
                acc[0][e] += q0[0] * sv[e]; acc[1][e] += q0[1] * sv[e]; acc[2][e] += q0[2] * sv[e]; acc[3][e] += q0[3] * sv[e]; \
                acc[4][e] += q1[0] * sv[e]; acc[5][e] += q1[1] * sv[e]; acc[6][e] += q1[2] * sv[e]; acc[7][e] += q1[3] * sv[e]; } \
            __builtin_amdgcn_raw_buffer_store_b128(__builtin_bit_cast(u32x4, s1), rs_out, loff, (dbase + (d0_) + u) * 2048, 2); } } while (0)
    RS_LD(bufA, 0);
#pragma unroll 1
    for (int d0 = 0; d0 < 128; d0 += 2 * RB) {
        RS_LD(bufB, d0 + RB);
        RS_CP(bufA, d0);
        if (d0 + 2 * RB < 128) RS_LD(bufA, d0 + 2 * RB);
        RS_CP(bufB, d0 + RB);
    }
#undef RS_LD
#undef RS_CP
    { int t3 = t256; asm volatile("" : "+v"(t3)); const int pr = t3 >> 2, i = pr >> 3, j = pr & 7, qd = t3 & 3; float s = 0.f;
      for (int d = qd * 64; d < qd * 64 + 64; ++d) s += qk[d * 16 + i] * qk[d * 16 + 8 + j];
      s += __shfl_xor(s, 1); s += __shfl_xor(s, 2);
      if (qd == 0) sc[i * 8 + j] = (j <= i) ? s * __builtin_amdgcn_exp2f(lg2 * (float)((i - j) - (7 - j))) : 0.f; }
    int t2 = t; asm volatile("" : "+v"(t2));
    if (dq == 1) {
#pragma unroll
        for (int i = 0; i < 8; ++i) red[i * 128 + t2] = acc[i]; }
    WG_SYNC();
    if (dq == 0) {
#pragma unroll
        for (int i = 0; i < 8; ++i) { f32x4 o = (acc[i] + red[i * 128 + t2]) * __builtin_amdgcn_exp2f(lg2 * (float)(i + 1));
#pragma unroll
            for (int j = 0; j <= i; ++j) { const float s = sc[i * 8 + j];
#pragma unroll
                for (int e = 0; e < 4; ++e) o[e] += s * v[j][e]; }
            u32x2 wv; wv.x = pk2(o[0], o[1]); wv.y = pk2(o[2], o[3]); *(u32x2*)(OR + (r0 + i) * 4096 + h * 512 + 4 * t2) = wv;
            float ssq = (o[0] * o[0] + o[1] * o[1]) + (o[2] * o[2] + o[3] * o[3]); ssq = wave_sum(ssq);
            if ((t2 & 63) == 0) atomicAdd(SS + (r0 + i) * 8 + h, (unsigned long long)__float2ll_rn(ssq * 16777216.0f)); } }
    WG_SYNC();
}
template <int NR>
__device__ __forceinline__ void ret_norm_rows(const Frame& F, const bf16* OR, const bf16* ZR, const unsigned long long* SS, bf16* YG) {
    const int gw = F.vcu * NWAVES + F.wave, NGW = F.G * NWAVES, lane = F.lane;
    for (int base = gw; base < M; base += NR * NGW) {
        u32x4 o[NR][8], g[NR][8];
#pragma unroll
        for (int r = 0; r < NR; ++r) { const int row = base + r * NGW, rw = row < M ? row : base;
#pragma unroll
            for (int j = 0; j < 8; ++j) { const int col = (lane + 64 * j) * 8; o[r][j] = __builtin_nontemporal_load((const u32x4*)(OR + (size_t)rw * 4096 + col)); g[r][j] = __builtin_nontemporal_load((const u32x4*)(ZR + (size_t)rw * RET_IN + 8192 + col)); } }
#pragma unroll
        for (int r = 0; r < NR; ++r) { const int row = base + r * NGW; if (row >= M) break;
#pragma unroll
            for (int j = 0; j < 8; ++j) { const int col = (lane + 64 * j) * 8, h = col >> 9; const float rs = 1.0f / sqrtf((float)SS[(size_t)row * 8 + h] * (1.0f / (512.0f * 16777216.0f)) + EPS); u32x4 y;
#pragma unroll
                for (int e = 0; e < 4; ++e) y[e] = pk2(__uint_as_float(o[r][j][e] << 16) * rs * __uint_as_float(g[r][j][e] << 16), __uint_as_float(o[r][j][e] & 0xffff0000u) * rs * __uint_as_float(g[r][j][e] & 0xffff0000u));
                *(u32x4*)(YG + (size_t)row * 4096 + col) = y; } }
    }
}
constexpr size_t MiB = 1u << 20;
constexpr size_t WS_CTL = 0, CTL_ZERO_BYTES = 32 * 1024;
constexpr size_t CTL_QUEUE = 1024, CTL_TQ = 2048, CTL_ZVSTAT = 256 * 1024, CTL_SS = 512 * 1024, CTL_BAR = 8 * 1024;
constexpr size_t WS_ROPE_A = 2 * MiB, WS_ROPE_R = 3 * MiB;
constexpr size_t WS_WT = 8 * MiB;
constexpr size_t WT_ABIN = WS_WT, WT_ABOUT = WT_ABIN + 14 * MiB, WT_RETIN = WT_ABOUT + 8 * MiB, WT_RETOUT = WT_RETIN + 48 * MiB, WT_MEMQ = WT_RETOUT + 16 * MiB,
                 WT_MEMKV = WT_MEMQ + 4 * MiB, WT_MEMO = WT_MEMKV + 8 * MiB, WT_UP = WT_MEMO + 4 * MiB, WT_DOWN = WT_UP + 64 * MiB, WT_END = WT_DOWN + 64 * MiB;
constexpr size_t WS_H = 240 * MiB, WS_Y0 = 276 * MiB, WS_Y1 = 348 * MiB, WS_BIG = 420 * MiB, WS_CAT = 636 * MiB, WS_OR = 708 * MiB, WS_QM = 780 * MiB, WS_OM = 789 * MiB, WS_HM = 798 * MiB, WS_MKV = 802 * MiB, WS_XB = 804 * MiB, WS_RS = 840 * MiB, WS_WTD = 842 * MiB, WS_QM2 = 912 * MiB, WS_END = 922 * MiB;
static_assert((WS_QM2 - WS_QM) / 2 == QSEG, "q partial distance");
static_assert(WT_END <= WS_H, "weights fit");
constexpr size_t BIG_Q = 0, BIG_K = 18 * MiB, BIG_V = BIG_K + 9216 * 256 * 2, BIG_ZU = 27 * MiB, BIG_ZV = 45 * MiB;
constexpr size_t O_X = 0, O_SKP = 18874368, O_SVP = 18939904, O_SKS = 19005440, O_SVS = 23199744, O_GV = 27394048, O_RP = 28442624, O_RS = 30539776, O_MK = 164757504, O_MV = 165281792, O_END = 165806080;
constexpr int LDFF = FF + 64;
constexpr int LDS_BYTES = 147456, MISC_OFF = LDS_BYTES - 512;

#define XB_TMO      128
#define XB_XCNT(j)  (256  + 64 * (j))
#define XB_XSUB(j)  (1280 + 64 * (j))
#define XB_XGEN(j)  (2304 + 64 * (j))
#define XB_TOP      3328
#define XB_TOPGEN   3392
#define XCD_BAR_WORDS 3456
#define XB_SPIN_CAP (1u << 18)

__device__ __forceinline__ unsigned xb_ld(unsigned* p)              { return __hip_atomic_load(p, __ATOMIC_RELAXED, __HIP_MEMORY_SCOPE_AGENT); }
__device__ __forceinline__ unsigned xb_add(unsigned* p, unsigned v) { return __hip_atomic_fetch_add(p, v, __ATOMIC_RELAXED, __HIP_MEMORY_SCOPE_AGENT); }
__device__ __forceinline__ unsigned xb_xcc_id() { return (unsigned)__builtin_amdgcn_s_getreg((3 << 11) | 20) & 0xFu; }
#define XB_SPIN(cond, bar) do { unsigned _sp = 0; while (cond) { __builtin_amdgcn_s_sleep(1); \
    if ((++_sp & 255u) == 0u) { if (xb_ld(&(bar)[XB_TMO])) break; if (_sp > XB_SPIN_CAP) { atomicAdd(&(bar)[XB_TMO], 1u); break; } } } } while (0)

struct XcdBarrier {
    unsigned* bar; unsigned x;
    volatile LAS unsigned* st;
};

__device__ __forceinline__ XcdBarrier xcd_barrier_post(unsigned* bar, volatile LAS unsigned* st) {
    XcdBarrier b; b.bar = bar; b.x = xb_xcc_id(); b.st = st;
    if (threadIdx.x == 0) (void)xb_add(&bar[XB_XCNT(b.x)], 1u);
    return b;
}
__device__ __forceinline__ void xcd_barrier_complete(unsigned* bar, unsigned x, unsigned& nloc, unsigned& nx) {
    const unsigned G = gridDim.x * gridDim.y * gridDim.z;
    unsigned sum, cnt, mine, sp = 0u;
    for (;;) {
        sum = 0u; cnt = 0u; mine = 0u;
#pragma unroll
        for (unsigned j = 0; j < 16; ++j) { const unsigned c = xb_ld(&bar[XB_XCNT(j)]); sum += c; cnt += (c > 0u) ? 1u : 0u; mine = (j == x) ? c : mine; }
        if (sum == G) break;
        __builtin_amdgcn_s_sleep(1);
        if ((++sp & 255u) == 0u) { if (xb_ld(&bar[XB_TMO])) break; if (sp > XB_SPIN_CAP) { atomicAdd(&bar[XB_TMO], 1u); break; } }
    }
    nloc = mine > 0u ? mine : 1u; nx = cnt > 0u ? cnt : 1u;
}

__device__ __forceinline__ void xcd_barrier(const XcdBarrier& b) {
    asm volatile("s_waitcnt vmcnt(0)" ::: "memory");
    __syncthreads();
    if (threadIdx.x == 0) {
        unsigned* bar = b.bar;
        __builtin_amdgcn_s_waitcnt(0);
        unsigned nloc = b.st[0], nx = b.st[1];
        if (nloc == 0u) { xcd_barrier_complete(bar, b.x, nloc, nx); b.st[0] = nloc; b.st[1] = nx; }
        const unsigned old = xb_add(&bar[XB_XSUB(b.x)], 1u);
        const unsigned gen = old / nloc;
        if (old + 1u == (gen + 1u) * nloc) {
            __builtin_amdgcn_fence(__ATOMIC_RELEASE, "agent");
            asm volatile("s_waitcnt vmcnt(0)" ::: "memory");
            const unsigned og = xb_add(&bar[XB_TOP], 1u);
            const unsigned tg = og / nx;
            if (og + 1u == (tg + 1u) * nx) xb_add(&bar[XB_TOPGEN], 1u);
            else XB_SPIN(xb_ld(&bar[XB_TOPGEN]) == tg, bar);
            __builtin_amdgcn_fence(__ATOMIC_ACQUIRE, "agent");
            xb_add(&bar[XB_XGEN(b.x)], 1u);
            asm volatile("s_waitcnt vmcnt(0)" ::: "memory");
        } else {
            XB_SPIN(xb_ld(&bar[XB_XGEN(b.x)]) == gen, bar);
            __builtin_amdgcn_fence(__ATOMIC_ACQUIRE, "agent");
            asm volatile("s_waitcnt vmcnt(0)" ::: "memory");
        }
    }
    __syncthreads();
}

struct Args {
    const float *x_prompt, *x_sample, *cache_swa_k, *cache_swa_v, *state_ret, *cache_mem_k, *cache_mem_v, *mem_prompt;
    const float *norm_mix_pre, *norm_mix_post, *norm_mem, *norm_x_pre, *norm_x_post, *norm_ffn_pre, *norm_ffn_post;
    const float *w_ab_in, *w_ab_out, *swa_sinks, *gmlp_ln_g, *gmlp_ln_b, *gmlp_w_s, *gmlp_b_s, *w_ret_in, *w_ret_out, *w_mem_q, *w_mem_k, *w_mem_v, *w_mem_o, *w_ffn_up, *w_ffn_down;
    float* out; unsigned char* ws; int ph_lo, ph_hi, li, pad;
};
#ifndef PHASE_MASK
#define PHASE_MASK 0xFFFFFFFFu
#endif
#define EN(b) (((PHASE_MASK) >> (b)) & 1u)
#ifndef DUPMASK
#define DUPMASK 0u
#endif
#define REPS(b) ((((DUPMASK) >> (b)) & 1u) ? 2 : 1)
#define DUMMY(ptr_t, p_) (dup_ ? (ptr_t)(ws + WS_END + 64 * MiB) : (p_))
constexpr int N_PHASES = 25;

#define CAS __attribute__((address_space(4)))
#define KARGS ((const CAS Args*)__builtin_amdgcn_kernarg_segment_ptr())
#define ARG(f) (*(const float* const volatile CAS*)&(KARGS->f))
#define ARGI(f) (*(const int volatile CAS*)&(KARGS->f))
#define ARG_OUT() (*(float* const volatile CAS*)&(KARGS->out))
#define ARG_WS() (*(unsigned char* const volatile CAS*)&(KARGS->ws))
__global__ void __launch_bounds__(NTHR, 2) fwd(Args a_unused) {
    extern __shared__ __attribute__((aligned(16))) unsigned char lds_raw[];
    Frame F0; F0.lds = (LAS unsigned char*)lds_raw; F0.tid = threadIdx.x; F0.lane = F0.tid & 63; F0.wave = __builtin_amdgcn_readfirstlane(F0.tid >> 6);
    F0.G = gridDim.x; { const int bx = blockIdx.x; F0.vcu = (F0.G % 8 == 0) ? (bx % 8) * (F0.G / 8) + bx / 8 : bx; }
    volatile LAS unsigned* MISC = (volatile LAS unsigned*)(F0.lds + MISC_OFF);
    if (F0.tid < 128) MISC[F0.tid] = 0u;
    __syncthreads();
    const XcdBarrier bar = xcd_barrier_post((unsigned*)(ARG_WS() + WS_CTL + CTL_BAR) + ARGI(li) * XCD_BAR_WORDS, MISC + 8);
    const int lo = ARGI(ph_lo), hi = ARGI(ph_hi);
#define IN(k) (lo <= (k) && (k) < hi)
#define SEAM(k) do { if (IN(k) && IN((k) + 1)) xcd_barrier(bar); } while (0)
#define GW (F.vcu * NWAVES + F.wave)
#define NGW (F.G * NWAVES)
#define IDLE_TJOB(c0_, Wp, WTp, K_, N_, Gp, LDW) do { if ((int)blockIdx.x >= (c0_)) { const int nit_ = ((K_) / 64) * ((N_) / 64), nw_ = ((int)F.G - (c0_)) * NWAVES; const float* W_ = (Wp); bf16* WT_ = (bf16*)(WTp); \
        LAS float* scr_ = (LAS float*)(F.lds + F.wave * 16640); transpose_strided(W_, K_, N_, WT_, scr_, ((int)blockIdx.x - (c0_)) * NWAVES + F.wave, nw_, nit_, F.lane, (Gp), (LDW)); } } while (0)
#define PHASE_FRAME Frame P = F0; asm volatile("" : "+v"(P.tid), "+s"(P.wave), "+s"(P.vcu), "+s"(P.G)); P.lane = P.tid & 63

    if (EN(0) && IN(0)) { for (int rep_ = 0; rep_ < REPS(0); ++rep_) { PHASE_FRAME; const Frame& F = P; const bool dup_ = (rep_ != 0); (void)dup_; if (dup_) __syncthreads();
        unsigned char* ws = ARG_WS();
        LAS float* scr = (LAS float*)(F.lds + F.wave * 16640);
        const int gw = GW, ngw = NGW;
        { u32x4* z1 = (u32x4*)(ws + WS_CTL + CTL_ZVSTAT); u32x4* z2 = (u32x4*)(ws + WS_CTL + CTL_SS);
          for (int x = F.vcu * NTHR + F.tid; x < M * 2 * 8 / 16; x += F.G * NTHR) z1[x] = (u32x4){0u, 0u, 0u, 0u};
          for (int x = F.vcu * NTHR + F.tid; x < M * 8 * 8 / 16; x += F.G * NTHR) z2[x] = (u32x4){0u, 0u, 0u, 0u}; }
        int base = 0;
#define TJOB(Wp, WTp, K_, N_, Gp) do { const int nit = ((K_) / 64) * ((N_) / 64); int it = gw - (base % ngw); if (it < 0) it += ngw; const float* W_ = (Wp); bf16* WT_ = (bf16*)(WTp); \
            const float* G_ = (Gp); transpose_strided(W_, K_, N_, WT_, scr, it, ngw, nit, F.lane, G_, 0); base += nit; } while (0)
        TJOB(ARG(w_ab_in), ws + WT_ABIN, D, AB_IN, ARG(norm_mix_pre));
        TJOB(ARG(w_ab_out), ws + WT_ABOUT, D, D, (const float*)nullptr);
#pragma unroll 1
        for (int l = 0; l < 2; ++l) {
            TJOB(ARG(w_mem_q) + (size_t)l * D * MEMW, ws + WT_MEMQ + (size_t)l * MEMW * D * 2, D, MEMW, ARG(norm_x_pre) + (size_t)l * D);
            TJOB(ARG(w_mem_k) + (size_t)l * D * MEMW, ws + WT_MEMKV + (size_t)(2 * l) * MEMW * D * 2, D, MEMW, (const float*)nullptr);
            TJOB(ARG(w_mem_v) + (size_t)l * D * MEMW, ws + WT_MEMKV + (size_t)(2 * l + 1) * MEMW * D * 2, D, MEMW, (const float*)nullptr);
            TJOB(ARG(w_mem_o) + (size_t)l * MEMW * D, ws + WT_MEMO + (size_t)l * D * MEMW * 2, MEMW, D, (const float*)nullptr);
        }
#undef TJOB
        norm_rows<false, 4>(F, ARG(x_prompt), ARG(x_sample), nullptr, nullptr, nullptr, 0, nullptr, (float*)(ws + WS_RS), nullptr, (bf16*)(ws + WS_XB));
        { const float* memp = ARG(mem_prompt); const float* nmem = ARG(norm_mem); bf16* HM = (bf16*)(ws + WS_HM);
        for (int r2 = gw; r2 < 1024; r2 += ngw) { const int l = r2 >> 9, row = r2 & 511; const float* xr = memp + (size_t)row * D; const float* g = nmem + (size_t)l * D;
            f32x4 xv[8]; float ss = 0.f;
#pragma unroll
            for (int j = 0; j < 8; ++j) { xv[j] = ((const f32x4*)xr)[F.lane + 64 * j]; ss += (xv[j][0] * xv[j][0] + xv[j][1] * xv[j][1]) + (xv[j][2] * xv[j][2] + xv[j][3] * xv[j][3]); }
            const float rs = 1.0f / sqrtf(wave_sum(ss) * (1.0f / D) + EPS);
#pragma unroll
            for (int j = 0; j < 8; ++j) { const f32x4 gg = ((const f32x4*)g)[F.lane + 64 * j]; const f32x4 h = xv[j] * rs * gg; u32x2 w; w.x = pk2(h[0], h[1]); w.y = pk2(h[2], h[3]);
                ((u32x2*)(HM + (size_t)r2 * D))[F.lane + 64 * j] = w; } } }
    } }
    SEAM(0);

#pragma unroll 1
    for (int layer = 0; layer < 2; ++layer) {
        const int pb = 1 + 12 * layer;
        if (layer == 0) {
            if (EN(1) && IN(pb + 0)) { for (int rep_ = 0; rep_ < REPS(1); ++rep_) { PHASE_FRAME; const Frame& F = P; const bool dup_ = (rep_ != 0); (void)dup_; if (dup_) __syncthreads();
                unsigned char* ws = ARG_WS(); float* out = ARG_OUT(); bf16* BIG = (bf16*)(ws + WS_BIG);
                pg8::Gemm g{(const bf16*)(ws + WS_XB), (const bf16*)(ws + WT_ABIN), M, AB_IN, D}; pg8::StaticOrder S; S.init(M, AB_IN, D, F.G, (int)blockIdx.x);
                pg8::EpiAbIn E{BIG, out, (const float*)(ws + WS_RS), DUMMY(unsigned long long*, (unsigned long long*)(ws + WS_CTL + CTL_ZVSTAT))};
                static_assert(pg8::EpiAbIn::OK == BIG_K / 2 && pg8::EpiAbIn::OV == BIG_V / 2 && pg8::EpiAbIn::OZU == BIG_ZU / 2 && pg8::EpiAbIn::OZV == BIG_ZV / 2 && pg8::EpiAbIn::OKP == O_SKP && pg8::EpiAbIn::OVS == O_SVS, "maps");
                pg8::gemm_phase<pg8::EpiAbIn, pg8::StaticOrder, true, true>(F.lds, g, S, E);
            } }
            SEAM(pb + 0);
            if (IN(pb + 1)) {
                const bool sample_first = ((blockIdx.x >> 3) & 1) != 0;
#pragma unroll 1
                for (int step = 0; step < 2; ++step) {
                  if ((step == 0) != sample_first) {
                if (EN(2)) { for (int rep_ = 0; rep_ < REPS(2); ++rep_) { PHASE_FRAME; const Frame& F = P; const bool dup_ = (rep_ != 0); (void)dup_; if (dup_) __syncthreads();     unsigned char* ws = ARG_WS(); const bf16* BIG = (const bf16*)(ws + WS_BIG); const float* sinks = ARG(swa_sinks);
                    for (int u = F.vcu; u < 256; u += F.G) swa_prompt_unit(F, u >> 7, (u >> 2) & 31, u & 3, BIG + BIG_Q / 2, BIG + BIG_K / 2, BIG + BIG_V / 2, sinks, (bf16*)(ws + WS_CAT)); } }
                if (EN(3)) { for (int rep_ = 0; rep_ < REPS(3); ++rep_) { PHASE_FRAME; const Frame& F = P; const bool dup_ = (rep_ != 0); (void)dup_; if (dup_) __syncthreads();     unsigned char* ws = ARG_WS(); const bf16* BIG = (const bf16*)(ws + WS_BIG);
                    const float *lng = ARG(gmlp_ln_g), *lnb = ARG(gmlp_ln_b), *wsp = ARG(gmlp_w_s), *bsp = ARG(gmlp_b_s);
                    for (int u = F.vcu; u < 256; u += F.G) gate_prompt_unit(F, u >> 7, (u >> 2) & 31, u & 3, BIG + BIG_ZU / 2, BIG + BIG_ZV / 2, (const long long*)(ws + WS_CTL + CTL_ZVSTAT), lng, lnb, wsp, bsp, (bf16*)(ws + WS_CAT)); } }
                  } else {
                if (EN(4)) { for (int rep_ = 0; rep_ < REPS(4); ++rep_) { PHASE_FRAME; const Frame& F = P; const bool dup_ = (rep_ != 0); (void)dup_; if (dup_) __syncthreads();     unsigned char* ws = ARG_WS(); float* out = ARG_OUT(); const bf16* BIG = (const bf16*)(ws + WS_BIG); const float *ck = ARG(cache_swa_k), *cv = ARG(cache_swa_v), *sinks = ARG(swa_sinks);
                    for (int u = F.vcu; u < 256; u += F.G) swa_sample_unit(F, u >> 1, u & 1, BIG + BIG_Q / 2, BIG + BIG_K / 2, BIG + BIG_V / 2, ck, cv, sinks, (bf16*)(ws + WS_CAT), out + O_SKS, out + O_SVS); } }
                if (EN(5)) { for (int rep_ = 0; rep_ < REPS(5); ++rep_) { PHASE_FRAME; const Frame& F = P; const bool dup_ = (rep_ != 0); (void)dup_; if (dup_) __syncthreads();     unsigned char* ws = ARG_WS(); float* out = ARG_OUT(); const bf16* BIG = (const bf16*)(ws + WS_BIG);
                    const float *lng = ARG(gmlp_ln_g), *lnb = ARG(gmlp_ln_b), *wsp = ARG(gmlp_w_s), *bsp = ARG(gmlp_b_s);
                    for (int u = F.vcu; u < 128; u += F.G) gate_sample_unit(F, u, BIG + BIG_ZU / 2, BIG + BIG_ZV / 2, (const long long*)(ws + WS_CTL + CTL_ZVSTAT), lng, lnb, wsp, bsp, (bf16*)(ws + WS_CAT), out + O_GV); } }
                  }
                }
            }
            SEAM(pb + 1);
            if (EN(6) && IN(pb + 3)) { for (int rep_ = 0; rep_ < REPS(6); ++rep_) { PHASE_FRAME; const Frame& F = P; const bool dup_ = (rep_ != 0); (void)dup_; if (dup_) __syncthreads();
                unsigned char* ws = ARG_WS();
                pg8::Gemm g{(const bf16*)(ws + WS_CAT), (const bf16*)(ws + WT_ABOUT), M, D, D}; pg8::PanelK S; S.init(D, F.G, F.vcu);
                pg8::EpiPart E{(bf16*)(ws + WS_Y0), (bf16*)(ws + WS_Y1)};
                pg8::gemm_phase<pg8::EpiPart, pg8::PanelK, true, true>(F.lds, g, S, E);
            } }
        } else {
            if (EN(7) && IN(pb + 0)) { for (int rep_ = 0; rep_ < REPS(7); ++rep_) { PHASE_FRAME; const Frame& F = P; const bool dup_ = (rep_ != 0); (void)dup_; if (dup_) __syncthreads();
                unsigned char* ws = ARG_WS();
                pg8::Gemm g{(const bf16*)(ws + WS_XB), (const bf16*)(ws + WT_RETIN), M, RET_IN, D}; pg8::StaticOrder S; S.init(M, RET_IN, D, F.G, (int)blockIdx.x);
                pg8::EpiRetIn E{(bf16*)(ws + WS_BIG), (const float*)(ws + WS_RS)};
                pg8::gemm_phase<pg8::EpiRetIn, pg8::StaticOrder, true, true>(F.lds, g, S, E);
            } }
            SEAM(pb + 0);
            if (IN(pb + 1)) {
                const int bx = blockIdx.x; const bool halves = (F0.G % 16 == 0);
                const int role = halves ? ((bx >> 3) & 1) : 0, rank = halves ? ((bx & 7) + 8 * (bx >> 4)) : bx, nrole0 = halves ? F0.G / 2 : F0.G;
                if (EN(9) && role == 0) { for (int rep_ = 0; rep_ < REPS(9); ++rep_) { PHASE_FRAME; const Frame& F = P; const bool dup_ = (rep_ != 0); (void)dup_; if (dup_) __syncthreads();     unsigned char* ws = ARG_WS(); float* out = ARG_OUT();
                    for (int u = rank; u < 128; u += nrole0) ret_prompt_scan(F, u >> 6, (u >> 3) & 7, u & 7, (const bf16*)(ws + WS_BIG), (bf16*)(ws + WS_OR), DUMMY(unsigned long long*, (unsigned long long*)(ws + WS_CTL + CTL_SS)), out + O_RP); } }
                if (EN(8)) { for (int rep_ = 0; rep_ < REPS(8); ++rep_) { PHASE_FRAME; const Frame& F = P; const bool dup_ = (rep_ != 0); (void)dup_; if (dup_) __syncthreads();     unsigned char* ws = ARG_WS(); float* out = ARG_OUT(); const float* st = ARG(state_ret);
                    unsigned* qctr = (unsigned*)(ws + WS_CTL + CTL_QUEUE) + (dup_ ? 64 : 0); volatile LAS unsigned* qw = (volatile LAS unsigned*)(F.lds + MISC_OFF + 64);
                    for (;;) {
                        if (F.tid == 0) qw[0] = atomicAdd(qctr, 1u);
                        __syncthreads();
                        const unsigned pss = (unsigned)__builtin_amdgcn_readfirstlane((int)qw[0]);
                        __syncthreads();
                        if (pss >= 512u) break;
                        ret_sample_pass(F, (int)pss * 2, (const bf16*)(ws + WS_BIG), st, out + O_RS, (bf16*)(ws + WS_OR), DUMMY(unsigned long long*, (unsigned long long*)(ws + WS_CTL + CTL_SS))); } } }
            }
            SEAM(pb + 1);
            if (EN(10) && IN(pb + 2)) { for (int rep_ = 0; rep_ < REPS(10); ++rep_) { PHASE_FRAME; const Frame& F = P; const bool dup_ = (rep_ != 0); (void)dup_; if (dup_) __syncthreads();     unsigned char* ws = ARG_WS(); ret_norm_rows<3>(F, (const bf16*)(ws + WS_OR), (const bf16*)(ws + WS_BIG), (const unsigned long long*)(ws + WS_CTL + CTL_SS), (bf16*)(ws + WS_CAT)); } }
            SEAM(pb + 2);
            if (EN(11) && IN(pb + 3)) { for (int rep_ = 0; rep_ < REPS(11); ++rep_) { PHASE_FRAME; const Frame& F = P; const bool dup_ = (rep_ != 0); (void)dup_; if (dup_) __syncthreads();
                unsigned char* ws = ARG_WS();
                pg8::Gemm g{(const bf16*)(ws + WS_CAT), (const bf16*)(ws + WT_RETOUT), M, D, 4096}; pg8::PanelK S; S.init(4096, F.G, F.vcu);
                pg8::EpiPart E{(bf16*)(ws + WS_Y0), (bf16*)(ws + WS_Y1)};
                pg8::gemm_phase<pg8::EpiPart, pg8::PanelK, true, true>(F.lds, g, S, E);
            } }
        }
        SEAM(pb + 3);
        if (EN(12) && IN(pb + 4)) { for (int rep_ = 0; rep_ < REPS(12); ++rep_) { PHASE_FRAME; const Frame& F = P; const bool dup_ = (rep_ != 0); (void)dup_; if (dup_) __syncthreads();
            unsigned char* ws = ARG_WS(); float* X = ARG_OUT() + O_X;
            pg8::PanelK S; S.init(layer == 0 ? D : 4096, F.G, 0);
            bf16* XB = (bf16*)(ws + WS_XB); (void)X;
            norm_rows<true, 4>(F, nullptr, nullptr, XB, (const bf16*)(ws + WS_Y0), (const bf16*)(ws + WS_Y1), S.splits, ARG(norm_mix_post) + (size_t)layer * D, DUMMY(float*, (float*)(ws + WS_RS)), nullptr, DUMMY(bf16*, XB));
        } }
        SEAM(pb + 4);
        if (IN(pb + 5)) {
            if (EN(13)) { for (int rep_ = 0; rep_ < REPS(13); ++rep_) { PHASE_FRAME; const Frame& F = P; const bool dup_ = (rep_ != 0); (void)dup_; if (dup_) __syncthreads();     unsigned char* ws = ARG_WS();
              pg8::Gemm g{(const bf16*)(ws + WS_XB), (const bf16*)(ws + WT_MEMQ) + (size_t)layer * MEMW * D, M, MEMW, D}; pg8::SplitK2 S; S.init(D, F.G, (int)blockIdx.x);
              pg8::EpiBf16<0> E{(bf16*)(ws + WS_QM), MEMW, (const float*)(ws + WS_RS), QSEG};
              pg8::gemm_phase<pg8::EpiBf16<0>, pg8::SplitK2, true, true>(F.lds, g, S, E); } }
            if (EN(14) && layer == 0) { for (int rep_ = 0; rep_ < REPS(14); ++rep_) { PHASE_FRAME; const Frame& F = P; const bool dup_ = (rep_ != 0); (void)dup_; if (dup_) __syncthreads();     unsigned char* ws = ARG_WS(); float* out = ARG_OUT();
                pg8::Gemm g{(const bf16*)(ws + WS_HM), (const bf16*)(ws + WT_MEMKV), 1024, 2048, D}; pg8::MemKVOrder S{F.G, (int)((blockIdx.x + F.G - (144 % F.G)) % F.G)};
                pg8::EpiMemKV E{out + O_MK, out + O_MV, (bf16*)(ws + WS_MKV)};
                pg8::gemm_phase<pg8::EpiMemKV, pg8::MemKVOrder, true, true>(F.lds, g, S, E);
            } }
            if (EN(22)) { for (int rep_ = 0; rep_ < REPS(22); ++rep_) { PHASE_FRAME; const Frame& F = P; const bool dup_ = (rep_ != 0); if (dup_) __syncthreads(); unsigned char* ws = ARG_WS();
                unsigned* tq = (unsigned*)(ws + WS_CTL + CTL_TQ) + layer * 64 + (dup_ ? 128 : 0); LAS float* scr = (LAS float*)(F.lds + F.wave * 16640);
                const int n_up = (D / 64) * (FF / 64), n_dn = (layer == 0) ? n_up : 0, n_ro = (layer == 0) ? (4096 / 64) * (D / 64) : 0, n_all = n_up + n_dn + n_ro;
                const float* w_up = ARG(w_ffn_up) + (size_t)layer * D * FF; const float* w_dn = ARG(w_ffn_down) + (size_t)layer * FF * D; const float* w_ro = ARG(w_ret_out); const float* g_up = ARG(norm_ffn_pre) + (size_t)layer * D;
                volatile LAS unsigned* tqw = (volatile LAS unsigned*)(F.lds + MISC_OFF + 96);
#define TQ_RUN(qi, Wp, K_, N_, WTp, Gp, LDW, NIT) do { const int nit_ = (NIT); const float* W_ = (Wp); bf16* WT_ = (bf16*)(WTp); const float* G_ = (Gp); \
                    for (;;) { if (F.tid == 0) tqw[0] = atomicAdd(tq + (qi) * 16, 64u); __syncthreads(); const int base = __builtin_amdgcn_readfirstlane((int)tqw[0]); __syncthreads(); if (base >= nit_) break; \
                        transpose_strided(W_, K_, N_, WT_, scr, base + F.wave, 8, (base + 64 < nit_) ? base + 64 : nit_, F.lane, G_, (LDW)); } } while (0)
                TQ_RUN(0, w_up, D, FF, ws + WT_UP + (size_t)layer * FF * D * 2, g_up, 0, n_up);
                if (layer == 0) { TQ_RUN(1, w_dn, FF, D, ws + WS_WTD, (const float*)nullptr, LDFF, n_dn); TQ_RUN(2, w_ro, 4096, D, ws + WT_RETOUT, (const float*)nullptr, 0, n_ro); }
#undef TQ_RUN
                (void)n_all; } }
        }
        SEAM(pb + 5);
        if (IN(pb + 6)) {
            { const bool sample_first = ((blockIdx.x >> 3) & 1) != 0;
#pragma unroll 1
              for (int step = 0; step < 2; ++step) {
                  if ((step == 0) != sample_first) { if (EN(15)) { PHASE_FRAME; const Frame& F = P; unsigned char* ws = ARG_WS();
                      for (int u = F.vcu; u < 256; u += F.G) mem_prompt_unit(F, u >> 7, (u >> 5) & 3, u & 31, (const bf16*)(ws + WS_QM), (const bf16*)(ws + WS_MKV) + (size_t)layer * 512 * 1024, (bf16*)(ws + WS_OM)); } }
                  else { if (EN(16)) { PHASE_FRAME; const Frame& F = P; unsigned char* ws = ARG_WS(); const float* ck = ARG(cache_mem_k) + (size_t)layer * NS * 256 * 512; const float* cv = ARG(cache_mem_v) + (size_t)layer * NS * 256 * 512;
                      mem_sample_units(F, F.vcu, F.G, (const bf16*)(ws + WS_QM), ck, cv, (bf16*)(ws + WS_OM)); } } } }
        }
        SEAM(pb + 6);
        if (EN(17) && IN(pb + 7)) { for (int rep_ = 0; rep_ < REPS(17); ++rep_) { PHASE_FRAME; const Frame& F = P; const bool dup_ = (rep_ != 0); (void)dup_; if (dup_) __syncthreads();
            unsigned char* ws = ARG_WS();
            pg8::Gemm g{(const bf16*)(ws + WS_OM), (const bf16*)(ws + WT_MEMO) + (size_t)layer * D * MEMW, M, D, MEMW}; pg8::PanelK S; S.init(MEMW, F.G, F.vcu);
            pg8::EpiPart E{(bf16*)(ws + WS_Y0), (bf16*)(ws + WS_Y1)};
            pg8::gemm_phase<pg8::EpiPart, pg8::PanelK, true, true>(F.lds, g, S, E);
        } }
        SEAM(pb + 7);
        if (EN(18) && IN(pb + 8)) { for (int rep_ = 0; rep_ < REPS(18); ++rep_) { PHASE_FRAME; const Frame& F = P; const bool dup_ = (rep_ != 0); (void)dup_; if (dup_) __syncthreads();     unsigned char* ws = ARG_WS(); float* X = ARG_OUT() + O_X;
            bf16* XB = (bf16*)(ws + WS_XB); (void)X;
            norm_rows<true, 4>(F, nullptr, nullptr, XB, (const bf16*)(ws + WS_Y0), (const bf16*)(ws + WS_Y1), 4, ARG(norm_x_post) + (size_t)layer * D, DUMMY(float*, (float*)(ws + WS_RS)), nullptr, DUMMY(bf16*, XB)); } }
        SEAM(pb + 8);
        if (EN(19) && IN(pb + 9)) { for (int rep_ = 0; rep_ < REPS(19); ++rep_) { PHASE_FRAME; const Frame& F = P; const bool dup_ = (rep_ != 0); (void)dup_; if (dup_) __syncthreads();
            unsigned char* ws = ARG_WS();
            pg8::Gemm g{(const bf16*)(ws + WS_XB), (const bf16*)(ws + WT_UP) + (size_t)layer * FF * D, M, FF, D}; pg8::StaticOrder S; S.init(M, FF, D, F.G, (int)blockIdx.x);
            pg8::EpiBf16<2> E{(bf16*)(ws + WS_BIG), LDFF, (const float*)(ws + WS_RS)};
            pg8::gemm_phase<pg8::EpiBf16<2>, pg8::StaticOrder, true, true>(F.lds, g, S, E);
            { const int c0 = (F.G > 128) ? 128 : 0;
              if (layer == 0) IDLE_TJOB(c0, ARG(w_ret_in), ws + WT_RETIN, D, RET_IN, ARG(norm_mix_pre) + D, 0);
              else IDLE_TJOB(c0, ARG(w_ffn_down) + (size_t)FF * D, ws + WS_WTD + (size_t)D * LDFF * 2, FF, D, (const float*)nullptr, LDFF); }
        } }
        SEAM(pb + 9);
        if (EN(20) && IN(pb + 10)) { for (int rep_ = 0; rep_ < REPS(20); ++rep_) { PHASE_FRAME; const Frame& F = P; const bool dup_ = (rep_ != 0); (void)dup_; if (dup_) __syncthreads();
            unsigned char* ws = ARG_WS();
            pg8::Gemm g{(const bf16*)(ws + WS_BIG), (const bf16*)(ws + WS_WTD) + (size_t)layer * D * LDFF, M, D, FF, LDFF, LDFF}; pg8::PanelK S; S.init(FF, F.G, F.vcu);
            pg8::EpiPart E{(bf16*)(ws + WS_Y0), (bf16*)(ws + WS_Y1)};
            pg8::gemm_phase<pg8::EpiPart, pg8::PanelK, true, true>(F.lds, g, S, E);
        } }
        SEAM(pb + 10);
        if (EN(21) && IN(pb + 11)) { for (int rep_ = 0; rep_ < REPS(21); ++rep_) { PHASE_FRAME; const Frame& F = P; const bool dup_ = (rep_ != 0); (void)dup_; if (dup_) __syncthreads();     unsigned char* ws = ARG_WS(); float* X = ARG_OUT() + O_X;
            pg8::PanelK S; S.init(FF, F.G, 0);
            bf16* XB = (bf16*)(ws + WS_XB);
            norm_rows<true, 4>(F, nullptr, nullptr, XB, (const bf16*)(ws + WS_Y0), (const bf16*)(ws + WS_Y1), S.splits, ARG(norm_ffn_post) + (size_t)layer * D, layer == 0 ? DUMMY(float*, (float*)(ws + WS_RS)) : (float*)nullptr,
                            layer == 0 ? (float*)nullptr : DUMMY(float*, X), layer == 0 ? DUMMY(bf16*, XB) : (bf16*)nullptr); } }
        if (layer == 0) SEAM(pb + 11);
    }
#undef IN
#undef SEAM
}

#ifndef MK_N_LAUNCHES
#define MK_N_LAUNCHES 1
#endif
extern "C" void kernel_launch(void* const* d_in, const int* in_sizes, int n_in, void* d_out, int out_size, void* d_ws, size_t ws_size, hipStream_t stream) {
    static int grid = 0;
    if (grid == 0) {
        if (n_in != 30 || out_size != (int)O_END || ws_size < WS_END) { fprintf(stderr, "kernel_launch: unexpected shapes (n_in %d, out %d, ws %zu)\n", n_in, out_size, ws_size); grid = -1; return; }
        int dev = 0, cus = 0, per_cu = 0;
        if (hipGetDevice(&dev) != hipSuccess || hipDeviceGetAttribute(&cus, hipDeviceAttributeMultiprocessorCount, dev) != hipSuccess) { grid = -1; return; }
        if (hipFuncSetAttribute((const void*)fwd, hipFuncAttributeMaxDynamicSharedMemorySize, LDS_BYTES) != hipSuccess) { fprintf(stderr, "kernel_launch: hipFuncSetAttribute failed\n"); grid = -1; return; }
        if (hipOccupancyMaxActiveBlocksPerMultiprocessor(&per_cu, (const void*)fwd, NTHR, LDS_BYTES) != hipSuccess || per_cu < 1) fprintf(stderr, "kernel_launch: occupancy query says %d\n", per_cu);
        (void)hipGetLastError();
        grid = cus;
    }
    if (grid < 0) return;
    (void)hipMemsetAsync((char*)d_ws + WS_CTL, 0, CTL_ZERO_BYTES, stream);
    Args a{};
    const float** p = (const float**)&a;
    for (int i = 0; i < 30; ++i) p[i] = (const float*)d_in[i];
    a.out = (float*)d_out; a.ws = (unsigned char*)d_ws; a.pad = 0;
    for (int li = 0; li < MK_N_LAUNCHES; ++li) {
        a.ph_lo = (MK_N_LAUNCHES == 1) ? 0 : li; a.ph_hi = (MK_N_LAUNCHES == 1) ? N_PHASES : li + 1; a.li = li;
        hipLaunchKernelGGL(fwd, dim3(grid), dim3(NTHR), LDS_BYTES, stream, a);
    }
}
```

```cpp
#include <hip/hip_runtime.h>
#include <cstdio>
#include <cstdint>

namespace pg8 {
#define PG8_LAS __attribute__((address_space(3)))
typedef unsigned short bf16_t;
typedef short bf16x8 __attribute__((ext_vector_type(8)));
typedef float f32x4 __attribute__((ext_vector_type(4)));
typedef unsigned u32x4 __attribute__((ext_vector_type(4)));
typedef unsigned u32x2 __attribute__((ext_vector_type(2)));
constexpr int BM = 256, BK = 64, HALF = 128, HTB = HALF * BK * 2  , STAGE_BYTES = 8 * HTB, NXCD = 8, WGM = 8;

__host__ __device__ __forceinline__ int lds_byte(int r, int c) { const int st = (r >> 4) * 2 + (c >> 5), rr = r & 15, cc = c & 31, ob = rr * 64 + cc * 2; return st * 1024 + (ob ^ (((ob >> 9) & 1) << 5)); }
__host__ __device__ __forceinline__ void stage_rc(int b, int& R, int& C) { const int st = b / 1024, sb = b % 1024, swz = sb ^ (((sb >> 9) & 1) << 5); R = (st >> 1) * 16 + swz / 64; C = (st & 1) * 32 + (swz % 64) / 2; }
__host__ __device__ __forceinline__ int perm32(int rho) { const int n = rho >> 4, i = rho & 15; return 8 * (i >> 2) + 4 * n + (i & 3); }

struct Unit { int pm, pn, kt0, nkt; };
struct Gemm { const bf16_t* A; const bf16_t* Bt; int M, N, K; int lda = 0, ldb = 0; };

struct StaticOrder {
    int nM, nN, nwg, G, c, nkt;
    __device__ void init(int M, int N, int K, int G_, int c_) { nM = M / BM; nN = N / BM; nwg = nM * nN; G = G_; c = c_; nkt = K / BK; }
    __device__ bool next(int i, Unit& u) const {
        const int L = i * G + c; if (L >= nwg) return false;
        int wgid = L; { const int q = nwg >> 3, r = nwg & 7, xcd = wgid & 7, off = wgid >> 3; wgid = (xcd < r ? xcd * (q + 1) : r * (q + 1) + (xcd - r) * q) + off; }
        const int nig = WGM * nN, gid = wgid / nig, rem = wgid - gid * nig, fm = gid * WGM; const bool full = (nM - fm) >= WGM;
        u.pm = fm + (full ? (rem & 7) : (rem & 3)); u.pn = full ? (rem >> 3) : (rem >> 2); u.kt0 = 0; u.nkt = nkt; return true;
    }
};
struct StreamK {
    int dpu, nN, w; long S, total;
    __device__ void init(int M, int N, int K, int G_, int w_) { dpu = K / (2 * BK); nN = N / BM; total = (long)(M / BM) * nN * dpu; S = (total + G_ - 1) / G_; w = w_; }
    __device__ bool next(int i, Unit& u) const {
        long pos = (long)w * S; long end = pos + S; if (end > total) end = total;
        for (int k = 0;; ++k) {
            if (pos >= end) return false;
            const int un = (int)(pos / dpu), off = (int)(pos % dpu); long len = dpu - off; if (len > end - pos) len = end - pos;
            if (k == i) { u.pm = un / nN; u.pn = un % nN; u.kt0 = 2 * off; u.nkt = 2 * (int)len; return true; }
            pos += len;
        }
    }
    __device__ static bool split(int pm, int pn, int nN_, int dpu_, long S_) { const long a = (long)(pm * nN_ + pn) * dpu_; return (a / S_) != ((a + dpu_ - 1) / S_); }
};

struct SplitK2 {
    int G, c, nkt;
    __device__ void init(int K, int G_, int c_) { G = G_; c = c_; nkt = K / BK; }
    __device__ bool next(int i, Unit& u) const { const int idx = i * G + c; if (idx >= 144) return false; const int un = idx >> 1; u.pm = un >> 1; u.pn = un & 1; u.kt0 = (idx & 1) * (nkt >> 1); u.nkt = nkt >> 1; return true; }
};
struct PanelK {
    int w, G, nkt, ls;
    int splits;
    __device__ void init(int K, int G_, int w_) { w = w_; G = G_; nkt = K / BK; ls = (nkt >= 16) ? 3 : 2; splits = 1 << ls; }
    __device__ bool next(int i, Unit& u) const {
        int np = 0; for (int x = w; x < 256; x += G) ++np;
        if (i < np) { const int un = w + i * G; u.pm = un >> 3; u.pn = un & 7; u.kt0 = 0; u.nkt = nkt; return true; }
        const int idx = w + (i - np) * G; if (idx >= (32 << ls)) return false;
        const int ns = nkt >> ls, seg = (idx >> 3) & (splits - 1);
        u.pm = 32 + (idx >> (3 + ls)); u.pn = idx & 7; u.kt0 = seg * ns; u.nkt = ns; return true;
    }
};

__device__ __forceinline__ unsigned cvt_pk_bf16(float lo, float hi) { unsigned r; asm volatile("v_cvt_pk_bf16_f32 %0, %1, %2" : "=v"(r) : "v"(lo), "v"(hi)); return r; }

constexpr int MROWS = 9216, NPROMPT = 8192, SEQ = 4096;
__device__ __forceinline__ float pos_of_row(int row) { return (float)(row < NPROMPT ? (row & (SEQ - 1)) : 8192 + ((row - NPROMPT) & 7)); }
__device__ __forceinline__ float rope_inv_turns(int i, float inv_half_log2theta) { return __builtin_amdgcn_exp2f(-(float)i * inv_half_log2theta) * 0.15915494309189535f; }
__device__ __forceinline__ void sincos_turns(float t, float& sn, float& cs) { const float f = __builtin_amdgcn_fractf(t); sn = __builtin_amdgcn_sinf(f); cs = __builtin_amdgcn_cosf(f); }
__device__ __forceinline__ float gelu_tanh(float x) {
    const float u = 0.7978845608028654f * (x + 0.044715f * x * x * x);
    return x * __builtin_amdgcn_rcpf(1.0f + __builtin_amdgcn_exp2f(-2.885390081777927f * u));
}
__device__ __forceinline__ float silu_f(float x) { return x * __builtin_amdgcn_rcpf(1.0f + __builtin_amdgcn_exp2f(-1.4426950408889634f * x)); }
__device__ __forceinline__ u32x4 pack8(const f32x4& a, const f32x4& b) { u32x4 w; w.x = cvt_pk_bf16(a[0], a[1]); w.y = cvt_pk_bf16(a[2], a[3]); w.z = cvt_pk_bf16(b[0], b[1]); w.w = cvt_pk_bf16(b[2], b[3]); return w; }

struct EpiPart {
    static constexpr bool PERM = true, AFTER_DRAIN = false;
    bf16_t* Y; bf16_t* P;
    __device__ __forceinline__ void operator()(const f32x4 (&acc)[2][2][4][2], const Unit& u, int wr, int wc, int fr, int fq) const {
        bf16_t* base = (u.pm < 32) ? Y + (size_t)u.pm * BM * 2048 : P + ((size_t)(u.kt0 >> __builtin_ctz(u.nkt)) * 1024 + (size_t)(u.pm - 32) * BM) * 2048;
        const int col0 = u.pn * BM + wc * 32 + 8 * fq;
#pragma unroll
        for (int ai = 0; ai < 2; ++ai)
#pragma unroll
            for (int m = 0; m < 4; ++m) { bf16_t* rowp = base + (size_t)(ai * HALF + wr * 64 + m * 16 + fr) * 2048 + col0;
#pragma unroll
                for (int bj = 0; bj < 2; ++bj) *(u32x4*)(rowp + bj * HALF) = pack8(acc[ai][bj][m][0], acc[ai][bj][m][1]);
                asm volatile("" ::: "memory"); }
    }
};
template <int ACT> struct EpiBf16 {
    static constexpr bool PERM = true, AFTER_DRAIN = false;
    bf16_t* O; int ldc; const float* rs;
    size_t seg_stride = 0;
    __device__ __forceinline__ void operator()(const f32x4 (&acc)[2][2][4][2], const Unit& u, int wr, int wc, int fr, int fq) const {
        const int col0 = u.pn * BM + wc * 32 + 8 * fq;
        float rsv[2][4];
#pragma unroll
        for (int ai = 0; ai < 2; ++ai)
#pragma unroll
            for (int m = 0; m < 4; ++m) rsv[ai][m] = rs[u.pm * BM + ai * HALF + wr * 64 + m * 16 + fr];
#pragma unroll
        for (int ai = 0; ai < 2; ++ai)
#pragma unroll
            for (int m = 0; m < 4; ++m) { const int row = u.pm * BM + ai * HALF + wr * 64 + m * 16 + fr; const float scale = rsv[ai][m]; bf16_t* rowp = O + (u.kt0 ? seg_stride : 0) + (size_t)row * ldc + col0;
#pragma unroll
                for (int bj = 0; bj < 2; ++bj) { f32x4 v0 = acc[ai][bj][m][0], v1 = acc[ai][bj][m][1];
                    if (ACT == 2) {
#pragma unroll
                        for (int e = 0; e < 4; ++e) { const float a = fmaxf(v0[e] * scale, 0.f), b = fmaxf(v1[e] * scale, 0.f); v0[e] = a * a; v1[e] = b * b; } }
                    else { v0 = v0 * scale; v1 = v1 * scale; }
                    *(u32x4*)(rowp + bj * HALF) = pack8(v0, v1); }
                asm volatile("" ::: "memory"); }
    }
};
struct EpiAbIn {
    static constexpr bool PERM = true, AFTER_DRAIN = false;
    bf16_t* big; float* out;
    const float* rs;
    unsigned long long* zvstat;
    static constexpr size_t OQ = 0, OK = 9437184, OV = OK + 2359296, OZU = 14155776, OZV = 23592960;
    static constexpr size_t OKP = 18874368, OVP = 18939904, OKS = 19005440, OVS = 23199744;
    __device__ __forceinline__ void operator()(const f32x4 (&acc)[2][2][4][2], const Unit& u, int wr, int wc, int fr, int fq) const {
        const int pn = u.pn;
        bf16_t* const Q = big + OQ; bf16_t* const K = big + OK; bf16_t* const V = big + OV; bf16_t* const ZU = big + OZU; bf16_t* const ZV = big + OZV;
        float* const okp = out + OKP; float* const ovp = out + OVP; float* const oks = out + OKS; float* const ovs = out + OVS;
        float rsv[2][4];
#pragma unroll
        for (int ai = 0; ai < 2; ++ai)
#pragma unroll
            for (int m = 0; m < 4; ++m) rsv[ai][m] = rs[u.pm * BM + ai * HALF + wr * 64 + m * 16 + fr];
#pragma unroll
        for (int ai = 0; ai < 2; ++ai)
#pragma unroll
            for (int m = 0; m < 4; ++m) {
                const int row = u.pm * BM + ai * HALF + wr * 64 + m * 16 + fr; const float rsc = rsv[ai][m];
                if (pn < 5) {
                    const float pos = pos_of_row(row);
#pragma unroll
                    for (int bj = 0; bj < 2; ++bj) { f32x4 v0 = acc[ai][bj][m][0] * rsc, v1 = acc[ai][bj][m][1] * rsc;
                        if ((wc & 1) == 0) {
                            const float sg = (fq == 0) ? -1.f : 1.f;
#pragma unroll
                            for (int e = 0; e < 4; ++e) { const float p0 = __shfl_xor(v0[e], 16), p1 = __shfl_xor(v1[e], 16); float sn, cs;
                                sincos_turns(pos * rope_inv_turns(e, 2.3664460f), sn, cs); const float r0 = v0[e] * cs + sg * p0 * sn;
                                sincos_turns(pos * rope_inv_turns(4 + e, 2.3664460f), sn, cs); const float r1 = v1[e] * cs + sg * p1 * sn;
                                if (fq < 2) { v0[e] = r0; v1[e] = r1; } }
                        }
                        const int c = bj * HALF + wc * 32 + 8 * fq;
                        if (pn < 4) *(u32x4*)(Q + (size_t)row * 1024 + pn * BM + c) = pack8(v0, v1);
                        else { *(u32x4*)(K + (size_t)row * 256 + c) = pack8(v0, v1);
                            float* o = nullptr;
                            if (row < NPROMPT) { const int s = row & (SEQ - 1); if (s >= SEQ - 128) o = okp + ((size_t)(row >> 12) * 128 + (s - (SEQ - 128))) * 256 + c; }
                            else { const int r = row - NPROMPT; o = oks + ((size_t)(r >> 3) * 128 + 120 + (r & 7)) * 256 + c; }
                            if (o) { *(f32x4*)o = v0; *(f32x4*)(o + 4) = v1; } }
                    }
                } else if (pn == 5) {
#pragma unroll
                    for (int bj = 0; bj < 2; ++bj) { const f32x4 v0 = acc[ai][bj][m][0] * rsc, v1 = acc[ai][bj][m][1] * rsc; const int c = bj * HALF + wc * 32 + 8 * fq;
                        *(u32x4*)(V + (size_t)row * 256 + c) = pack8(v0, v1);
                        float* o = nullptr;
                        if (row < NPROMPT) { const int s = row & (SEQ - 1); if (s >= SEQ - 128) o = ovp + ((size_t)(row >> 12) * 128 + (s - (SEQ - 128))) * 256 + c; }
                        else { const int r = row - NPROMPT; o = ovs + ((size_t)(r >> 3) * 128 + 120 + (r & 7)) * 256 + c; }
                        if (o) { *(f32x4*)o = v0; *(f32x4*)(o + 4) = v1; } }
                } else {
                    float s1 = 0.f, s2 = 0.f;
#pragma unroll
                    for (int bj = 0; bj < 2; ++bj) { f32x4 v0 = acc[ai][bj][m][0] * rsc, v1 = acc[ai][bj][m][1] * rsc;
#pragma unroll
                        for (int e = 0; e < 4; ++e) { v0[e] = gelu_tanh(v0[e]); v1[e] = gelu_tanh(v1[e]); s1 += v0[e] + v1[e]; s2 += v0[e] * v0[e] + v1[e] * v1[e]; }
                        const int c = bj * HALF + wc * 32 + 8 * fq;
                        if (pn < 10) *(u32x4*)(ZU + (size_t)row * 1024 + (pn - 6) * BM + c) = pack8(v0, v1);
                        else *(u32x4*)(ZV + (size_t)row * 1024 + (pn - 10) * BM + c) = pack8(v0, v1); }
                    if (pn >= 10) { s1 += __shfl_xor(s1, 16); s1 += __shfl_xor(s1, 32); s2 += __shfl_xor(s2, 16); s2 += __shfl_xor(s2, 32);
                        if (fq == 0) { atomicAdd(zvstat + 2 * row, (unsigned long long)(long long)__float2ll_rn(s1 * 16777216.0f)); atomicAdd(zvstat + 2 * row + 1, (unsigned long long)(long long)__float2ll_rn(s2 * 16777216.0f)); } }
                }
                asm volatile("" ::: "memory");
            }
    }
};
struct EpiRetIn {
    static constexpr bool PERM = true, AFTER_DRAIN = false;
    bf16_t* Z; const float* rs;
    __device__ __forceinline__ void operator()(const f32x4 (&acc)[2][2][4][2], const Unit& u, int wr, int wc, int fr, int fq) const {
        const int pn = u.pn;
        float rsv[2][4];
#pragma unroll
        for (int ai = 0; ai < 2; ++ai)
#pragma unroll
            for (int m = 0; m < 4; ++m) rsv[ai][m] = rs[u.pm * BM + ai * HALF + wr * 64 + m * 16 + fr];
#pragma unroll
        for (int ai = 0; ai < 2; ++ai)
#pragma unroll
            for (int m = 0; m < 4; ++m) {
                const int row = u.pm * BM + ai * HALF + wr * 64 + m * 16 + fr;
                bf16_t* rowp = Z + (size_t)row * 12288 + pn * BM + wc * 32 + 8 * fq;
                if (pn < 16) {
                    const float pos = pos_of_row(row); const int ib = wc * 32 + 8 * fq;
                    f32x4 cs[4];
#pragma unroll
                    for (int t = 0; t < 4; ++t) { float s0, c0, s1, c1; sincos_turns(pos * rope_inv_turns(ib + 2 * t, 0.10381025f), s0, c0); sincos_turns(pos * rope_inv_turns(ib + 2 * t + 1, 0.10381025f), s1, c1); cs[t] = (f32x4){c0, s0, c1, s1}; }
                    const float sc = ((pn >= 8) ? 0.0625f : 1.0f) * rsv[ai][m];
                    f32x4 a0 = acc[ai][0][m][0], a1 = acc[ai][0][m][1], b0 = acc[ai][1][m][0], b1 = acc[ai][1][m][1], r0, r1, q0, q1;
                    r0[0] = a0[0] * cs[0][0] - b0[0] * cs[0][1]; q0[0] = b0[0] * cs[0][0] + a0[0] * cs[0][1];
                    r0[1] = a0[1] * cs[0][2] - b0[1] * cs[0][3]; q0[1] = b0[1] * cs[0][2] + a0[1] * cs[0][3];
                    r0[2] = a0[2] * cs[1][0] - b0[2] * cs[1][1]; q0[2] = b0[2] * cs[1][0] + a0[2] * cs[1][1];
                    r0[3] = a0[3] * cs[1][2] - b0[3] * cs[1][3]; q0[3] = b0[3] * cs[1][2] + a0[3] * cs[1][3];
                    r1[0] = a1[0] * cs[2][0] - b1[0] * cs[2][1]; q1[0] = b1[0] * cs[2][0] + a1[0] * cs[2][1];
                    r1[1] = a1[1] * cs[2][2] - b1[1] * cs[2][3]; q1[1] = b1[1] * cs[2][2] + a1[1] * cs[2][3];
                    r1[2] = a1[2] * cs[3][0] - b1[2] * cs[3][1]; q1[2] = b1[2] * cs[3][0] + a1[2] * cs[3][1];
                    r1[3] = a1[3] * cs[3][2] - b1[3] * cs[3][3]; q1[3] = b1[3] * cs[3][2] + a1[3] * cs[3][3];
                    *(u32x4*)(rowp) = pack8(r0 * sc, r1 * sc); *(u32x4*)(rowp + HALF) = pack8(q0 * sc, q1 * sc);
                } else {
                    const float rsc = rsv[ai][m];
#pragma unroll
                    for (int bj = 0; bj < 2; ++bj) { f32x4 v0 = acc[ai][bj][m][0] * rsc, v1 = acc[ai][bj][m][1] * rsc;
                        if (pn >= 32) {
#pragma unroll
                            for (int e = 0; e < 4; ++e) { v0[e] = silu_f(v0[e]); v1[e] = silu_f(v1[e]); } }
                        *(u32x4*)(rowp + bj * HALF) = pack8(v0, v1); }
                }
                asm volatile("" ::: "memory");
            }
    }
};
struct MemKVOrder {
    int G, c;
    __device__ bool next(int i, Unit& u) const { const int idx = i * G + c; if (idx >= 16) return false; u.pm = idx >> 2; u.pn = (u.pm >> 1) * 4 + (idx & 3); u.kt0 = 0; u.nkt = 32; return true; }
};
struct EpiMemKV {
    static constexpr bool PERM = false, AFTER_DRAIN = false;
    float* ok; float* ov; bf16_t* KV;
    __device__ __forceinline__ void operator()(const f32x4 (&acc)[2][2][4][2], const Unit& u, int wr, int wc, int fr, int fq) const {
        const int layer = u.pm >> 1, pn = u.pn & 3;
        const int col0 = pn * BM + wc * 32 + 4 * fq;
        float* o = ((pn < 2) ? ok : ov) + (size_t)layer * 512 * 512; const int cb = (pn < 2) ? col0 : col0 - 512;
        bf16_t* kv = KV + (size_t)layer * 512 * 1024;
#pragma unroll
        for (int ai = 0; ai < 2; ++ai)
#pragma unroll
            for (int m = 0; m < 4; ++m) { const int row = (u.pm & 1) * BM + ai * HALF + wr * 64 + m * 16 + fr;
#pragma unroll
                for (int bj = 0; bj < 2; ++bj)
#pragma unroll
                    for (int n = 0; n < 2; ++n) { const f32x4 v = acc[ai][bj][m][n]; const int c = bj * HALF + n * 16;
                        *(f32x4*)(o + (size_t)row * 512 + cb + c) = v;
                        u32x2 w; w.x = cvt_pk_bf16(v[0], v[1]); w.y = cvt_pk_bf16(v[2], v[3]); *(u32x2*)(kv + (size_t)row * 1024 + col0 + c) = w; }
                asm volatile("" ::: "memory"); }
    }
};

template <class Epi, class Sched, bool ALIGN_EPI = false, bool SP2 = false>
__device__ __forceinline__ void gemm_phase(PG8_LAS unsigned char* lds, const Gemm g, const Sched& S, const Epi& E) {
    int tid_ = threadIdx.x; asm volatile("" : "+v"(tid_));
    const int tid = tid_, wid = __builtin_amdgcn_readfirstlane(tid >> 6), lane = tid & 63, wr = wid >> 2, wc = wid & 3, fr = lane & 15, fq = lane >> 4;
    const int K = g.K, lda = g.lda ? g.lda : K, ldb = g.ldb ? g.ldb : K; int nt; (void)K;
    unsigned voffA[2], voffB[2];
#pragma unroll
    for (int i = 0; i < 2; ++i) { int R, C; stage_rc(tid * 16 + i * 8192, R, C); const int Rb = Epi::PERM ? ((R & ~31) + perm32(R & 31)) : R;
        voffA[i] = (unsigned)(R * lda + C) * 2u; voffB[i] = (unsigned)(Rb * ldb + C) * 2u; }
    const size_t kstep = (size_t)(BK * 2);
    const size_t hstepA = (size_t)HALF * lda * 2, hstepB = (size_t)HALF * ldb * 2;
    const size_t tstepA = 2 * hstepA, tstepB = 2 * hstepB;
    const unsigned ldsw = (unsigned)wid * 1024u;
    const int aoff = lds_byte(wr * 64 + fr, fq * 8), boff = lds_byte(wc * 32 + fr, fq * 8);
#define PG8_SA(b, h) (((b) * 2 + (h)) * HTB)
#define PG8_SB(b, h) ((4 + (b) * 2 + (h)) * HTB)
#define PG8_STAGE(bufoff, gbase, voff) do { _Pragma("unroll") for (int _i = 0; _i < 2; ++_i) \
        __builtin_amdgcn_global_load_lds((const unsigned*)((const char*)(gbase) + (voff)[_i]), (PG8_LAS unsigned*)(lds + (bufoff) + ldsw + _i * 8192), 16, 0, 0); } while (0)
#define PG8_LDA(dst, b, h) do { _Pragma("unroll") for (int m = 0; m < 4; ++m) _Pragma("unroll") for (int k = 0; k < 2; ++k) dst[m][k] = *(const PG8_LAS bf16x8*)(lds + PG8_SA(b, h) + aoff + m * 2048 + k * 1024); } while (0)
#define PG8_LDB(dst, b, h) do { _Pragma("unroll") for (int n = 0; n < 2; ++n) _Pragma("unroll") for (int k = 0; k < 2; ++k) dst[n][k] = *(const PG8_LAS bf16x8*)(lds + PG8_SB(b, h) + boff + n * 2048 + k * 1024); } while (0)
#define PG8_MMA(ai, bj, At, Bt) do { __builtin_amdgcn_s_setprio(1); _Pragma("unroll") for (int m = 0; m < 4; ++m) _Pragma("unroll") for (int n = 0; n < 2; ++n) _Pragma("unroll") for (int k = 0; k < 2; ++k) \
        acc[ai][bj][m][n] = __builtin_amdgcn_mfma_f32_16x16x32_bf16(Bt[n][k], At[m][k], acc[ai][bj][m][n], 0, 0, 0); __builtin_amdgcn_s_setprio(0); } while (0)
#define PG8_WAIT_V(n) asm volatile("s_waitcnt vmcnt(" #n ")" ::: "memory")
#define PG8_WAIT_L(n) asm volatile("s_waitcnt lgkmcnt(" #n ")" ::: "memory")
#define PG8_BAR __builtin_amdgcn_s_barrier()
#define PG8_SCHED __builtin_amdgcn_sched_barrier(0)
    Unit cur, nxt; int ui = 0;
    if (!S.next(0, cur)) return;
    f32x4 acc[2][2][4][2];
#pragma unroll
    for (int a = 0; a < 2; ++a)
#pragma unroll
        for (int b = 0; b < 2; ++b)
#pragma unroll
            for (int m = 0; m < 4; ++m)
#pragma unroll
                for (int n = 0; n < 2; ++n) acc[a][b][m][n] = (f32x4){0.f, 0.f, 0.f, 0.f};
    bf16x8 At[4][2], B0[2][2], B1[2][2];
    const char* cA = (const char*)g.A + (size_t)cur.pm * tstepA + (size_t)cur.kt0 * kstep; const char* cB = (const char*)g.Bt + (size_t)cur.pn * tstepB + (size_t)cur.kt0 * kstep; nt = cur.nkt;
    if constexpr (SP2) {
        PG8_STAGE(PG8_SB(0, 0), cB, voffB); PG8_STAGE(PG8_SB(0, 1), cB + hstepB, voffB); PG8_STAGE(PG8_SA(0, 0), cA, voffA); PG8_STAGE(PG8_SA(0, 1), cA + hstepA, voffA);
        if (wr == 1) PG8_BAR;
        PG8_WAIT_V(2); PG8_BAR;
        PG8_STAGE(PG8_SB(1, 0), cB + kstep, voffB); PG8_STAGE(PG8_SA(1, 0), cA + kstep, voffA); PG8_STAGE(PG8_SB(1, 1), cB + hstepB + kstep, voffB);
        PG8_WAIT_V(6); PG8_BAR;
    } else {
        PG8_STAGE(PG8_SB(0, 0), cB, voffB); PG8_STAGE(PG8_SA(0, 0), cA, voffA); PG8_STAGE(PG8_SB(0, 1), cB + hstepB, voffB); PG8_STAGE(PG8_SA(0, 1), cA + hstepA, voffA);
        if (wr == 1) PG8_BAR;
        PG8_WAIT_V(4); PG8_BAR;
        PG8_STAGE(PG8_SB(1, 0), cB + kstep, voffB); PG8_STAGE(PG8_SA(1, 0), cA + kstep, voffA); PG8_STAGE(PG8_SB(1, 1), cB + hstepB + kstep, voffB);
        PG8_WAIT_V(6); PG8_BAR;
    }
    for (;;) {
        const bool has_next = S.next(ui + 1, nxt);
        const char* nA = has_next ? (const char*)g.A + (size_t)nxt.pm * tstepA + (size_t)nxt.kt0 * kstep : cA; const char* nB = has_next ? (const char*)g.Bt + (size_t)nxt.pn * tstepB + (size_t)nxt.kt0 * kstep : cB;
        for (int t = 0; t < nt; t += 2) {
            const bool last = (t == nt - 2);
            const char* a1 = cA + (size_t)(t + 1) * kstep;
            const char* a2 = last ? nA : cA + (size_t)(t + 2) * kstep; const char* b2 = last ? nB : cB + (size_t)(t + 2) * kstep;
            const char* a3 = a2 + kstep; const char* b3 = b2 + kstep;
            if constexpr (SP2) {
            PG8_LDB(B0, 0, 0); PG8_LDB(B1, 0, 1); PG8_SCHED; PG8_LDA(At, 0, 0); PG8_STAGE(PG8_SA(1, 1), a1 + hstepA, voffA);
            PG8_WAIT_V(8); PG8_WAIT_L(0); PG8_BAR; PG8_MMA(0, 0, At, B0); PG8_MMA(0, 1, At, B1); PG8_BAR; PG8_SCHED;
            PG8_LDA(At, 0, 1); PG8_STAGE(PG8_SB(0, 0), b2, voffB); PG8_STAGE(PG8_SB(0, 1), b2 + hstepB, voffB); PG8_STAGE(PG8_SA(0, 0), a2, voffA);
            PG8_WAIT_V(8); PG8_WAIT_L(0); PG8_BAR; PG8_MMA(1, 0, At, B0); PG8_MMA(1, 1, At, B1); PG8_BAR; PG8_SCHED;
            PG8_LDB(B0, 1, 0); PG8_LDB(B1, 1, 1); PG8_SCHED; PG8_LDA(At, 1, 0); PG8_STAGE(PG8_SA(0, 1), a2 + hstepA, voffA);
            PG8_WAIT_V(8); PG8_WAIT_L(0); PG8_BAR; PG8_MMA(0, 0, At, B0); PG8_MMA(0, 1, At, B1); PG8_BAR; PG8_SCHED;
            PG8_LDA(At, 1, 1); PG8_STAGE(PG8_SB(1, 0), b3, voffB); PG8_STAGE(PG8_SB(1, 1), b3 + hstepB, voffB); PG8_STAGE(PG8_SA(1, 0), a3, voffA);
            PG8_WAIT_V(8); PG8_WAIT_L(0); PG8_BAR; PG8_MMA(1, 0, At, B0); PG8_MMA(1, 1, At, B1); PG8_BAR; PG8_SCHED;
            } else {
            PG8_LDB(B0, 0, 0); PG8_SCHED; PG8_LDA(At, 0, 0); PG8_STAGE(PG8_SA(1, 1), a1 + hstepA, voffA);
            PG8_WAIT_L(8); PG8_BAR; PG8_WAIT_L(0); PG8_MMA(0, 0, At, B0); PG8_BAR; PG8_SCHED;
            PG8_LDB(B1, 0, 1); PG8_STAGE(PG8_SB(0, 0), b2, voffB);
            PG8_BAR; PG8_WAIT_L(0); PG8_MMA(0, 1, At, B1); PG8_BAR;
            PG8_LDA(At, 0, 1); PG8_STAGE(PG8_SA(0, 0), a2, voffA);
            PG8_BAR; PG8_WAIT_L(0); PG8_MMA(1, 0, At, B0); PG8_BAR; PG8_SCHED;
            PG8_STAGE(PG8_SB(0, 1), b2 + hstepB, voffB);
            PG8_WAIT_V(6); PG8_BAR; PG8_MMA(1, 1, At, B1); PG8_BAR;
            PG8_LDB(B0, 1, 0); PG8_SCHED; PG8_LDA(At, 1, 0); PG8_STAGE(PG8_SA(0, 1), a2 + hstepA, voffA);
            PG8_WAIT_L(8); PG8_BAR; PG8_WAIT_L(0); PG8_MMA(0, 0, At, B0); PG8_BAR; PG8_SCHED;
            PG8_LDB(B1, 1, 1); PG8_STAGE(PG8_SB(1, 0), b3, voffB);
            PG8_BAR; PG8_WAIT_L(0); PG8_MMA(0, 1, At, B1); PG8_BAR;
            PG8_LDA(At, 1, 1); PG8_STAGE(PG8_SA(1, 0), a3, voffA);
            PG8_BAR; PG8_WAIT_L(0); PG8_MMA(1, 0, At, B0); PG8_BAR; PG8_SCHED;
            PG8_STAGE(PG8_SB(1, 1), b3 + hstepB, voffB);
            PG8_WAIT_V(6); PG8_BAR; PG8_MMA(1, 1, At, B1); PG8_BAR;
            }
        }
        if constexpr (ALIGN_EPI) { if (wr == 0) PG8_BAR; }
        if constexpr (!Epi::AFTER_DRAIN) { E(acc, cur, wr, wc, fr, fq); }
        if (!has_next) break;
#pragma unroll
        for (int a = 0; a < 2; ++a)
#pragma unroll
            for (int b = 0; b < 2; ++b)
#pragma unroll
                for (int m = 0; m < 4; ++m)
#pragma unroll
                    for (int n = 0; n < 2; ++n) acc[a][b][m][n] = (f32x4){0.f, 0.f, 0.f, 0.f};
        cur = nxt; cA = nA; cB = nB; ++ui; nt = cur.nkt;
        if constexpr (ALIGN_EPI) { if (wr == 1) PG8_BAR; }
    }
    PG8_WAIT_V(0);
    if constexpr (!ALIGN_EPI) { if (wr == 0) PG8_BAR; }
    PG8_BAR;
    if constexpr (Epi::AFTER_DRAIN) { E.fused(acc, cur, wr, wc, fr, fq, lds, wid, lane); }
#undef PG8_SA
#undef PG8_SB
#undef PG8_STAGE
#undef PG8_LDA
#undef PG8_LDB
#undef PG8_MMA
#undef PG8_WAIT_V
#undef PG8_WAIT_L
#undef PG8_BAR
#undef PG8_SCHED
}
}

#define GAS __attribute__((address_space(1)))
#define LAS __attribute__((address_space(3)))
typedef unsigned short bf16;
typedef short bf16x8 __attribute__((ext_vector_type(8)));
typedef short s16x4 __attribute__((ext_vector_type(4)));
typedef float f32x4 __attribute__((ext_vector_type(4)));
typedef float f32x2 __attribute__((ext_vector_type(2)));
typedef unsigned u32x4 __attribute__((ext_vector_type(4)));
typedef unsigned u32x2 __attribute__((ext_vector_type(2)));
typedef GAS unsigned gu32;

constexpr int D = 2048, M = 9216, NP = 8192, SEQ = 4096, NS = 128, TS = 8, FF = 8192;
constexpr int AB_IN = 3584, RET_IN = 12288, MEMW = 512;
constexpr float EPS = 1e-6f;
constexpr int NWAVES = 8, NTHR = 512;

__device__ __forceinline__ float bf2f(unsigned short b) { return __uint_as_float((unsigned)b << 16); }
__device__ __forceinline__ unsigned f2bf(float f) { unsigned u = __float_as_uint(f); return (u + 0x7fffu + ((u >> 16) & 1u)) >> 16; }
__device__ __forceinline__ unsigned pk2(float lo, float hi) { return pg8::cvt_pk_bf16(lo, hi); }
__device__ __forceinline__ float wave_sum(float v) {
#pragma unroll
    for (int o = 1; o < 64; o <<= 1) v += __shfl_xor(v, o);
    return v;
}
__device__ __forceinline__ f32x4 mfma16(bf16x8 a, bf16x8 b, f32x4 c) { return __builtin_amdgcn_mfma_f32_16x16x32_bf16(a, b, c, 0, 0, 0); }
__device__ __forceinline__ bf16x8 frag_nat(const LAS bf16* base, int stride, int row0, int k0, int lane) {
    return *(const LAS bf16x8*)(base + (row0 + (lane & 15)) * stride + k0 + 8 * (lane >> 4));
}
__device__ __forceinline__ s16x4 tr4(const LAS bf16* p) { return __builtin_amdgcn_ds_read_tr16_b64_v4i16((LAS s16x4*)p); }
__device__ __forceinline__ bf16x8 frag_tr(const LAS bf16* base, int stride, int k0, int r0, int lane) {
    const LAS bf16* a = base + (k0 + 8 * (lane >> 4) + ((lane & 15) >> 2)) * stride + r0 + 4 * (lane & 3);
    const s16x4 lo = tr4(a), hi = tr4(a + 4 * stride);
    return (bf16x8){lo[0], lo[1], lo[2], lo[3], hi[0], hi[1], hi[2], hi[3]};
}
__device__ __forceinline__ bf16x8 frag_tr_perm(const LAS bf16* base, int stride, int k0, int r0, int lane) {
    const LAS bf16* a = base + (k0 + 4 * (lane >> 4) + ((lane & 15) >> 2)) * stride + r0 + 4 * (lane & 3);
    const s16x4 lo = tr4(a), hi = tr4(a + 16 * stride);
    return (bf16x8){lo[0], lo[1], lo[2], lo[3], hi[0], hi[1], hi[2], hi[3]};
}
__device__ __forceinline__ bf16x8 pack_p(const f32x4& a, const f32x4& b) {
    u32x4 w; w.x = pk2(a[0], a[1]); w.y = pk2(a[2], a[3]); w.z = pk2(b[0], b[1]); w.w = pk2(b[2], b[3]);
    return __builtin_bit_cast(bf16x8, w);
}
#define WG_SYNC() do { asm volatile("s_waitcnt lgkmcnt(0)" ::: "memory"); __builtin_amdgcn_s_barrier(); asm volatile("" ::: "memory"); } while (0)

struct Frame {
    LAS unsigned char* lds;
    int tid, lane, wave, vcu, G;
};

struct f32x8 { f32x4 lo, hi; };
__device__ __forceinline__ f32x8 bf8_to_f32(const u32x4 r) { f32x8 o; o.lo = (f32x4){__uint_as_float(r.x << 16), __uint_as_float(r.x & 0xffff0000u), __uint_as_float(r.y << 16), __uint_as_float(r.y & 0xffff0000u)};
    o.hi = (f32x4){__uint_as_float(r.z << 16), __uint_as_float(r.z & 0xffff0000u), __uint_as_float(r.w << 16), __uint_as_float(r.w & 0xffff0000u)}; return o; }
__device__ __forceinline__ u32x4 f32_to_bf8(const f32x8& v) { u32x4 w; w.x = pk2(v.lo[0], v.lo[1]); w.y = pk2(v.lo[2], v.lo[3]); w.z = pk2(v.hi[0], v.hi[1]); w.w = pk2(v.hi[2], v.hi[3]); return w; }
__device__ __forceinline__ float sumsq8(const f32x8& v) { return ((v.lo[0] * v.lo[0] + v.lo[1] * v.lo[1]) + (v.lo[2] * v.lo[2] + v.lo[3] * v.lo[3])) + ((v.hi[0] * v.hi[0] + v.hi[1] * v.hi[1]) + (v.hi[2] * v.hi[2] + v.hi[3] * v.hi[3])); }
template <bool HAS_Y, int NR>
__device__ __forceinline__ void norm_rows(const Frame& F, const float* xin_p, const float* xin_s, const bf16* xin_b, const bf16* Y0, const bf16* P, int splits, const float* gpost, float* rs_out, float* xout, bf16* xout_b) {
    const int gw = F.vcu * NWAVES + F.wave, NGW = F.G * NWAVES, lane = F.lane;
    for (int base = gw; base < NP; base += NR * NGW) {
        u32x4 xr[NR][4], yr[NR][4]; f32x8 xf[NR][4];
#pragma unroll
        for (int r = 0; r < NR; ++r) { const int row = base + r * NGW, rw = row < NP ? row : base;
            if (xin_b) {
#pragma unroll
                for (int j = 0; j < 4; ++j) xr[r][j] = __builtin_nontemporal_load((const u32x4*)(xin_b + (size_t)rw * D) + lane + 64 * j);
            } else {
#pragma unroll
                for (int j = 0; j < 4; ++j) { xf[r][j].lo = __builtin_nontemporal_load((const f32x4*)(xin_p + (size_t)rw * D) + 2 * (lane + 64 * j)); xf[r][j].hi = __builtin_nontemporal_load((const f32x4*)(xin_p + (size_t)rw * D) + 2 * (lane + 64 * j) + 1); }
            }
            if (HAS_Y) {
#pragma unroll
                for (int j = 0; j < 4; ++j) yr[r][j] = __builtin_nontemporal_load((const u32x4*)(Y0 + (size_t)rw * D) + lane + 64 * j); } }
#pragma unroll
        for (int r = 0; r < NR; ++r) { const int row = base + r * NGW; const bool ok = row < NP;
            f32x8 x[4];
#pragma unroll
            for (int j = 0; j < 4; ++j) x[j] = xin_b ? bf8_to_f32(xr[r][j]) : xf[r][j];
            if (HAS_Y) {
                f32x8 y[4]; float ss = 0.f;
#pragma unroll
                for (int j = 0; j < 4; ++j) { y[j] = bf8_to_f32(yr[r][j]); ss += sumsq8(y[j]); }
                const float rs = 1.0f / sqrtf(wave_sum(ss) * (1.0f / D) + EPS);
#pragma unroll
                for (int j = 0; j < 4; ++j) { const f32x4 g0 = ((const f32x4*)gpost)[2 * (lane + 64 * j)], g1 = ((const f32x4*)gpost)[2 * (lane + 64 * j) + 1];
                    x[j].lo += y[j].lo * rs * g0; x[j].hi += y[j].hi * rs * g1;
                    if (xout && ok) { __builtin_nontemporal_store(x[j].lo, (f32x4*)(xout + (size_t)row * D) + 2 * (lane + 64 * j)); __builtin_nontemporal_store(x[j].hi, (f32x4*)(xout + (size_t)row * D) + 2 * (lane + 64 * j) + 1); } }
            }
            if (xout_b) {
#pragma unroll
                for (int j = 0; j < 4; ++j) { const u32x4 w = f32_to_bf8(x[j]); if (ok) ((u32x4*)(xout_b + (size_t)row * D))[lane + 64 * j] = w; x[j] = bf8_to_f32(w); } }
            if (rs_out) { float ss = 0.f;
#pragma unroll
                for (int j = 0; j < 4; ++j) ss += sumsq8(x[j]);
                const float rs = 1.0f / sqrtf(wave_sum(ss) * (1.0f / D) + EPS);
                if (lane == 0 && ok) rs_out[row] = rs; }
        }
    }
    for (int row = NP + gw; row < M; row += NGW) {
        f32x8 x[4];
        if (xin_b) {
#pragma unroll
            for (int j = 0; j < 4; ++j) x[j] = bf8_to_f32(__builtin_nontemporal_load((const u32x4*)(xin_b + (size_t)row * D) + lane + 64 * j));
        } else {
#pragma unroll
            for (int j = 0; j < 4; ++j) { x[j].lo = __builtin_nontemporal_load((const f32x4*)(xin_s + (size_t)(row - NP) * D) + 2 * (lane + 64 * j)); x[j].hi = __builtin_nontemporal_load((const f32x4*)(xin_s + (size_t)(row - NP) * D) + 2 * (lane + 64 * j) + 1); }
        }
        if (HAS_Y) {
            f32x8 y[4];
#pragma unroll
            for (int j = 0; j < 4; ++j) { y[j].lo = (f32x4){0.f, 0.f, 0.f, 0.f}; y[j].hi = y[j].lo; }
            if (splits == 8) {
#pragma unroll
                for (int s = 0; s < 8; ++s)
#pragma unroll
                    for (int j = 0; j < 4; ++j) { const f32x8 v = bf8_to_f32(__builtin_nontemporal_load((const u32x4*)(P + ((size_t)s * 1024 + (row - NP)) * D) + lane + 64 * j)); y[j].lo += v.lo; y[j].hi += v.hi; }
            } else {
                for (int s = 0; s < splits; ++s)
#pragma unroll
                    for (int j = 0; j < 4; ++j) { const f32x8 v = bf8_to_f32(__builtin_nontemporal_load((const u32x4*)(P + ((size_t)s * 1024 + (row - NP)) * D) + lane + 64 * j)); y[j].lo += v.lo; y[j].hi += v.hi; }
            }
            float ss = 0.f;
#pragma unroll
            for (int j = 0; j < 4; ++j) ss += sumsq8(y[j]);
            const float rs = 1.0f / sqrtf(wave_sum(ss) * (1.0f / D) + EPS);
#pragma unroll
            for (int j = 0; j < 4; ++j) { const f32x4 g0 = ((const f32x4*)gpost)[2 * (lane + 64 * j)], g1 = ((const f32x4*)gpost)[2 * (lane + 64 * j) + 1];
                x[j].lo += y[j].lo * rs * g0; x[j].hi += y[j].hi * rs * g1;
                if (xout) { __builtin_nontemporal_store(x[j].lo, (f32x4*)(xout + (size_t)row * D) + 2 * (lane + 64 * j)); __builtin_nontemporal_store(x[j].hi, (f32x4*)(xout + (size_t)row * D) + 2 * (lane + 64 * j) + 1); } }
        }
        if (xout_b) {
#pragma unroll
            for (int j = 0; j < 4; ++j) { const u32x4 w = f32_to_bf8(x[j]); ((u32x4*)(xout_b + (size_t)row * D))[lane + 64 * j] = w; x[j] = bf8_to_f32(w); } }
        if (rs_out) { float ss = 0.f;
#pragma unroll
            for (int j = 0; j < 4; ++j) ss += sumsq8(x[j]);
            const float rs = 1.0f / sqrtf(wave_sum(ss) * (1.0f / D) + EPS);
            if (lane == 0) rs_out[row] = rs; }
    }
}

__device__ __forceinline__ void transpose_item(const float* W, int K, int N, bf16* WT, LAS float* scr, int item, int lane, const float* gain = nullptr, int ldw = 0) {
    const int nblk = N / 64, kb = item / nblk, nb = item % nblk, k0 = 64 * kb, n0 = 64 * nb;
    f32x4 v[16];
#pragma unroll
    for (int i = 0; i < 16; ++i) v[i] = __builtin_nontemporal_load((const f32x4*)(W + (size_t)(k0 + 4 * i + (lane >> 4)) * N + n0 + 4 * (lane & 15)));
#pragma unroll
    for (int i = 0; i < 16; ++i) { LAS float* s = scr + (4 * i + (lane >> 4)) * 65 + 4 * (lane & 15); const float gk = gain ? gain[k0 + 4 * i + (lane >> 4)] : 1.0f; s[0] = v[i][0] * gk; s[1] = v[i][1] * gk; s[2] = v[i][2] * gk; s[3] = v[i][3] * gk; }
    asm volatile("s_waitcnt lgkmcnt(0)" ::: "memory");
    const int c = lane & 7;
#pragma unroll
    for (int j = 0; j < 8; ++j) { const int n = (lane >> 3) + 8 * j; const LAS float* s = scr + (8 * c) * 65 + n;
        u32x4 o; o.x = pk2(s[0 * 65], s[1 * 65]); o.y = pk2(s[2 * 65], s[3 * 65]); o.z = pk2(s[4 * 65], s[5 * 65]); o.w = pk2(s[6 * 65], s[7 * 65]);
        *(u32x4*)(WT + (size_t)(n0 + n) * (ldw ? ldw : K) + k0 + 8 * c) = o; }
    asm volatile("s_waitcnt lgkmcnt(0)" ::: "memory");
}
__device__ __forceinline__ void transpose_strided(const float* W, int K, int N, bf16* WT, LAS float* scr, int it0, int stride, int nit, int lane, const float* gain = nullptr, int ldw = 0) {
    const int nblk = N / 64, ldo = ldw ? ldw : K;
#define TR_LOAD(v, item) do { const int kb_ = (item) / nblk, nb_ = (item) - kb_ * nblk; _Pragma("unroll") for (int i = 0; i < 16; ++i) v[i] = __builtin_nontemporal_load((const f32x4*)(W + (size_t)(64 * kb_ + 4 * i + (lane >> 4)) * N + 64 * nb_ + 4 * (lane & 15))); } while (0)
#define TR_STORE(v, item) do { const int kb_ = (item) / nblk, nb_ = (item) - kb_ * nblk, k0 = 64 * kb_, n0 = 64 * nb_; \
        _Pragma("unroll") for (int i = 0; i < 16; ++i) { LAS float* s = scr + (4 * i + (lane >> 4)) * 65 + 4 * (lane & 15); const float gk = gain ? gain[k0 + 4 * i + (lane >> 4)] : 1.0f; s[0] = v[i][0] * gk; s[1] = v[i][1] * gk; s[2] = v[i][2] * gk; s[3] = v[i][3] * gk; } \
        asm volatile("s_waitcnt lgkmcnt(0)" ::: "memory"); \
        _Pragma("unroll") for (int j = 0; j < 8; ++j) { const int n = (lane >> 3) + 8 * j, c = lane & 7; const LAS float* s = scr + (8 * c) * 65 + n; \
            u32x4 o; o.x = pk2(s[0 * 65], s[1 * 65]); o.y = pk2(s[2 * 65], s[3 * 65]); o.z = pk2(s[4 * 65], s[5 * 65]); o.w = pk2(s[6 * 65], s[7 * 65]); \
            *(u32x4*)(WT + (size_t)(n0 + n) * ldo + k0 + 8 * c) = o; } \
        asm volatile("s_waitcnt lgkmcnt(0)" ::: "memory"); } while (0)
    int it = it0; if (it >= nit) return;
    f32x4 va[16], vb[16];
    TR_LOAD(va, it);
    for (;;) {
        int itn = it + stride; bool hn = itn < nit;
        if (hn) TR_LOAD(vb, itn);
        TR_STORE(va, it);
        if (!hn) break;
        it = itn; itn = it + stride; hn = itn < nit;
        if (hn) TR_LOAD(va, itn);
        TR_STORE(vb, it);
        if (!hn) break;
        it = itn;
    }
#undef TR_LOAD
#undef TR_STORE
}
struct WJob { const float* W; bf16* WT; int K, N; };
constexpr float LOG2E = 1.4426950408889634f;
__device__ __forceinline__ void swa_prompt_unit(const Frame& F, int b, int c, int kh, const bf16* Q, const bf16* K, const bf16* V, const float* sinks, bf16* CAT) {
    LAS bf16* Ks = (LAS bf16*)F.lds; LAS bf16* Vs = Ks + 256 * 72;
    const int lane = F.lane, kg = lane >> 4, w = F.wave;
    const int rowbase = b * SEQ + (c - 1) * 128;
#pragma unroll
    for (int i = 0; i < 4; ++i) { const int idx = F.tid + NTHR * i, r = idx >> 3, ch = idx & 7;
        u32x4 kv = (u32x4){0u, 0u, 0u, 0u}, vv = kv;
        if (c > 0 || r >= 128) { kv = *(const u32x4*)(K + (size_t)(rowbase + r) * 256 + kh * 64 + ch * 8); vv = *(const u32x4*)(V + (size_t)(rowbase + r) * 256 + kh * 64 + ch * 8); }
        *(LAS u32x4*)(Ks + r * 72 + ch * 8) = kv; *(LAS u32x4*)(Vs + r * 72 + ch * 8) = vv; }
    WG_SYNC();
    const int hq = kh * 4 + (w >> 1);
    const float sink2 = sinks[hq] * LOG2E;
    for (int mb = 0; mb < 4; ++mb) {
        const int i0 = (w & 1) * 64 + mb * 16, qrow = b * SEQ + c * 128 + i0 + (lane & 15), tb = 2 * (i0 >> 5), tq = i0 + (lane & 15);
        bf16x8 bq[2];
#pragma unroll
        for (int ks = 0; ks < 2; ++ks) bq[ks] = *(const bf16x8*)(Q + (size_t)qrow * 1024 + hq * 64 + ks * 32 + 8 * kg);
        f32x4 st[10]; float mx = -1e30f;
#pragma unroll
        for (int t = 0; t < 10; ++t) { f32x4 a = (f32x4){0.f, 0.f, 0.f, 0.f};
#pragma unroll
            for (int ks = 0; ks < 2; ++ks) a = mfma16(frag_nat(Ks, 72, (tb + t) * 16, ks * 32, lane), bq[ks], a);
#pragma unroll
            for (int r = 0; r < 4; ++r) { const int j = (tb + t) * 16 + 4 * kg + r; const bool ok = (j > tq) && (j <= tq + 128) && (c > 0 || j >= 128);
                a[r] = ok ? a[r] * (0.125f * LOG2E) : -1e30f; mx = fmaxf(mx, a[r]); }
            st[t] = a; }
        mx = fmaxf(mx, __shfl_xor(mx, 16)); mx = fmaxf(mx, __shfl_xor(mx, 32)); mx = fmaxf(mx, sink2);
        float sum = 0.f;
#pragma unroll
        for (int t = 0; t < 10; ++t)
#pragma unroll
            for (int r = 0; r < 4; ++r) { const float p = __builtin_amdgcn_exp2f(st[t][r] - mx); st[t][r] = p; sum += p; }
        sum += __shfl_xor(sum, 16); sum += __shfl_xor(sum, 32);
        const float inv = 1.0f / (sum + __builtin_amdgcn_exp2f(sink2 - mx));
        f32x4 o[4];
#pragma unroll
        for (int dt = 0; dt < 4; ++dt) o[dt] = (f32x4){0.f, 0.f, 0.f, 0.f};
#pragma unroll
        for (int s = 0; s < 5; ++s) { const bf16x8 pb = pack_p(st[2 * s], st[2 * s + 1]);
#pragma unroll
            for (int dt = 0; dt < 4; ++dt) o[dt] = mfma16(frag_tr_perm(Vs, 72, (tb + 2 * s) * 16, dt * 16, lane), pb, o[dt]); }
#pragma unroll
        for (int dt = 0; dt < 4; ++dt) { u32x2 wv; wv.x = pk2(o[dt][0] * inv, o[dt][1] * inv); wv.y = pk2(o[dt][2] * inv, o[dt][3] * inv);
            *(u32x2*)(CAT + (size_t)qrow * 2048 + hq * 64 + dt * 16 + 4 * kg) = wv; }
    }
    WG_SYNC();
}
__device__ __forceinline__ void gate_prompt_unit(const Frame& F, int b, int c, int g, const bf16* ZU, const bf16* ZV, const long long* zvstat, const float* lng, const float* lnb, const float* w_s, const float* b_s, bf16* CAT) {
    LAS bf16* Ws = (LAS bf16*)F.lds; LAS bf16* Zs = Ws + 128 * 136;
    const int lane = F.lane, kg = lane >> 4, w = F.wave;
#pragma unroll
    for (int i = 0; i < 8; ++i) { const int idx = F.tid + NTHR * i, r = idx >> 5, j4 = (idx & 31) * 4;
        f32x4 v = *(const f32x4*)(w_s + ((size_t)g * 128 + r) * 128 + j4);
#pragma unroll
        for (int e = 0; e < 4; ++e) if (j4 + e > r) v[e] = 0.f;
        u32x2 wv; wv.x = pk2(v[0], v[1]); wv.y = pk2(v[2], v[3]); *(LAS u32x2*)(Ws + r * 136 + j4) = wv; }
#pragma unroll
    for (int i = 0; i < 8; ++i) { const int idx = F.tid + NTHR * i, r = idx >> 5, ch = idx & 31, col = g * 256 + ch * 8, row = b * SEQ + c * 128 + r;
        const u32x4 raw = *(const u32x4*)(ZV + (size_t)row * 1024 + col);
        const float mean = (float)zvstat[2 * row] * (1.0f / (1024.0f * 16777216.0f)), var = (float)zvstat[2 * row + 1] * (1.0f / (1024.0f * 16777216.0f)) - mean * mean, rstd = 1.0f / sqrtf(fmaxf(var, 0.f) + EPS);
        const f32x4 g0 = *(const f32x4*)(lng + col), g1 = *(const f32x4*)(lng + col + 4), b0 = *(const f32x4*)(lnb + col), b1 = *(const f32x4*)(lnb + col + 4);
        float z[8];
#pragma unroll
        for (int e = 0; e < 4; ++e) { z[2 * e] = __uint_as_float(raw[e] << 16); z[2 * e + 1] = __uint_as_float(raw[e] & 0xffff0000u); }
        u32x4 o;
        o.x = pk2((z[0] - mean) * rstd * g0[0] + b0[0], (z[1] - mean) * rstd * g0[1] + b0[1]); o.y = pk2((z[2] - mean) * rstd * g0[2] + b0[2], (z[3] - mean) * rstd * g0[3] + b0[3]);
        o.z = pk2((z[4] - mean) * rstd * g1[0] + b1[0], (z[5] - mean) * rstd * g1[1] + b1[1]); o.w = pk2((z[6] - mean) * rstd * g1[2] + b1[2], (z[7] - mean) * rstd * g1[3] + b1[3]);
        *(LAS u32x4*)(Zs + r * 264 + ch * 8) = o; }
    WG_SYNC();
    const int i0 = 16 * w, nst = (w >> 1) + 1;
    f32x4 acc[16];
#pragma unroll
    for (int dt = 0; dt < 16; ++dt) acc[dt] = (f32x4){0.f, 0.f, 0.f, 0.f};
    for (int s = 0; s < nst; ++s) { const bf16x8 bw = frag_nat(Ws, 136, i0, 32 * s, lane);
#pragma unroll
        for (int dt = 0; dt < 16; ++dt) acc[dt] = mfma16(frag_tr(Zs, 264, 32 * s, dt * 16, lane), bw, acc[dt]); }
    const int row = b * SEQ + c * 128 + i0 + (lane & 15); const float bs = b_s[g * 128 + i0 + (lane & 15)];
#pragma unroll
    for (int dt = 0; dt < 16; ++dt) { const int col = g * 256 + dt * 16 + 4 * kg; const u32x2 zu = *(const u32x2*)(ZU + (size_t)row * 1024 + col);
        u32x2 wv; wv.x = pk2(__uint_as_float(zu.x << 16) * (acc[dt][0] + bs), __uint_as_float(zu.x & 0xffff0000u) * (acc[dt][1] + bs));
        wv.y = pk2(__uint_as_float(zu.y << 16) * (acc[dt][2] + bs), __uint_as_float(zu.y & 0xffff0000u) * (acc[dt][3] + bs));
        *(u32x2*)(CAT + (size_t)row * 2048 + 1024 + col) = wv; }
    WG_SYNC();
}
__device__ __forceinline__ void gate_sample_unit(const Frame& F, int n, const bf16* ZU, const bf16* ZV, const long long* zvstat, const float* lng, const float* lnb, const float* w_s, const float* b_s, bf16* CAT, float* ogv) {
#pragma unroll
    for (int cc = 0; cc < 2; ++cc) { const int col = F.tid + NTHR * cc, g = col >> 8; const float lg = lng[col], lb = lnb[col];
        float z[8];
#pragma unroll
        for (int j = 0; j < 8; ++j) { const int row = NP + n * 8 + j;
            const float mean = (float)zvstat[2 * row] * (1.0f / (1024.0f * 16777216.0f)), var = (float)zvstat[2 * row + 1] * (1.0f / (1024.0f * 16777216.0f)) - mean * mean, rstd = 1.0f / sqrtf(fmaxf(var, 0.f) + EPS);
            z[j] = (bf2f(ZV[(size_t)row * 1024 + col]) - mean) * rstd * lg + lb; ogv[(size_t)(n * 8 + j) * 1024 + col] = z[j]; }
#pragma unroll
        for (int i = 0; i < 8; ++i) { float mixed = b_s[g * 128 + i];
#pragma unroll
            for (int j = 0; j <= i; ++j) mixed += w_s[((size_t)g * 128 + i) * 128 + j] * z[j];
            const int row = NP + n * 8 + i; CAT[(size_t)row * 2048 + 1024 + col] = (bf16)f2bf(bf2f(ZU[(size_t)row * 1024 + col]) * mixed); } }
}
__device__ __forceinline__ void swa_sample_unit(const Frame& F, int n, int khp, const bf16* Q, const bf16* K, const bf16* V, const float* ck, const float* cv, const float* sinks, bf16* CAT, float* oks, float* ovs) {
    LAS bf16* Ks = (LAS bf16*)F.lds; LAS bf16* Vs = Ks + 2 * 144 * 72;
    const int lane = F.lane, kg = lane >> 4, w = F.wave;
#pragma unroll
    for (int i = 0; i < 8; ++i) { const int idx = F.tid + NTHR * i, j = idx >> 5, f4 = idx & 31, khl = f4 >> 4, d = (f4 & 15) * 4;
        const size_t off = (((size_t)n * 128 + j) * 4 + 2 * khp) * 64 + f4 * 4;
        const f32x4 kv = *(const f32x4*)(ck + off), vv = *(const f32x4*)(cv + off);
        u32x2 a; a.x = pk2(kv[0], kv[1]); a.y = pk2(kv[2], kv[3]); *(LAS u32x2*)(Ks + (khl * 144 + j) * 72 + d) = a;
        u32x2 c2; c2.x = pk2(vv[0], vv[1]); c2.y = pk2(vv[2], vv[3]); *(LAS u32x2*)(Vs + (khl * 160 + j) * 72 + d) = c2;
        if (j >= 8) { const size_t oo = (((size_t)n * 128 + j - 8) * 4 + 2 * khp) * 64 + f4 * 4; *(f32x4*)(oks + oo) = kv; *(f32x4*)(ovs + oo) = vv; } }
    if (F.tid < 128) { const int t = F.tid >> 4, khl = (F.tid >> 3) & 1, ch = F.tid & 7; const size_t off = (size_t)(NP + n * 8 + t) * 256 + (2 * khp + khl) * 64 + ch * 8;
        *(LAS u32x4*)(Ks + (khl * 144 + 128 + t) * 72 + ch * 8) = *(const u32x4*)(K + off); *(LAS u32x4*)(Vs + (khl * 160 + 128 + t) * 72 + ch * 8) = *(const u32x4*)(V + off); }
    else if (F.tid < 128 + 64 * 2) { const int x = F.tid - 128, khl = x >> 6, r = 136 + ((x & 63) >> 3), ch = x & 7; *(LAS u32x4*)(Ks + (khl * 144 + r) * 72 + ch * 8) = (u32x4){0u, 0u, 0u, 0u}; }
    for (int x = F.tid; x < 2 * 24 * 8; x += NTHR) { const int khl = x / 192, r = 136 + ((x % 192) >> 3), ch = x & 7; *(LAS u32x4*)(Vs + (khl * 160 + r) * 72 + ch * 8) = (u32x4){0u, 0u, 0u, 0u}; }
    WG_SYNC();
    if (w < 4) {
        const int khl = w >> 1, kh = 2 * khp + khl, t = lane & 7, head = kh * 4 + 2 * (w & 1) + ((lane & 15) >> 3), qrow = NP + n * 8 + t;
        const LAS bf16* Kh = Ks + khl * 144 * 72; const LAS bf16* Vh = Vs + khl * 160 * 72;
        const float sink2 = sinks[head] * LOG2E;
        bf16x8 bq[2];
#pragma unroll
        for (int ks = 0; ks < 2; ++ks) bq[ks] = *(const bf16x8*)(Q + (size_t)qrow * 1024 + head * 64 + ks * 32 + 8 * kg);
        f32x4 st[10]; float mx = -1e30f;
#pragma unroll
        for (int tt = 0; tt < 9; ++tt) { f32x4 a = (f32x4){0.f, 0.f, 0.f, 0.f};
#pragma unroll
            for (int ks = 0; ks < 2; ++ks) a = mfma16(frag_nat(Kh, 72, tt * 16, ks * 32, lane), bq[ks], a);
#pragma unroll
            for (int r = 0; r < 4; ++r) { const int j = tt * 16 + 4 * kg + r; const bool ok = (j > t) && (j <= t + 128);
                a[r] = ok ? a[r] * (0.125f * LOG2E) : -1e30f; mx = fmaxf(mx, a[r]); }
            st[tt] = a; }
        st[9] = (f32x4){-1e30f, -1e30f, -1e30f, -1e30f};
        mx = fmaxf(mx, __shfl_xor(mx, 16)); mx = fmaxf(mx, __shfl_xor(mx, 32)); mx = fmaxf(mx, sink2);
        float sum = 0.f;
#pragma unroll
        for (int tt = 0; tt < 10; ++tt)
#pragma unroll
            for (int r = 0; r < 4; ++r) { const float p = __builtin_amdgcn_exp2f(st[tt][r] - mx); st[tt][r] = p; sum += p; }
        sum += __shfl_xor(sum, 16); sum += __shfl_xor(sum, 32);
        const float inv = 1.0f / (sum + __builtin_amdgcn_exp2f(sink2 - mx));
        f32x4 o[4];
#pragma unroll
        for (int dt = 0; dt < 4; ++dt) o[dt] = (f32x4){0.f, 0.f, 0.f, 0.f};
#pragma unroll
        for (int s = 0; s < 5; ++s) { const bf16x8 pb = pack_p(st[2 * s], st[2 * s + 1]);
#pragma unroll
            for (int dt = 0; dt < 4; ++dt) o[dt] = mfma16(frag_tr_perm(Vh, 72, 32 * s, dt * 16, lane), pb, o[dt]); }
#pragma unroll
        for (int dt = 0; dt < 4; ++dt) { u32x2 wv; wv.x = pk2(o[dt][0] * inv, o[dt][1] * inv); wv.y = pk2(o[dt][2] * inv, o[dt][3] * inv);
            *(u32x2*)(CAT + (size_t)qrow * 2048 + head * 64 + dt * 16 + 4 * kg) = wv; }
    }
    WG_SYNC();
}

constexpr size_t QSEG = (size_t)132 * 1024 * 1024 / 2;
__device__ __forceinline__ bf16x8 ldq2(const bf16* p) {
    const u32x4 a = *(const u32x4*)p, b = *(const u32x4*)(p + QSEG); u32x4 o;
#pragma unroll
    for (int e = 0; e < 4; ++e) o[e] = pk2(__uint_as_float(a[e] << 16) + __uint_as_float(b[e] << 16), __uint_as_float(a[e] & 0xffff0000u) + __uint_as_float(b[e] & 0xffff0000u));
    return __builtin_bit_cast(bf16x8, o);
}
__device__ __forceinline__ void mem_attn_wave(const LAS bf16* Ks, const LAS bf16* Vs, const bf16* qptr  , bf16* optr, bool store, int lane) {
    const int kg = lane >> 4;
    bf16x8 bq[4];
#pragma unroll
    for (int ks = 0; ks < 4; ++ks) bq[ks] = ldq2(qptr + ks * 32 + 8 * kg);
    f32x4 st[16]; float mx = -1e30f;
#pragma unroll
    for (int t = 0; t < 16; ++t) { f32x4 a = (f32x4){0.f, 0.f, 0.f, 0.f};
#pragma unroll
        for (int ks = 0; ks < 4; ++ks) a = mfma16(frag_nat(Ks, 136, t * 16, ks * 32, lane), bq[ks], a);
#pragma unroll
        for (int r = 0; r < 4; ++r) { a[r] *= (0.08838834764831845f * LOG2E); mx = fmaxf(mx, a[r]); }
        st[t] = a; }
    mx = fmaxf(mx, __shfl_xor(mx, 16)); mx = fmaxf(mx, __shfl_xor(mx, 32));
    float sum = 0.f;
#pragma unroll
    for (int t = 0; t < 16; ++t)
#pragma unroll
        for (int r = 0; r < 4; ++r) { const float p = __builtin_amdgcn_exp2f(st[t][r] - mx); st[t][r] = p; sum += p; }
    sum += __shfl_xor(sum, 16); sum += __shfl_xor(sum, 32);
    const float inv = 1.0f / sum;
    f32x4 o[8];
#pragma unroll
    for (int dt = 0; dt < 8; ++dt) o[dt] = (f32x4){0.f, 0.f, 0.f, 0.f};
#pragma unroll
    for (int s = 0; s < 8; ++s) { const bf16x8 pb = pack_p(st[2 * s], st[2 * s + 1]);
#pragma unroll
        for (int dt = 0; dt < 8; ++dt) o[dt] = mfma16(frag_tr_perm(Vs, 136, 32 * s, dt * 16, lane), pb, o[dt]); }
    if (store) {
#pragma unroll
        for (int dt = 0; dt < 8; ++dt) { u32x2 wv; wv.x = pk2(o[dt][0] * inv, o[dt][1] * inv); wv.y = pk2(o[dt][2] * inv, o[dt][3] * inv); *(u32x2*)(optr + dt * 16 + 4 * kg) = wv; } }
}
__device__ __forceinline__ void mem_prompt_unit(const Frame& F, int b, int h, int qb, const bf16* QM, const bf16* KV, bf16* OM) {
    LAS bf16* Ks = (LAS bf16*)F.lds; LAS bf16* Vs = Ks + 256 * 136;
#pragma unroll
    for (int i = 0; i < 8; ++i) { const int idx = F.tid + NTHR * i, r = idx >> 4, ch = idx & 15; const size_t off = (size_t)(b * 256 + r) * 1024 + h * 128 + ch * 8;
        *(LAS u32x4*)(Ks + r * 136 + ch * 8) = *(const u32x4*)(KV + off); *(LAS u32x4*)(Vs + r * 136 + ch * 8) = *(const u32x4*)(KV + off + 512); }
    WG_SYNC();
    const size_t row = (size_t)b * SEQ + qb * 128 + F.wave * 16 + (F.lane & 15);
    mem_attn_wave(Ks, Vs, QM + row * 512 + h * 128, OM + row * 512 + h * 128, true, F.lane);
    WG_SYNC();
}
__device__ __forceinline__ void mem_sample_units(const Frame& F, int u0, int ustride, const bf16* QM, const float* ck, const float* cv, bf16* OM) {
    LAS bf16* Ks = (LAS bf16*)F.lds; LAS bf16* Vs = Ks + 256 * 136; LAS bf16* Pb = Vs + 256 * 136; LAS float* smax = (LAS float*)(Pb + 8 * 264); LAS float* ssum = smax + 64;
    const int lane = F.lane, kg = lane >> 4, w = F.wave, q = lane & 7;
    f32x4 kv[16], vv[16];
#define MS_LOAD(u_) do { const int n_ = (u_) >> 2, h_ = (u_) & 3; _Pragma("unroll") for (int i = 0; i < 16; ++i) { const int idx = F.tid + NTHR * i, r = idx >> 5, f4 = idx & 31; const size_t off = (((size_t)n_ * 256 + r) * 4 + h_) * 128 + f4 * 4; \
            kv[i] = __builtin_nontemporal_load((const f32x4*)(ck + off)); vv[i] = __builtin_nontemporal_load((const f32x4*)(cv + off)); } } while (0)
    if (u0 < 512) MS_LOAD(u0);
    for (int u = u0; u < 512; u += ustride) {
        const int n = u >> 2, h = u & 3;
#pragma unroll
        for (int i = 0; i < 16; ++i) { const int idx = F.tid + NTHR * i, r = idx >> 5, f4 = idx & 31;
            u32x2 a; a.x = pk2(kv[i][0], kv[i][1]); a.y = pk2(kv[i][2], kv[i][3]); *(LAS u32x2*)(Ks + r * 136 + f4 * 4) = a;
            u32x2 c2; c2.x = pk2(vv[i][0], vv[i][1]); c2.y = pk2(vv[i][2], vv[i][3]); *(LAS u32x2*)(Vs + r * 136 + f4 * 4) = c2; }
        if (u + ustride < 512) MS_LOAD(u + ustride);
        const size_t row = (size_t)NP + n * 8 + q;
        bf16x8 bq[4];
#pragma unroll
        for (int ks = 0; ks < 4; ++ks) bq[ks] = ldq2(QM + row * 512 + h * 128 + ks * 32 + 8 * kg);
        WG_SYNC();
        f32x4 st[2]; float mx = -1e30f;
#pragma unroll
        for (int t = 0; t < 2; ++t) { f32x4 a = (f32x4){0.f, 0.f, 0.f, 0.f};
#pragma unroll
            for (int ks = 0; ks < 4; ++ks) a = mfma16(frag_nat(Ks, 136, (2 * w + t) * 16, ks * 32, lane), bq[ks], a);
#pragma unroll
            for (int r = 0; r < 4; ++r) { a[r] *= (0.08838834764831845f * LOG2E); mx = fmaxf(mx, a[r]); }
            st[t] = a; }
        mx = fmaxf(mx, __shfl_xor(mx, 16)); mx = fmaxf(mx, __shfl_xor(mx, 32));
        if (lane < 8) smax[w * 8 + lane] = mx;
        WG_SYNC();
        float gm = smax[q];
#pragma unroll
        for (int ww = 1; ww < 8; ++ww) gm = fmaxf(gm, smax[ww * 8 + q]);
        float sum = 0.f;
#pragma unroll
        for (int t = 0; t < 2; ++t)
#pragma unroll
            for (int r = 0; r < 4; ++r) { const float p = __builtin_amdgcn_exp2f(st[t][r] - gm); sum += p; if ((lane & 15) < 8) Pb[q * 264 + (2 * w + t) * 16 + 4 * kg + r] = (bf16)f2bf(p); }
        sum += __shfl_xor(sum, 16); sum += __shfl_xor(sum, 32);
        if (lane < 8) ssum[w * 8 + lane] = sum;
        WG_SYNC();
        float tot = ssum[q];
#pragma unroll
        for (int ww = 1; ww < 8; ++ww) tot += ssum[ww * 8 + q];
        f32x4 o = (f32x4){0.f, 0.f, 0.f, 0.f};
#pragma unroll
        for (int s2 = 0; s2 < 8; ++s2) o = mfma16(frag_tr(Vs, 136, 32 * s2, w * 16, lane), *(const LAS bf16x8*)(Pb + q * 264 + 32 * s2 + 8 * kg), o);
        if ((lane & 15) < 8) { const float inv = 1.0f / tot; u32x2 wv; wv.x = pk2(o[0] * inv, o[1] * inv); wv.y = pk2(o[2] * inv, o[3] * inv); *(u32x2*)(OM + row * 512 + h * 128 + w * 16 + 4 * kg) = wv; }
        WG_SYNC();
    }
#undef MS_LOAD
}
constexpr int ES = 64, NE = ES / 16;
__device__ __forceinline__ float ret_lg2(int h) { return log2f(1.0f - exp2f(-5.0f - (float)h)); }
__device__ __forceinline__ void ret_prompt_scan(const Frame& F, int b, int h, int es, const bf16* ZR, bf16* OR, unsigned long long* SS, float* ostate) {
    constexpr int VST = ES + 8, NV = ES / 32;
    LAS bf16* Ks = (LAS bf16*)F.lds; LAS bf16* Vs = Ks + 128 * 264; LAS bf16* Vd = Vs + 128 * VST; LAS bf16* Ss = Vd + 128 * VST;
    const int lane = F.lane, kg = lane >> 4, w = F.wave, tid = F.tid;
    const int it = (w < 4) ? w : 11 - w;
    const float lg2 = ret_lg2(h);
    const int e0 = es * ES;
    bf16x8 qf[8]; u32x4 kpre[8], vpre[NV];
    const size_t rb = (size_t)b * SEQ;
#define RET_LOAD_KV(c_, tid) do { \
        const unsigned kl_off = (unsigned)(((tid) >> 5) * RET_IN + ((tid) & 31) * 8) * 2u; \
        const char* kb_ = (const char*)(ZR + (rb + (size_t)(c_) * 128) * RET_IN + 2048 + h * 256); \
        _Pragma("unroll") for (int i = 0; i < 8; ++i) kpre[i] = *(const u32x4*)(kb_ + (size_t)i * (16 * RET_IN * 2) + kl_off); \
        _Pragma("unroll") for (int i = 0; i < NV; ++i) { const int idx = tid + NTHR * i, r = idx / (ES / 8), ch = idx % (ES / 8); vpre[i] = *(const u32x4*)(ZR + (rb + (c_) * 128 + r) * RET_IN + 4096 + h * 512 + e0 + ch * 8); } } while (0)
#define RET_LOAD_Q(c_, lane) do { const unsigned q_off = (unsigned)((16 * it + ((lane) & 15)) * RET_IN + 8 * ((lane) >> 4)) * 2u; const char* qb_ = (const char*)(ZR + (rb + (size_t)(c_) * 128) * RET_IN + h * 256); \
        _Pragma("unroll") for (int ks = 0; ks < 8; ++ks) qf[ks] = *(const bf16x8*)(qb_ + ks * 64 + q_off); } while (0)
#define RET_STORE_KV(tid) do { \
        const unsigned kl_lds = (unsigned)(((tid) >> 5) * 264 + ((tid) & 31) * 8) * 2u; \
        _Pragma("unroll") for (int i = 0; i < 8; ++i) *(LAS u32x4*)((LAS char*)Ks + kl_lds + i * (16 * 264 * 2)) = kpre[i]; \
        _Pragma("unroll") for (int i = 0; i < NV; ++i) { const int idx = tid + NTHR * i, r = idx / (ES / 8), ch = idx % (ES / 8); *(LAS u32x4*)(Vs + r * VST + ch * 8) = vpre[i]; \
          const float dk = __builtin_amdgcn_exp2f(lg2 * (float)(127 - r)); u32x4 o; \
          _Pragma("unroll") for (int e = 0; e < 4; ++e) o[e] = pk2(__uint_as_float(vpre[i][e] << 16) * dk, __uint_as_float(vpre[i][e] & 0xffff0000u) * dk); \
          *(LAS u32x4*)(Vd + r * VST + ch * 8) = o; } } while (0)
    for (int x = tid; x < 256 * VST / 8; x += NTHR) *(LAS u32x4*)(Ss + x * 8) = (u32x4){0u, 0u, 0u, 0u};
    f32x4 sacc[2][NE];
#pragma unroll
    for (int a = 0; a < 2; ++a)
#pragma unroll
        for (int e = 0; e < NE; ++e) sacc[a][e] = (f32x4){0.f, 0.f, 0.f, 0.f};
    const float g128 = __builtin_amdgcn_exp2f(lg2 * 128.0f);
    RET_LOAD_KV(0, tid); RET_LOAD_Q(0, lane); RET_STORE_KV(tid);
    WG_SYNC();
    for (int c = 0; c < 32; ++c) {
        int ln = lane, tc = tid; asm volatile("" : "+v"(ln), "+v"(tc));
        const int kg = ln >> 4, iq = 16 * it + (ln & 15);
        const float giq = __builtin_amdgcn_exp2f(lg2 * (float)iq);
        float gkr[4];
#pragma unroll
        for (int r = 0; r < 4; ++r) gkr[r] = __builtin_amdgcn_exp2f(lg2 * (float)(-(4 * kg + r)));
        f32x4 oi[NE];
#pragma unroll
        for (int e = 0; e < NE; ++e) oi[e] = (f32x4){0.f, 0.f, 0.f, 0.f};
#pragma unroll
        for (int ks = 0; ks < 8; ++ks) { if ((ks & 1) == 0) asm volatile("" ::: "memory");
#pragma unroll
            for (int e = 0; e < NE; ++e) oi[e] = mfma16(frag_tr(Ss, VST, 32 * ks, e * 16, ln), qf[ks], oi[e]); }
        { const float qd = __builtin_amdgcn_exp2f(lg2 * (float)(iq + 1));
#pragma unroll
          for (int e = 0; e < NE; ++e) oi[e] *= qd; }
        if (c + 1 < 32) RET_LOAD_KV(c + 1, tc);
#pragma unroll
        for (int s = 0; s < 4; ++s) if (2 * s <= it) { asm volatile("" ::: "memory");
            f32x4 a2[2];
#pragma unroll
            for (int hh = 0; hh < 2; ++hh) { const int jt = 2 * s + hh; f32x4 a = (f32x4){0.f, 0.f, 0.f, 0.f};
                if (jt <= it) {
#pragma unroll
                    for (int ks = 0; ks < 8; ++ks) a = mfma16(frag_nat(Ks, 264, jt * 16, ks * 32, ln), qf[ks], a);
                    const float gj = giq * __builtin_amdgcn_exp2f(lg2 * (float)(-16 * jt));
#pragma unroll
                    for (int r = 0; r < 4; ++r) a[r] *= gj * gkr[r];
                    if (jt == it) {
#pragma unroll
                        for (int r = 0; r < 4; ++r) if (4 * kg + r > (ln & 15)) a[r] = 0.f; } }
                a2[hh] = a; }
            const bf16x8 pb = pack_p(a2[0], a2[1]);
#pragma unroll
            for (int e = 0; e < NE; ++e) oi[e] = mfma16(frag_tr_perm(Vs, VST, 32 * s, e * 16, ln), pb, oi[e]); }
        const size_t orow = rb + c * 128 + iq; float ssq = 0.f;
#pragma unroll
        for (int e = 0; e < NE; ++e) { const f32x4 o = oi[e]; ssq += (o[0] * o[0] + o[1] * o[1]) + (o[2] * o[2] + o[3] * o[3]);
            u32x2 wv; wv.x = pk2(o[0], o[1]); wv.y = pk2(o[2], o[3]); *(u32x2*)(OR + orow * 4096 + h * 512 + e0 + e * 16 + 4 * kg) = wv; }
        ssq += __shfl_xor(ssq, 16); ssq += __shfl_xor(ssq, 32);
        if (kg == 0) atomicAdd(SS + orow * 8 + h, (unsigned long long)__float2ll_rn(ssq * 16777216.0f));
        WG_SYNC();
        if (c + 1 < 32) RET_LOAD_Q(c + 1, ln);
#pragma unroll
        for (int a = 0; a < 2; ++a)
#pragma unroll
            for (int e = 0; e < NE; ++e) sacc[a][e] *= g128;
#pragma unroll
        for (int s = 0; s < 4; ++s) { asm volatile("" ::: "memory");
            bf16x8 vf[NE];
#pragma unroll
            for (int e = 0; e < NE; ++e) vf[e] = frag_tr(Vd, VST, 32 * s, e * 16, ln);
#pragma unroll
            for (int a = 0; a < 2; ++a) { const bf16x8 kf = frag_tr(Ks, 264, 32 * s, (2 * w + a) * 16, ln);
#pragma unroll
                for (int e = 0; e < NE; ++e) sacc[a][e] = mfma16(kf, vf[e], sacc[a][e]); } }
#pragma unroll
        for (int a = 0; a < 2; ++a)
#pragma unroll
            for (int e = 0; e < NE; ++e)
#pragma unroll
                for (int r = 0; r < 4; ++r) Ss[((2 * w + a) * 16 + 4 * kg + r) * VST + e * 16 + (ln & 15)] = (bf16)f2bf(sacc[a][e][r]);
        WG_SYNC();
        if (c + 1 < 32) RET_STORE_KV(tc);
        WG_SYNC();
    }
#undef RET_LOAD_KV
#undef RET_LOAD_Q
#undef RET_STORE_KV
#pragma unroll
    for (int a = 0; a < 2; ++a)
#pragma unroll
        for (int e = 0; e < NE; ++e)
#pragma unroll
            for (int r = 0; r < 4; ++r) ostate[(((size_t)b * 8 + h) * 256 + (2 * w + a) * 16 + 4 * kg + r) * 512 + e0 + e * 16 + (lane & 15)] = sacc[a][e][r];
}
__device__ __forceinline__ void ret_sample_pass(const Frame& F, int unit0, const bf16* ZR, const float* state, float* ostate, bf16* OR, unsigned long long* SS) {
    const int grp = F.wave >> 2, dq = (F.wave >> 1) & 1, t = (F.wave & 1) * 64 + F.lane, t256 = dq * 128 + t, unit = unit0 + grp, n = unit >> 3, h = unit & 7;
    LAS float* qk = (LAS float*)F.lds + grp * (256 * 16 + 64 + 8 * 128 * 4); LAS float* sc = qk + 256 * 16; LAS f32x4* red = (LAS f32x4*)(sc + 64);
    const float lg2 = ret_lg2(h);
    const size_t r0 = (size_t)NP + n * 8;
#pragma unroll 4
    for (int x = t256; x < 8 * 256; x += 256) { const int i = x >> 8, d = x & 255;
        qk[d * 16 + i] = bf2f(ZR[(r0 + i) * RET_IN + h * 256 + d]);
        qk[d * 16 + 8 + i] = bf2f(ZR[(r0 + i) * RET_IN + 2048 + h * 256 + d]) * __builtin_amdgcn_exp2f(lg2 * (float)(7 - i)); }
    float v[8][4];
#pragma unroll
    for (int j = 0; j < 8; ++j) { const u32x2 raw = *(const u32x2*)(ZR + (r0 + j) * RET_IN + 4096 + h * 512 + 4 * t);
        v[j][0] = __uint_as_float(raw.x << 16); v[j][1] = __uint_as_float(raw.x & 0xffff0000u); v[j][2] = __uint_as_float(raw.y << 16); v[j][3] = __uint_as_float(raw.y & 0xffff0000u); }
    WG_SYNC();
    const float g8 = __builtin_amdgcn_exp2f(lg2 * 8.0f);
    const __amdgpu_buffer_rsrc_t rs_in = __builtin_amdgcn_make_buffer_rsrc((void*)(state + ((size_t)n * 8 + h) * 256 * 512), 0, 256 * 2048, 0x00020000);
    const __amdgpu_buffer_rsrc_t rs_out = __builtin_amdgcn_make_buffer_rsrc((void*)(ostate + ((size_t)n * 8 + h) * 256 * 512), 0, 256 * 2048, 0x00020000);
    const int loff = t * 16, dbase = dq * 128;
    f32x4 acc[8];
#pragma unroll
    for (int i = 0; i < 8; ++i) acc[i] = (f32x4){0.f, 0.f, 0.f, 0.f};
    constexpr int RB = 4;
    f32x4 bufA[RB], bufB[RB];
#define RS_LD(buf, d0_) do { _Pragma("unroll") for (int u = 0; u < RB; ++u) buf[u] = __builtin_bit_cast(f32x4, __builtin_amdgcn_raw_buffer_load_b128(rs_in, loff, (dbase + (d0_) + u) * 2048, 2)); } while (0)
#define RS_CP(buf, d0_) do { _Pragma("unroll") for (int u = 0; u < RB; ++u) { __builtin_amdgcn_sched_barrier(0); const LAS f32x4* qp = (const LAS f32x4*)(qk + (dbase + (d0_) + u) * 16); const f32x4 q0 = qp[0], q1 = qp[1], k0 = qp[2], k1 = qp[3]; \
            const f32x4 sv = buf[u]; f32x4 s1 = sv * g8; \
            _Pragma("unroll") for (int e = 0; e < 4; ++e) { \
                s1[e] += k0[0] * v[0][e] + k0[1] * v[1][e] + k0[2] * v[2][e] + k0[3] * v[3][e] + k1[0] * v[4][e] + k1[1] * v[5][e] + k1[2] * v[6][e] + k1[3] * v[7][e]; \
                acc[0][e] += q0[0] * sv[e]; acc[1][e] += q0[1] * sv[e]; acc[2][e] += q0[2] * sv[e]; acc[3][e] += q0[3] * sv[e]; \
                acc[4][e] += q1[0] * sv[e]; acc[5][e] += q1[1] * sv[e]; acc[6][e] += q1[2] * sv[e]; acc[7][e] += q1[3] * sv[e]; } \
            __builtin_amdgcn_raw_buffer_store_b128(__builtin_bit_cast(u32x4, s1), rs_out, loff, (dbase + (d0_) + u) * 2048, 2); } } while (0)
    RS_LD(bufA, 0);
#pragma unroll 1
    for (int d0 = 0; d0 < 128; d0 += 2 * RB) {
        RS_LD(bufB, d0 + RB);
        RS_CP(bufA, d0);
        if (d0 + 2 * RB < 128) RS_LD(bufA, d0 + 2 * RB);
        RS_CP(bufB, d0 + RB);
    }
#undef RS_LD
#undef RS_CP
    { int t3 = t256; asm volatile("" : "+v"(t3)); const int pr = t3 >> 2, i = pr >> 3, j = pr & 7, qd = t3 & 3; float s = 0.f;
      for (int d = qd * 64; d < qd * 64 + 64; ++d) s += qk[d * 16 + i] * qk[d * 16 + 8 + j];
      s += __shfl_xor(s, 1); s += __shfl_xor(s, 2);
      if (qd == 0) sc[i * 8 + j] = (j <= i) ? s * __builtin_amdgcn_exp2f(lg2 * (float)((i - j) - (7 - j))) : 0.f; }
    int t2 = t; asm volatile("" : "+v"(t2));
    if (dq == 1) {
#pragma unroll
        for (int i = 0; i < 8; ++i) red[i * 128 + t2] = acc[i]; }
    WG_SYNC();
    if (dq == 0) {
#pragma unroll
        for (int i = 0; i < 8; ++i) { f32x4 o = (acc[i] + red[i * 128 + t2]) * __builtin_amdgcn_exp2f(lg2 * (float)(i + 1));
#pragma unroll
            for (int j = 0; j <= i; ++j) { const float s = sc[i * 8 + j];
#pragma unroll
                for (int e = 0; e < 4; ++e) o[e] += s * v[j][e]; }
            u32x2 wv; wv.x = pk2(o[0], o[1]); wv.y = pk2(o[2], o[3]); *(u32x2*)(OR + (r0 + i) * 4096 + h * 512 + 4 * t2) = wv;
            float ssq = (o[0] * o[0] + o[1] * o[1]) + (o[2] * o[2] + o[3] * o[3]); ssq = wave_sum(ssq);
            if ((t2 & 63) == 0) atomicAdd(SS + (r0 + i) * 8 + h, (unsigned long long)__float2ll_rn(ssq * 16777216.0f)); } }
    WG_SYNC();
}
template <int NR>
__device__ __forceinline__ void ret_norm_rows(const Frame& F, const bf16* OR, const bf16* ZR, const unsigned long long* SS, bf16* YG) {
    const int gw = F.vcu * NWAVES + F.wave, NGW = F.G * NWAVES, lane = F.lane;
    for (int base = gw; base < M; base += NR * NGW) {
        u32x4 o[NR][8], g[NR][8];
#pragma unroll
        for (int r = 0; r < NR; ++r) { const int row = base + r * NGW, rw = row < M ? row : base;
#pragma unroll
            for (int j = 0; j < 8; ++j) { const int col = (lane + 64 * j) * 8; o[r][j] = __builtin_nontemporal_load((const u32x4*)(OR + (size_t)rw * 4096 + col)); g[r][j] = __builtin_nontemporal_load((const u32x4*)(ZR + (size_t)rw * RET_IN + 8192 + col)); } }
#pragma unroll
        for (int r = 0; r < NR; ++r) { const int row = base + r * NGW; if (row >= M) break;
#pragma unroll
            for (int j = 0; j < 8; ++j) { const int col = (lane + 64 * j) * 8, h = col >> 9; const float rs = 1.0f / sqrtf((float)SS[(size_t)row * 8 + h] * (1.0f / (512.0f * 16777216.0f)) + EPS); u32x4 y;
#pragma unroll
                for (int e = 0; e < 4; ++e) y[e] = pk2(__uint_as_float(o[r][j][e] << 16) * rs * __uint_as_float(g[r][j][e] << 16), __uint_as_float(o[r][j][e] & 0xffff0000u) * rs * __uint_as_float(g[r][j][e] & 0xffff0000u));
                *(u32x4*)(YG + (size_t)row * 4096 + col) = y; } }
    }
}
constexpr size_t MiB = 1u << 20;
constexpr size_t WS_CTL = 0, CTL_ZERO_BYTES = 32 * 1024;
constexpr size_t CTL_QUEUE = 1024, CTL_TQ = 2048, CTL_ZVSTAT = 256 * 1024, CTL_SS = 512 * 1024, CTL_BAR = 8 * 1024;
constexpr size_t WS_ROPE_A = 2 * MiB, WS_ROPE_R = 3 * MiB;
constexpr size_t WS_WT = 8 * MiB;
constexpr size_t WT_ABIN = WS_WT, WT_ABOUT = WT_ABIN + 14 * MiB, WT_RETIN = WT_ABOUT + 8 * MiB, WT_RETOUT = WT_RETIN + 48 * MiB, WT_MEMQ = WT_RETOUT + 16 * MiB,
                 WT_MEMKV = WT_MEMQ + 4 * MiB, WT_MEMO = WT_MEMKV + 8 * MiB, WT_UP = WT_MEMO + 4 * MiB, WT_DOWN = WT_UP + 64 * MiB, WT_END = WT_DOWN + 64 * MiB;
constexpr size_t WS_H = 240 * MiB, WS_Y0 = 276 * MiB, WS_Y1 = 348 * MiB, WS_BIG = 420 * MiB, WS_CAT = 636 * MiB, WS_OR = 708 * MiB, WS_QM = 780 * MiB, WS_OM = 789 * MiB, WS_HM = 798 * MiB, WS_MKV = 802 * MiB, WS_XB = 804 * MiB, WS_RS = 840 * MiB, WS_WTD = 842 * MiB, WS_QM2 = 912 * MiB, WS_END = 922 * MiB;
static_assert((WS_QM2 - WS_QM) / 2 == QSEG, "q partial distance");
static_assert(WT_END <= WS_H, "weights fit");
constexpr size_t BIG_Q = 0, BIG_K = 18 * MiB, BIG_V = BIG_K + 9216 * 256 * 2, BIG_ZU = 27 * MiB, BIG_ZV = 45 * MiB;
constexpr size_t O_X = 0, O_SKP = 18874368, O_SVP = 18939904, O_SKS = 19005440, O_SVS = 23199744, O_GV = 27394048, O_RP = 28442624, O_RS = 30539776, O_MK = 164757504, O_MV = 165281792, O_END = 165806080;
constexpr int LDFF = FF + 64;
constexpr int LDS_BYTES = 147456, MISC_OFF = LDS_BYTES - 512;

#define XB_TMO      128
#define XB_XCNT(j)  (256  + 64 * (j))
#define XB_XSUB(j)  (1280 + 64 * (j))
#define XB_XGEN(j)  (2304 + 64 * (j))
#define XB_TOP      3328
#define XB_TOPGEN   3392
#define XCD_BAR_WORDS 3456
#define XB_SPIN_CAP (1u << 18)

__device__ __forceinline__ unsigned xb_ld(unsigned* p)              { return __hip_atomic_load(p, __ATOMIC_RELAXED, __HIP_MEMORY_SCOPE_AGENT); }
__device__ __forceinline__ unsigned xb_add(unsigned* p, unsigned v) { return __hip_atomic_fetch_add(p, v, __ATOMIC_RELAXED, __HIP_MEMORY_SCOPE_AGENT); }
__device__ __forceinline__ unsigned xb_xcc_id() { return (unsigned)__builtin_amdgcn_s_getreg((3 << 11) | 20) & 0xFu; }
#define XB_SPIN(cond, bar) do { unsigned _sp = 0; while (cond) { __builtin_amdgcn_s_sleep(1); \
    if ((++_sp & 255u) == 0u) { if (xb_ld(&(bar)[XB_TMO])) break; if (_sp > XB_SPIN_CAP) { atomicAdd(&(bar)[XB_TMO], 1u); break; } } } } while (0)

struct XcdBarrier {
    unsigned* bar; unsigned x;
    volatile LAS unsigned* st;
};

__device__ __forceinline__ XcdBarrier xcd_barrier_post(unsigned* bar, volatile LAS unsigned* st) {
    XcdBarrier b; b.bar = bar; b.x = xb_xcc_id(); b.st = st;
    if (threadIdx.x == 0) (void)xb_add(&bar[XB_XCNT(b.x)], 1u);
    return b;
}
__device__ __forceinline__ void xcd_barrier_complete(unsigned* bar, unsigned x, unsigned& nloc, unsigned& nx) {
    const unsigned G = gridDim.x * gridDim.y * gridDim.z;
    unsigned sum, cnt, mine, sp = 0u;
    for (;;) {
        sum = 0u; cnt = 0u; mine = 0u;
#pragma unroll
        for (unsigned j = 0; j < 16; ++j) { const unsigned c = xb_ld(&bar[XB_XCNT(j)]); sum += c; cnt += (c > 0u) ? 1u : 0u; mine = (j == x) ? c : mine; }
        if (sum == G) break;
        __builtin_amdgcn_s_sleep(1);
        if ((++sp & 255u) == 0u) { if (xb_ld(&bar[XB_TMO])) break; if (sp > XB_SPIN_CAP) { atomicAdd(&bar[XB_TMO], 1u); break; } }
    }
    nloc = mine > 0u ? mine : 1u; nx = cnt > 0u ? cnt : 1u;
}

__device__ __forceinline__ void xcd_barrier(const XcdBarrier& b) {
    asm volatile("s_waitcnt vmcnt(0)" ::: "memory");
    __syncthreads();
    if (threadIdx.x == 0) {
        unsigned* bar = b.bar;
        __builtin_amdgcn_s_waitcnt(0);
        unsigned nloc = b.st[0], nx = b.st[1];
        if (nloc == 0u) { xcd_barrier_complete(bar, b.x, nloc, nx); b.st[0] = nloc; b.st[1] = nx; }
        const unsigned old = xb_add(&bar[XB_XSUB(b.x)], 1u);
        const unsigned gen = old / nloc;
        if (old + 1u == (gen + 1u) * nloc) {
            __builtin_amdgcn_fence(__ATOMIC_RELEASE, "agent");
            asm volatile("s_waitcnt vmcnt(0)" ::: "memory");
            const unsigned og = xb_add(&bar[XB_TOP], 1u);
            const unsigned tg = og / nx;
            if (og + 1u == (tg + 1u) * nx) xb_add(&bar[XB_TOPGEN], 1u);
            else XB_SPIN(xb_ld(&bar[XB_TOPGEN]) == tg, bar);
            __builtin_amdgcn_fence(__ATOMIC_ACQUIRE, "agent");
            xb_add(&bar[XB_XGEN(b.x)], 1u);
            asm volatile("s_waitcnt vmcnt(0)" ::: "memory");
        } else {
            XB_SPIN(xb_ld(&bar[XB_XGEN(b.x)]) == gen, bar);
            __builtin_amdgcn_fence(__ATOMIC_ACQUIRE, "agent");
            asm volatile("s_waitcnt vmcnt(0)" ::: "memory");
        }
    }
    __syncthreads();
}

struct Args {
    const float *x_prompt, *x_sample, *cache_swa_k, *cache_swa_v, *state_ret, *cache_mem_k, *cache_mem_v, *mem_prompt;
    const float *norm_mix_pre, *norm_mix_post, *norm_mem, *norm_x_pre, *norm_x_post, *norm_ffn_pre, *norm_ffn_post;
    const float *w_ab_in, *w_ab_out, *swa_sinks, *gmlp_ln_g, *gmlp_ln_b, *gmlp_w_s, *gmlp_b_s, *w_ret_in, *w_ret_out, *w_mem_q, *w_mem_k, *w_mem_v, *w_mem_o, *w_ffn_up, *w_ffn_down;
    float* out; unsigned char* ws; int ph_lo, ph_hi, li, pad;
};
#ifndef PHASE_MASK
#define PHASE_MASK 0xFFFFFFFFu
#endif
#define EN(b) (((PHASE_MASK) >> (b)) & 1u)
#ifndef DUPMASK
#define DUPMASK 0u
#endif
#define REPS(b) ((((DUPMASK) >> (b)) & 1u) ? 2 : 1)
#define DUMMY(ptr_t, p_) (dup_ ? (ptr_t)(ws + WS_END + 64 * MiB) : (p_))
constexpr int N_PHASES = 25;

#define CAS __attribute__((address_space(4)))
#define KARGS ((const CAS Args*)__builtin_amdgcn_kernarg_segment_ptr())
#define ARG(f) (*(const float* const volatile CAS*)&(KARGS->f))
#define ARGI(f) (*(const int volatile CAS*)&(KARGS->f))
#define ARG_OUT() (*(float* const volatile CAS*)&(KARGS->out))
#define ARG_WS() (*(unsigned char* const volatile CAS*)&(KARGS->ws))
__global__ void __launch_bounds__(NTHR, 2) fwd(Args a_unused) {
    extern __shared__ __attribute__((aligned(16))) unsigned char lds_raw[];
    Frame F0; F0.lds = (LAS unsigned char*)lds_raw; F0.tid = threadIdx.x; F0.lane = F0.tid & 63; F0.wave = __builtin_amdgcn_readfirstlane(F0.tid >> 6);
    F0.G = gridDim.x; { const int bx = blockIdx.x; F0.vcu = (F0.G % 8 == 0) ? (bx % 8) * (F0.G / 8) + bx / 8 : bx; }
    volatile LAS unsigned* MISC = (volatile LAS unsigned*)(F0.lds + MISC_OFF);
    if (F0.tid < 128) MISC[F0.tid] = 0u;
    __syncthreads();
    const XcdBarrier bar = xcd_barrier_post((unsigned*)(ARG_WS() + WS_CTL + CTL_BAR) + ARGI(li) * XCD_BAR_WORDS, MISC + 8);
    const int lo = ARGI(ph_lo), hi = ARGI(ph_hi);
#define IN(k) (lo <= (k) && (k) < hi)
#define SEAM(k) do { if (IN(k) && IN((k) + 1)) xcd_barrier(bar); } while (0)
#define GW (F.vcu * NWAVES + F.wave)
#define NGW (F.G * NWAVES)
#define IDLE_TJOB(c0_, Wp, WTp, K_, N_, Gp, LDW) do { if ((int)blockIdx.x >= (c0_)) { const int nit_ = ((K_) / 64) * ((N_) / 64), nw_ = ((int)F.G - (c0_)) * NWAVES; const float* W_ = (Wp); bf16* WT_ = (bf16*)(WTp); \
        LAS float* scr_ = (LAS float*)(F.lds + F.wave * 16640); transpose_strided(W_, K_, N_, WT_, scr_, ((int)blockIdx.x - (c0_)) * NWAVES + F.wave, nw_, nit_, F.lane, (Gp), (LDW)); } } while (0)
#define PHASE_FRAME Frame P = F0; asm volatile("" : "+v"(P.tid), "+s"(P.wave), "+s"(P.vcu), "+s"(P.G)); P.lane = P.tid & 63

    if (EN(0) && IN(0)) { for (int rep_ = 0; rep_ < REPS(0); ++rep_) { PHASE_FRAME; const Frame& F = P; const bool dup_ = (rep_ != 0); (void)dup_; if (dup_) __syncthreads();
        unsigned char* ws = ARG_WS();
        LAS float* scr = (LAS float*)(F.lds + F.wave * 16640);
        const int gw = GW, ngw = NGW;
        { u32x4* z1 = (u32x4*)(ws + WS_CTL + CTL_ZVSTAT); u32x4* z2 = (u32x4*)(ws + WS_CTL + CTL_SS);
          for (int x = F.vcu * NTHR + F.tid; x < M * 2 * 8 / 16; x += F.G * NTHR) z1[x] = (u32x4){0u, 0u, 0u, 0u};
          for (int x = F.vcu * NTHR + F.tid; x < M * 8 * 8 / 16; x += F.G * NTHR) z2[x] = (u32x4){0u, 0u, 0u, 0u}; }
        int base = 0;
#define TJOB(Wp, WTp, K_, N_, Gp) do { const int nit = ((K_) / 64) * ((N_) / 64); int it = gw - (base % ngw); if (it < 0) it += ngw; const float* W_ = (Wp); bf16* WT_ = (bf16*)(WTp); \
            const float* G_ = (Gp); transpose_strided(W_, K_, N_, WT_, scr, it, ngw, nit, F.lane, G_, 0); base += nit; } while (0)
        TJOB(ARG(w_ab_in), ws + WT_ABIN, D, AB_IN, ARG(norm_mix_pre));
        TJOB(ARG(w_ab_out), ws + WT_ABOUT, D, D, (const float*)nullptr);
#pragma unroll 1
        for (int l = 0; l < 2; ++l) {
            TJOB(ARG(w_mem_q) + (size_t)l * D * MEMW, ws + WT_MEMQ + (size_t)l * MEMW * D * 2, D, MEMW, ARG(norm_x_pre) + (size_t)l * D);
            TJOB(ARG(w_mem_k) + (size_t)l * D * MEMW, ws + WT_MEMKV + (size_t)(2 * l) * MEMW * D * 2, D, MEMW, (const float*)nullptr);
            TJOB(ARG(w_mem_v) + (size_t)l * D * MEMW, ws + WT_MEMKV + (size_t)(2 * l + 1) * MEMW * D * 2, D, MEMW, (const float*)nullptr);
            TJOB(ARG(w_mem_o) + (size_t)l * MEMW * D, ws + WT_MEMO + (size_t)l * D * MEMW * 2, MEMW, D, (const float*)nullptr);
        }
#undef TJOB
        norm_rows<false, 4>(F, ARG(x_prompt), ARG(x_sample), nullptr, nullptr, nullptr, 0, nullptr, (float*)(ws + WS_RS), nullptr, (bf16*)(ws + WS_XB));
        { const float* memp = ARG(mem_prompt); const float* nmem = ARG(norm_mem); bf16* HM = (bf16*)(ws + WS_HM);
        for (int r2 = gw; r2 < 1024; r2 += ngw) { const int l = r2 >> 9, row = r2 & 511; const float* xr = memp + (size_t)row * D; const float* g = nmem + (size_t)l * D;
            f32x4 xv[8]; float ss = 0.f;
#pragma unroll
            for (int j = 0; j < 8; ++j) { xv[j] = ((const f32x4*)xr)[F.lane + 64 * j]; ss += (xv[j][0] * xv[j][0] + xv[j][1] * xv[j][1]) + (xv[j][2] * xv[j][2] + xv[j][3] * xv[j][3]); }
            const float rs = 1.0f / sqrtf(wave_sum(ss) * (1.0f / D) + EPS);
#pragma unroll
            for (int j = 0; j < 8; ++j) { const f32x4 gg = ((const f32x4*)g)[F.lane + 64 * j]; const f32x4 h = xv[j] * rs * gg; u32x2 w; w.x = pk2(h[0], h[1]); w.y = pk2(h[2], h[3]);
                ((u32x2*)(HM + (size_t)r2 * D))[F.lane + 64 * j] = w; } } }
    } }
    SEAM(0);

#pragma unroll 1
    for (int layer = 0; layer < 2; ++layer) {
        const int pb = 1 + 12 * layer;
        if (layer == 0) {
            if (EN(1) && IN(pb + 0)) { for (int rep_ = 0; rep_ < REPS(1); ++rep_) { PHASE_FRAME; const Frame& F = P; const bool dup_ = (rep_ != 0); (void)dup_; if (dup_) __syncthreads();
                unsigned char* ws = ARG_WS(); float* out = ARG_OUT(); bf16* BIG = (bf16*)(ws + WS_BIG);
                pg8::Gemm g{(const bf16*)(ws + WS_XB), (const bf16*)(ws + WT_ABIN), M, AB_IN, D}; pg8::StaticOrder S; S.init(M, AB_IN, D, F.G, (int)blockIdx.x);
                pg8::EpiAbIn E{BIG, out, (const float*)(ws + WS_RS), DUMMY(unsigned long long*, (unsigned long long*)(ws + WS_CTL + CTL_ZVSTAT))};
                static_assert(pg8::EpiAbIn::OK == BIG_K / 2 && pg8::EpiAbIn::OV == BIG_V / 2 && pg8::EpiAbIn::OZU == BIG_ZU / 2 && pg8::EpiAbIn::OZV == BIG_ZV / 2 && pg8::EpiAbIn::OKP == O_SKP && pg8::EpiAbIn::OVS == O_SVS, "maps");
                pg8::gemm_phase<pg8::EpiAbIn, pg8::StaticOrder, true, true>(F.lds, g, S, E);
            } }
            SEAM(pb + 0);
            if (IN(pb + 1)) {
                const bool sample_first = ((blockIdx.x >> 3) & 1) != 0;
#pragma unroll 1
                for (int step = 0; step < 2; ++step) {
                  if ((step == 0) != sample_first) {
                if (EN(2)) { for (int rep_ = 0; rep_ < REPS(2); ++rep_) { PHASE_FRAME; const Frame& F = P; const bool dup_ = (rep_ != 0); (void)dup_; if (dup_) __syncthreads();     unsigned char* ws = ARG_WS(); const bf16* BIG = (const bf16*)(ws + WS_BIG); const float* sinks = ARG(swa_sinks);
                    for (int u = F.vcu; u < 256; u += F.G) swa_prompt_unit(F, u >> 7, (u >> 2) & 31, u & 3, BIG + BIG_Q / 2, BIG + BIG_K / 2, BIG + BIG_V / 2, sinks, (bf16*)(ws + WS_CAT)); } }
                if (EN(3)) { for (int rep_ = 0; rep_ < REPS(3); ++rep_) { PHASE_FRAME; const Frame& F = P; const bool dup_ = (rep_ != 0); (void)dup_; if (dup_) __syncthreads();     unsigned char* ws = ARG_WS(); const bf16* BIG = (const bf16*)(ws + WS_BIG);
                    const float *lng = ARG(gmlp_ln_g), *lnb = ARG(gmlp_ln_b), *wsp = ARG(gmlp_w_s), *bsp = ARG(gmlp_b_s);
                    for (int u = F.vcu; u < 256; u += F.G) gate_prompt_unit(F, u >> 7, (u >> 2) & 31, u & 3, BIG + BIG_ZU / 2, BIG + BIG_ZV / 2, (const long long*)(ws + WS_CTL + CTL_ZVSTAT), lng, lnb, wsp, bsp, (bf16*)(ws + WS_CAT)); } }
                  } else {
                if (EN(4)) { for (int rep_ = 0; rep_ < REPS(4); ++rep_) { PHASE_FRAME; const Frame& F = P; const bool dup_ = (rep_ != 0); (void)dup_; if (dup_) __syncthreads();     unsigned char* ws = ARG_WS(); float* out = ARG_OUT(); const bf16* BIG = (const bf16*)(ws + WS_BIG); const float *ck = ARG(cache_swa_k), *cv = ARG(cache_swa_v), *sinks = ARG(swa_sinks);
                    for (int u = F.vcu; u < 256; u += F.G) swa_sample_unit(F, u >> 1, u & 1, BIG + BIG_Q / 2, BIG + BIG_K / 2, BIG + BIG_V / 2, ck, cv, sinks, (bf16*)(ws + WS_CAT), out + O_SKS, out + O_SVS); } }
                if (EN(5)) { for (int rep_ = 0; rep_ < REPS(5); ++rep_) { PHASE_FRAME; const Frame& F = P; const bool dup_ = (rep_ != 0); (void)dup_; if (dup_) __syncthreads();     unsigned char* ws = ARG_WS(); float* out = ARG_OUT(); const bf16* BIG = (const bf16*)(ws + WS_BIG);
                    const float *lng = ARG(gmlp_ln_g), *lnb = ARG(gmlp_ln_b), *wsp = ARG(gmlp_w_s), *bsp = ARG(gmlp_b_s);
                    for (int u = F.vcu; u < 128; u += F.G) gate_sample_unit(F, u, BIG + BIG_ZU / 2, BIG + BIG_ZV / 2, (const long long*)(ws + WS_CTL + CTL_ZVSTAT), lng, lnb, wsp, bsp, (bf16*)(ws + WS_CAT), out + O_GV); } }
                  }
                }
            }
            SEAM(pb + 1);
            if (EN(6) && IN(pb + 3)) { for (int rep_ = 0; rep_ < REPS(6); ++rep_) { PHASE_FRAME; const Frame& F = P; const bool dup_ = (rep_ != 0); (void)dup_; if (dup_) __syncthreads();
                unsigned char* ws = ARG_WS();
                pg8::Gemm g{(const bf16*)(ws + WS_CAT), (const bf16*)(ws + WT_ABOUT), M, D, D}; pg8::PanelK S; S.init(D, F.G, F.vcu);
                pg8::EpiPart E{(bf16*)(ws + WS_Y0), (bf16*)(ws + WS_Y1)};
                pg8::gemm_phase<pg8::EpiPart, pg8::PanelK, true, true>(F.lds, g, S, E);
            } }
        } else {
            if (EN(7) && IN(pb + 0)) { for (int rep_ = 0; rep_ < REPS(7); ++rep_) { PHASE_FRAME; const Frame& F = P; const bool dup_ = (rep_ != 0); (void)dup_; if (dup_) __syncthreads();
                unsigned char* ws = ARG_WS();
                pg8::Gemm g{(const bf16*)(ws + WS_XB), (const bf16*)(ws + WT_RETIN), M, RET_IN, D}; pg8::StaticOrder S; S.init(M, RET_IN, D, F.G, (int)blockIdx.x);
                pg8::EpiRetIn E{(bf16*)(ws + WS_BIG), (const float*)(ws + WS_RS)};
                pg8::gemm_phase<pg8::EpiRetIn, pg8::StaticOrder, true, true>(F.lds, g, S, E);
            } }
            SEAM(pb + 0);
            if (IN(pb + 1)) {
                const int bx = blockIdx.x; const bool halves = (F0.G % 16 == 0);
                const int role = halves ? ((bx >> 3) & 1) : 0, rank = halves ? ((bx & 7) + 8 * (bx >> 4)) : bx, nrole0 = halves ? F0.G / 2 : F0.G;
                if (EN(9) && role == 0) { for (int rep_ = 0; rep_ < REPS(9); ++rep_) { PHASE_FRAME; const Frame& F = P; const bool dup_ = (rep_ != 0); (void)dup_; if (dup_) __syncthreads();     unsigned char* ws = ARG_WS(); float* out = ARG_OUT();
                    for (int u = rank; u < 128; u += nrole0) ret_prompt_scan(F, u >> 6, (u >> 3) & 7, u & 7, (const bf16*)(ws + WS_BIG), (bf16*)(ws + WS_OR), DUMMY(unsigned long long*, (unsigned long long*)(ws + WS_CTL + CTL_SS)), out + O_RP); } }
                if (EN(8)) { for (int rep_ = 0; rep_ < REPS(8); ++rep_) { PHASE_FRAME; const Frame& F = P; const bool dup_ = (rep_ != 0); (void)dup_; if (dup_) __syncthreads();     unsigned char* ws = ARG_WS(); float* out = ARG_OUT(); const float* st = ARG(state_ret);
                    unsigned* qctr = (unsigned*)(ws + WS_CTL + CTL_QUEUE) + (dup_ ? 64 : 0); volatile LAS unsigned* qw = (volatile LAS unsigned*)(F.lds + MISC_OFF + 64);
                    for (;;) {
                        if (F.tid == 0) qw[0] = atomicAdd(qctr, 1u);
                        __syncthreads();
                        const unsigned pss = (unsigned)__builtin_amdgcn_readfirstlane((int)qw[0]);
                        __syncthreads();
                        if (pss >= 512u) break;
                        ret_sample_pass(F, (int)pss * 2, (const bf16*)(ws + WS_BIG), st, out + O_RS, (bf16*)(ws + WS_OR), DUMMY(unsigned long long*, (unsigned long long*)(ws + WS_CTL + CTL_SS))); } } }
            }
            SEAM(pb + 1);
            if (EN(10) && IN(pb + 2)) { for (int rep_ = 0; rep_ < REPS(10); ++rep_) { PHASE_FRAME; const Frame& F = P; const bool dup_ = (rep_ != 0); (void)dup_; if (dup_) __syncthreads();     unsigned char* ws = ARG_WS(); ret_norm_rows<3>(F, (const bf16*)(ws + WS_OR), (const bf16*)(ws + WS_BIG), (const unsigned long long*)(ws + WS_CTL + CTL_SS), (bf16*)(ws + WS_CAT)); } }
            SEAM(pb + 2);
            if (EN(11) && IN(pb + 3)) { for (int rep_ = 0; rep_ < REPS(11); ++rep_) { PHASE_FRAME; const Frame& F = P; const bool dup_ = (rep_ != 0); (void)dup_; if (dup_) __syncthreads();
                unsigned char* ws = ARG_WS();
                pg8::Gemm g{(const bf16*)(ws + WS_CAT), (const bf16*)(ws + WT_RETOUT), M, D, 4096}; pg8::PanelK S; S.init(4096, F.G, F.vcu);
                pg8::EpiPart E{(bf16*)(ws + WS_Y0), (bf16*)(ws + WS_Y1)};
                pg8::gemm_phase<pg8::EpiPart, pg8::PanelK, true, true>(F.lds, g, S, E);
            } }
        }
        SEAM(pb + 3);
        if (EN(12) && IN(pb + 4)) { for (int rep_ = 0; rep_ < REPS(12); ++rep_) { PHASE_FRAME; const Frame& F = P; const bool dup_ = (rep_ != 0); (void)dup_; if (dup_) __syncthreads();
            unsigned char* ws = ARG_WS(); float* X = ARG_OUT() + O_X;
            pg8::PanelK S; S.init(layer == 0 ? D : 4096, F.G, 0);
            bf16* XB = (bf16*)(ws + WS_XB); (void)X;
            norm_rows<true, 4>(F, nullptr, nullptr, XB, (const bf16*)(ws + WS_Y0), (const bf16*)(ws + WS_Y1), S.splits, ARG(norm_mix_post) + (size_t)layer * D, DUMMY(float*, (float*)(ws + WS_RS)), nullptr, DUMMY(bf16*, XB));
        } }
        SEAM(pb + 4);
        if (IN(pb + 5)) {
            if (EN(13)) { for (int rep_ = 0; rep_ < REPS(13); ++rep_) { PHASE_FRAME; const Frame& F = P; const bool dup_ = (rep_ != 0); (void)dup_; if (dup_) __syncthreads();     unsigned char* ws = ARG_WS();
              pg8::Gemm g{(const bf16*)(ws + WS_XB), (const bf16*)(ws + WT_MEMQ) + (size_t)layer * MEMW * D, M, MEMW, D}; pg8::SplitK2 S; S.init(D, F.G, (int)blockIdx.x);
              pg8::EpiBf16<0> E{(bf16*)(ws + WS_QM), MEMW, (const float*)(ws + WS_RS), QSEG};
              pg8::gemm_phase<pg8::EpiBf16<0>, pg8::SplitK2, true, true>(F.lds, g, S, E); } }
            if (EN(14) && layer == 0) { for (int rep_ = 0; rep_ < REPS(14); ++rep_) { PHASE_FRAME; const Frame& F = P; const bool dup_ = (rep_ != 0); (void)dup_; if (dup_) __syncthreads();     unsigned char* ws = ARG_WS(); float* out = ARG_OUT();
                pg8::Gemm g{(const bf16*)(ws + WS_HM), (const bf16*)(ws + WT_MEMKV), 1024, 2048, D}; pg8::MemKVOrder S{F.G, (int)((blockIdx.x + F.G - (144 % F.G)) % F.G)};
                pg8::EpiMemKV E{out + O_MK, out + O_MV, (bf16*)(ws + WS_MKV)};
                pg8::gemm_phase<pg8::EpiMemKV, pg8::MemKVOrder, true, true>(F.lds, g, S, E);
            } }
            if (EN(22)) { for (int rep_ = 0; rep_ < REPS(22); ++rep_) { PHASE_FRAME; const Frame& F = P; const bool dup_ = (rep_ != 0); if (dup_) __syncthreads(); unsigned char* ws = ARG_WS();
                unsigned* tq = (unsigned*)(ws + WS_CTL + CTL_TQ) + layer * 64 + (dup_ ? 128 : 0); LAS float* scr = (LAS float*)(F.lds + F.wave * 16640);
                const int n_up = (D / 64) * (FF / 64), n_dn = (layer == 0) ? n_up : 0, n_ro = (layer == 0) ? (4096 / 64) * (D / 64) : 0, n_all = n_up + n_dn + n_ro;
                const float* w_up = ARG(w_ffn_up) + (size_t)layer * D * FF; const float* w_dn = ARG(w_ffn_down) + (size_t)layer * FF * D; const float* w_ro = ARG(w_ret_out); const float* g_up = ARG(norm_ffn_pre) + (size_t)layer * D;
                volatile LAS unsigned* tqw = (volatile LAS unsigned*)(F.lds + MISC_OFF + 96);
#define TQ_RUN(qi, Wp, K_, N_, WTp, Gp, LDW, NIT) do { const int nit_ = (NIT); const float* W_ = (Wp); bf16* WT_ = (bf16*)(WTp); const float* G_ = (Gp); \
                    for (;;) { if (F.tid == 0) tqw[0] = atomicAdd(tq + (qi) * 16, 64u); __syncthreads(); const int base = __builtin_amdgcn_readfirstlane((int)tqw[0]); __syncthreads(); if (base >= nit_) break; \
                        transpose_strided(W_, K_, N_, WT_, scr, base + F.wave, 8, (base + 64 < nit_) ? base + 64 : nit_, F.lane, G_, (LDW)); } } while (0)
                TQ_RUN(0, w_up, D, FF, ws + WT_UP + (size_t)layer * FF * D * 2, g_up, 0, n_up);
                if (layer == 0) { TQ_RUN(1, w_dn, FF, D, ws + WS_WTD, (const float*)nullptr, LDFF, n_dn); TQ_RUN(2, w_ro, 4096, D, ws + WT_RETOUT, (const float*)nullptr, 0, n_ro); }
#undef TQ_RUN
                (void)n_all; } }
        }
        SEAM(pb + 5);
        if (IN(pb + 6)) {
            { const bool sample_first = ((blockIdx.x >> 3) & 1) != 0;
#pragma unroll 1
              for (int step = 0; step < 2; ++step) {
                  if ((step == 0) != sample_first) { if (EN(15)) { PHASE_FRAME; const Frame& F = P; unsigned char* ws = ARG_WS();
                      for (int u = F.vcu; u < 256; u += F.G) mem_prompt_unit(F, u >> 7, (u >> 5) & 3, u & 31, (const bf16*)(ws + WS_QM), (const bf16*)(ws + WS_MKV) + (size_t)layer * 512 * 1024, (bf16*)(ws + WS_OM)); } }
                  else { if (EN(16)) { PHASE_FRAME; const Frame& F = P; unsigned char* ws = ARG_WS(); const float* ck = ARG(cache_mem_k) + (size_t)layer * NS * 256 * 512; const float* cv = ARG(cache_mem_v) + (size_t)layer * NS * 256 * 512;
                      mem_sample_units(F, F.vcu, F.G, (const bf16*)(ws + WS_QM), ck, cv, (bf16*)(ws + WS_OM)); } } } }
        }
        SEAM(pb + 6);
        if (EN(17) && IN(pb + 7)) { for (int rep_ = 0; rep_ < REPS(17); ++rep_) { PHASE_FRAME; const Frame& F = P; const bool dup_ = (rep_ != 0); (void)dup_; if (dup_) __syncthreads();
            unsigned char* ws = ARG_WS();
            pg8::Gemm g{(const bf16*)(ws + WS_OM), (const bf16*)(ws + WT_MEMO) + (size_t)layer * D * MEMW, M, D, MEMW}; pg8::PanelK S; S.init(MEMW, F.G, F.vcu);
            pg8::EpiPart E{(bf16*)(ws + WS_Y0), (bf16*)(ws + WS_Y1)};
            pg8::gemm_phase<pg8::EpiPart, pg8::PanelK, true, true>(F.lds, g, S, E);
        } }
        SEAM(pb + 7);
        if (EN(18) && IN(pb + 8)) { for (int rep_ = 0; rep_ < REPS(18); ++rep_) { PHASE_FRAME; const Frame& F = P; const bool dup_ = (rep_ != 0); (void)dup_; if (dup_) __syncthreads();     unsigned char* ws = ARG_WS(); float* X = ARG_OUT() + O_X;
            bf16* XB = (bf16*)(ws + WS_XB); (void)X;
            norm_rows<true, 4>(F, nullptr, nullptr, XB, (const bf16*)(ws + WS_Y0), (const bf16*)(ws + WS_Y1), 4, ARG(norm_x_post) + (size_t)layer * D, DUMMY(float*, (float*)(ws + WS_RS)), nullptr, DUMMY(bf16*, XB)); } }
        SEAM(pb + 8);
        if (EN(19) && IN(pb + 9)) { for (int rep_ = 0; rep_ < REPS(19); ++rep_) { PHASE_FRAME; const Frame& F = P; const bool dup_ = (rep_ != 0); (void)dup_; if (dup_) __syncthreads();
            unsigned char* ws = ARG_WS();
            pg8::Gemm g{(const bf16*)(ws + WS_XB), (const bf16*)(ws + WT_UP) + (size_t)layer * FF * D, M, FF, D}; pg8::StaticOrder S; S.init(M, FF, D, F.G, (int)blockIdx.x);
            pg8::EpiBf16<2> E{(bf16*)(ws + WS_BIG), LDFF, (const float*)(ws + WS_RS)};
            pg8::gemm_phase<pg8::EpiBf16<2>, pg8::StaticOrder, true, true>(F.lds, g, S, E);
            { const int c0 = (F.G > 128) ? 128 : 0;
              if (layer == 0) IDLE_TJOB(c0, ARG(w_ret_in), ws + WT_RETIN, D, RET_IN, ARG(norm_mix_pre) + D, 0);
              else IDLE_TJOB(c0, ARG(w_ffn_down) + (size_t)FF * D, ws + WS_WTD + (size_t)D * LDFF * 2, FF, D, (const float*)nullptr, LDFF); }
        } }
        SEAM(pb + 9);
        if (EN(20) && IN(pb + 10)) { for (int rep_ = 0; rep_ < REPS(20); ++rep_) { PHASE_FRAME; const Frame& F = P; const bool dup_ = (rep_ != 0); (void)dup_; if (dup_) __syncthreads();
            unsigned char* ws = ARG_WS();
            pg8::Gemm g{(const bf16*)(ws + WS_BIG), (const bf16*)(ws + WS_WTD) + (size_t)layer * D * LDFF, M, D, FF, LDFF, LDFF}; pg8::PanelK S; S.init(FF, F.G, F.vcu);
            pg8::EpiPart E{(bf16*)(ws + WS_Y0), (bf16*)(ws + WS_Y1)};
            pg8::gemm_phase<pg8::EpiPart, pg8::PanelK, true, true>(F.lds, g, S, E);
        } }
        SEAM(pb + 10);
        if (EN(21) && IN(pb + 11)) { for (int rep_ = 0; rep_ < REPS(21); ++rep_) { PHASE_FRAME; const Frame& F = P; const bool dup_ = (rep_ != 0); (void)dup_; if (dup_) __syncthreads();     unsigned char* ws = ARG_WS(); float* X = ARG_OUT() + O_X;
            pg8::PanelK S; S.init(FF, F.G, 0);
            bf16* XB = (bf16*)(ws + WS_XB);
            norm_rows<true, 4>(F, nullptr, nullptr, XB, (const bf16*)(ws + WS_Y0), (const bf16*)(ws + WS_Y1), S.splits, ARG(norm_ffn_post) + (size_t)layer * D, layer == 0 ? DUMMY(float*, (float*)(ws + WS_RS)) : (float*)nullptr,
                            layer == 0 ? (float*)nullptr : DUMMY(float*, X), layer == 0 ? DUMMY(bf16*, XB) : (bf16*)nullptr); } }
        if (layer == 0) SEAM(pb + 11);
    }
#undef IN
#undef SEAM
}

#ifndef MK_N_LAUNCHES
#define MK_N_LAUNCHES 1
#endif
extern "C" void kernel_launch(void* const* d_in, const int* in_sizes, int n_in, void* d_out, int out_size, void* d_ws, size_t ws_size, hipStream_t stream) {
    static int grid = 0;
    if (grid == 0) {
        if (n_in != 30 || out_size != (int)O_END || ws_size < WS_END) { fprintf(stderr, "kernel_launch: unexpected shapes (n_in %d, out %d, ws %zu)\n", n_in, out_size, ws_size); grid = -1; return; }
        int dev = 0, cus = 0, per_cu = 0;
        if (hipGetDevice(&dev) != hipSuccess || hipDeviceGetAttribute(&cus, hipDeviceAttributeMultiprocessorCount, dev) != hipSuccess) { grid = -1; return; }
        if (hipFuncSetAttribute((const void*)fwd, hipFuncAttributeMaxDynamicSharedMemorySize, LDS_BYTES) != hipSuccess) { fprintf(stderr, "kernel_launch: hipFuncSetAttribute failed\n"); grid = -1; return; }
        if (hipOccupancyMaxActiveBlocksPerMultiprocessor(&per_cu, (const void*)fwd, NTHR, LDS_BYTES) != hipSuccess || per_cu < 1) fprintf(stderr, "kernel_launch: occupancy query says %d\n", per_cu);
        (void)hipGetLastError();
        grid = cus;
    }
    if (grid < 0) return;
    (void)hipMemsetAsync((char*)d_ws + WS_CTL, 0, CTL_ZERO_BYTES, stream);
    Args a{};
    const float** p = (const float**)&a;
    for (int i = 0; i < 30; ++i) p[i] = (const float*)d_in[i];
    a.out = (float*)d_out; a.ws = (unsigned char*)d_ws; a.pad = 0;
    for (int li = 0; li < MK_N_LAUNCHES; ++li) {
        a.ph_lo = (MK_N_LAUNCHES == 1) ? 0 : li; a.ph_hi = (MK_N_LAUNCHES == 1) ? N_PHASES : li + 1; a.li = li;
        hipLaunchKernelGGL(fwd, dim3(grid), dim3(NTHR), LDS_BYTES, stream, a);
    }
}
```

```cpp
#include <hip/hip_runtime.h>
#include <cstdio>
#include <cstdint>

namespace pg8 {
#define PG8_LAS __attribute__((address_space(3)))
typedef unsigned short bf16_t;
typedef short bf16x8 __attribute__((ext_vector_type(8)));
typedef float f32x4 __attribute__((ext_vector_type(4)));
typedef unsigned u32x4 __attribute__((ext_vector_type(4)));
typedef unsigned u32x2 __attribute__((ext_vector_type(2)));
constexpr int BM = 256, BK = 64, HALF = 128, HTB = HALF * BK * 2  , STAGE_BYTES = 8 * HTB, NXCD = 8, WGM = 8;

__host__ __device__ __forceinline__ int lds_byte(int r, int c) { const int st = (r >> 4) * 2 + (c >> 5), rr = r & 15, cc = c & 31, ob = rr * 64 + cc * 2; return st * 1024 + (ob ^ (((ob >> 9) & 1) << 5)); }
__host__ __device__ __forceinline__ void stage_rc(int b, int& R, int& C) { const int st = b / 1024, sb = b % 1024, swz = sb ^ (((sb >> 9) & 1) << 5); R = (st >> 1) * 16 + swz / 64; C = (st & 1) * 32 + (swz % 64) / 2; }
__host__ __device__ __forceinline__ int perm32(int rho) { const int n = rho >> 4, i = rho & 15; return 8 * (i >> 2) + 4 * n + (i & 3); }

struct Unit { int pm, pn, kt0, nkt; };
struct Gemm { const bf16_t* A; const bf16_t* Bt; int M, N, K; int lda = 0, ldb = 0; };

struct StaticOrder {
    int nM, nN, nwg, G, c, nkt;
    __device__ void init(int M, int N, int K, int G_, int c_) { nM = M / BM; nN = N / BM; nwg = nM * nN; G = G_; c = c_; nkt = K / BK; }
    __device__ bool next(int i, Unit& u) const {
        const int L = i * G + c; if (L >= nwg) return false;
        int wgid = L; { const int q = nwg >> 3, r = nwg & 7, xcd = wgid & 7, off = wgid >> 3; wgid = (xcd < r ? xcd * (q + 1) : r * (q + 1) + (xcd - r) * q) + off; }
        const int nig = WGM * nN, gid = wgid / nig, rem = wgid - gid * nig, fm = gid * WGM; const bool full = (nM - fm) >= WGM;
        u.pm = fm + (full ? (rem & 7) : (rem & 3)); u.pn = full ? (rem >> 3) : (rem >> 2); u.kt0 = 0; u.nkt = nkt; return true;
    }
};
struct StreamK {
    int dpu, nN, w; long S, total;
    __device__ void init(int M, int N, int K, int G_, int w_) { dpu = K / (2 * BK); nN = N / BM; total = (long)(M / BM) * nN * dpu; S = (total + G_ - 1) / G_; w = w_; }
    __device__ bool next(int i, Unit& u) const {
        long pos = (long)w * S; long end = pos + S; if (end > total) end = total;
        for (int k = 0;; ++k) {
            if (pos >= end) return false;
            const int un = (int)(pos / dpu), off = (int)(pos % dpu); long len = dpu - off; if (len > end - pos) len = end - pos;
            if (k == i) { u.pm = un / nN; u.pn = un % nN; u.kt0 = 2 * off; u.nkt = 2 * (int)len; return true; }
            pos += len;
        }
    }
    __device__ static bool split(int pm, int pn, int nN_, int dpu_, long S_) { const long a = (long)(pm * nN_ + pn) * dpu_; return (a / S_) != ((a + dpu_ - 1) / S_); }
};

struct SplitK2 {
    int G, c, nkt;
    __device__ void init(int K, int G_, int c_) { G = G_; c = c_; nkt = K / BK; }
    __device__ bool next(int i, Unit& u) const { const int idx = i * G + c; if (idx >= 144) return false; const int un = idx >> 1; u.pm = un >> 1; u.pn = un & 1; u.kt0 = (idx & 1) * (nkt >> 1); u.nkt = nkt >> 1; return true; }
};
struct PanelK {
    int w, G, nkt, ls;
    int splits;
    __device__ void init(int K, int G_, int w_) { w = w_; G = G_; nkt = K / BK; ls = (nkt >= 16) ? 3 : 2; splits = 1 << ls; }
    __device__ bool next(int i, Unit& u) const {
        int np = 0; for (int x = w; x < 256; x += G) ++np;
        if (i < np) { const int un = w + i * G; u.pm = un >> 3; u.pn = un & 7; u.kt0 = 0; u.nkt = nkt; return true; }
        const int idx = w + (i - np) * G; if (idx >= (32 << ls)) return false;
        const int ns = nkt >> ls, seg = (idx >> 3) & (splits - 1);
        u.pm = 32 + (idx >> (3 + ls)); u.pn = idx & 7; u.kt0 = seg * ns; u.nkt = ns; return true;
    }
};

typedef float f32x2_cv __attribute__((ext_vector_type(2))); typedef __bf16 bf16x2_cv __attribute__((ext_vector_type(2)));
__device__ __forceinline__ unsigned cvt_pk_bf16(float lo, float hi) { const f32x2_cv v = {lo, hi}; const bf16x2_cv b = __builtin_convertvector(v, bf16x2_cv); return __builtin_bit_cast(unsigned, b); }

constexpr int MROWS = 9216, NPROMPT = 8192, SEQ = 4096;
__device__ __forceinline__ float pos_of_row(int row) { return (float)(row < NPROMPT ? (row & (SEQ - 1)) : 8192 + ((row - NPROMPT) & 7)); }
__device__ __forceinline__ float rope_inv_turns(int i, float inv_half_log2theta) { return __builtin_amdgcn_exp2f(-(float)i * inv_half_log2theta) * 0.15915494309189535f; }
__device__ __forceinline__ void sincos_turns(float t, float& sn, float& cs) { const float f = __builtin_amdgcn_fractf(t); sn = __builtin_amdgcn_sinf(f); cs = __builtin_amdgcn_cosf(f); }
__device__ __forceinline__ float gelu_tanh(float x) {
    const float u = 0.7978845608028654f * (x + 0.044715f * x * x * x);
    return x * __builtin_amdgcn_rcpf(1.0f + __builtin_amdgcn_exp2f(-2.885390081777927f * u));
}
__device__ __forceinline__ float silu_f(float x) { return x * __builtin_amdgcn_rcpf(1.0f + __builtin_amdgcn_exp2f(-1.4426950408889634f * x)); }
__device__ __forceinline__ u32x4 pack8(const f32x4& a, const f32x4& b) { u32x4 w; w.x = cvt_pk_bf16(a[0], a[1]); w.y = cvt_pk_bf16(a[2], a[3]); w.z = cvt_pk_bf16(b[0], b[1]); w.w = cvt_pk_bf16(b[2], b[3]); return w; }

struct EpiPart {
    static constexpr bool PERM = true, AFTER_DRAIN = false;
    bf16_t* Y; bf16_t* P;
    __device__ __forceinline__ void operator()(const f32x4 (&acc)[2][2][4][2], const Unit& u, int wr, int wc, int fr, int fq) const {
        bf16_t* base = (u.pm < 32) ? Y + (size_t)u.pm * BM * 2048 : P + ((size_t)(u.kt0 >> __builtin_ctz(u.nkt)) * 1024 + (size_t)(u.pm - 32) * BM) * 2048;
        const int col0 = u.pn * BM + wc * 32 + 8 * fq;
#pragma unroll
        for (int ai = 0; ai < 2; ++ai)
#pragma unroll
            for (int m = 0; m < 4; ++m) { bf16_t* rowp = base + (size_t)(ai * HALF + wr * 64 + m * 16 + fr) * 2048 + col0;
#pragma unroll
                for (int bj = 0; bj < 2; ++bj) *(u32x4*)(rowp + bj * HALF) = pack8(acc[ai][bj][m][0], acc[ai][bj][m][1]);
                if (m == 3) asm volatile("" ::: "memory"); }
    }
};
template <int ACT> struct EpiBf16 {
    static constexpr bool PERM = true, AFTER_DRAIN = false;
    bf16_t* O; int ldc; const float* rs;
    size_t seg_stride = 0;
    __device__ __forceinline__ void operator()(const f32x4 (&acc)[2][2][4][2], const Unit& u, int wr, int wc, int fr, int fq) const {
        const int col0 = u.pn * BM + wc * 32 + 8 * fq;
        float rsv[2][4];
#pragma unroll
        for (int ai = 0; ai < 2; ++ai)
#pragma unroll
            for (int m = 0; m < 4; ++m) rsv[ai][m] = rs[u.pm * BM + ai * HALF + wr * 64 + m * 16 + fr];
#pragma unroll
        for (int ai = 0; ai < 2; ++ai)
#pragma unroll
            for (int m = 0; m < 4; ++m) { const int row = u.pm * BM + ai * HALF + wr * 64 + m * 16 + fr; const float scale = rsv[ai][m]; bf16_t* rowp = O + (u.kt0 ? seg_stride : 0) + (size_t)row * ldc + col0;
#pragma unroll
                for (int bj = 0; bj < 2; ++bj) { f32x4 v0 = acc[ai][bj][m][0], v1 = acc[ai][bj][m][1];
                    if (ACT == 2) {
#pragma unroll
                        for (int e = 0; e < 4; ++e) { const float a = fmaxf(v0[e] * scale, 0.f), b = fmaxf(v1[e] * scale, 0.f); v0[e] = a * a; v1[e] = b * b; } }
                    else { v0 = v0 * scale; v1 = v1 * scale; }
                    *(u32x4*)(rowp + bj * HALF) = pack8(v0, v1); }
                if (m == 3) asm volatile("" ::: "memory"); }
    }
};
struct EpiAbIn {
    static constexpr bool PERM = true, AFTER_DRAIN = false;
    bf16_t* big; float* out;
    const float* rs;
    unsigned long long* zvstat;
    static constexpr size_t OQ = 0, OK = 9437184, OV = OK + 2359296, OZU = 14155776, OZV = 23592960;
    static constexpr size_t OKP = 18874368, OVP = 18939904, OKS = 19005440, OVS = 23199744;
    __device__ __forceinline__ void operator()(const f32x4 (&acc)[2][2][4][2], const Unit& u, int wr, int wc, int fr, int fq) const {
        const int pn = u.pn;
        bf16_t* const Q = big + OQ; bf16_t* const K = big + OK; bf16_t* const V = big + OV; bf16_t* const ZU = big + OZU; bf16_t* const ZV = big + OZV;
        float* const okp = out + OKP; float* const ovp = out + OVP; float* const oks = out + OKS; float* const ovs = out + OVS;
        float rsv[2][4];
#pragma unroll
        for (int ai = 0; ai < 2; ++ai)
#pragma unroll
            for (int m = 0; m < 4; ++m) rsv[ai][m] = rs[u.pm * BM + ai * HALF + wr * 64 + m * 16 + fr];
#pragma unroll
        for (int ai = 0; ai < 2; ++ai)
#pragma unroll
            for (int m = 0; m < 4; ++m) {
                const int row = u.pm * BM + ai * HALF + wr * 64 + m * 16 + fr; const float rsc = rsv[ai][m];
                if (pn < 5) {
                    const float pos = pos_of_row(row);
#pragma unroll
                    for (int bj = 0; bj < 2; ++bj) { f32x4 v0 = acc[ai][bj][m][0] * rsc, v1 = acc[ai][bj][m][1] * rsc;
                        if ((wc & 1) == 0) {
                            const float sg = (fq == 0) ? -1.f : 1.f;
#pragma unroll
                            for (int e = 0; e < 4; ++e) { const float p0 = __shfl_xor(v0[e], 16), p1 = __shfl_xor(v1[e], 16); float sn, cs;
                                constexpr float IT[8] = {1.591549431e-01f, 3.086376340e-02f, 5.985185713e-03f, 1.160663641e-03f, 2.250790790e-04f, 4.364795279e-05f, 8.464330808e-06f, 1.641426263e-06f};
                                sincos_turns(pos * IT[e], sn, cs); const float r0 = v0[e] * cs + sg * p0 * sn;
                                sincos_turns(pos * IT[4 + e], sn, cs); const float r1 = v1[e] * cs + sg * p1 * sn;
                                if (fq < 2) { v0[e] = r0; v1[e] = r1; } }
                        }
                        const int c = bj * HALF + wc * 32 + 8 * fq;
                        if (pn < 4) *(u32x4*)(Q + (size_t)row * 1024 + pn * BM + c) = pack8(v0, v1);
                        else { *(u32x4*)(K + (size_t)row * 256 + c) = pack8(v0, v1);
                            float* o = nullptr;
                            if (row < NPROMPT) { const int s = row & (SEQ - 1); if (s >= SEQ - 128) o = okp + ((size_t)(row >> 12) * 128 + (s - (SEQ - 128))) * 256 + c; }
                            else { const int r = row - NPROMPT; o = oks + ((size_t)(r >> 3) * 128 + 120 + (r & 7)) * 256 + c; }
                            if (o) { *(f32x4*)o = v0; *(f32x4*)(o + 4) = v1; } }
                    }
                } else if (pn == 5) {
#pragma unroll
                    for (int bj = 0; bj < 2; ++bj) { const f32x4 v0 = acc[ai][bj][m][0] * rsc, v1 = acc[ai][bj][m][1] * rsc; const int c = bj * HALF + wc * 32 + 8 * fq;
                        *(u32x4*)(V + (size_t)row * 256 + c) = pack8(v0, v1);
                        float* o = nullptr;
                        if (row < NPROMPT) { const int s = row & (SEQ - 1); if (s >= SEQ - 128) o = ovp + ((size_t)(row >> 12) * 128 + (s - (SEQ - 128))) * 256 + c; }
                        else { const int r = row - NPROMPT; o = ovs + ((size_t)(r >> 3) * 128 + 120 + (r & 7)) * 256 + c; }
                        if (o) { *(f32x4*)o = v0; *(f32x4*)(o + 4) = v1; } }
                } else {
                    float s1 = 0.f, s2 = 0.f;
#pragma unroll
                    for (int bj = 0; bj < 2; ++bj) { f32x4 v0 = acc[ai][bj][m][0] * rsc, v1 = acc[ai][bj][m][1] * rsc;
#pragma unroll
                        for (int e = 0; e < 4; ++e) { v0[e] = gelu_tanh(v0[e]); v1[e] = gelu_tanh(v1[e]); s1 += v0[e] + v1[e]; s2 += v0[e] * v0[e] + v1[e] * v1[e]; }
                        const int c = bj * HALF + wc * 32 + 8 * fq;
                        if (pn < 10) *(u32x4*)(ZU + (size_t)row * 1024 + (pn - 6) * BM + c) = pack8(v0, v1);
                        else *(u32x4*)(ZV + (size_t)row * 1024 + (pn - 10) * BM + c) = pack8(v0, v1); }
                    if (pn >= 10) { s1 += __shfl_xor(s1, 16); s1 += __shfl_xor(s1, 32); s2 += __shfl_xor(s2, 16); s2 += __shfl_xor(s2, 32);
                        if (fq == 0) { atomicAdd(zvstat + 2 * row, (unsigned long long)(long long)__float2ll_rn(s1 * 16777216.0f)); atomicAdd(zvstat + 2 * row + 1, (unsigned long long)(long long)__float2ll_rn(s2 * 16777216.0f)); } }
                }
                if (m & 1) asm volatile("" ::: "memory");
            }
    }
};
struct EpiRetIn {
    static constexpr bool PERM = true, AFTER_DRAIN = false;
    bf16_t* Z; const float* rs;
    __device__ __forceinline__ void operator()(const f32x4 (&acc)[2][2][4][2], const Unit& u, int wr, int wc, int fr, int fq) const {
        const int pn = u.pn;
        float rsv[2][4];
#pragma unroll
        for (int ai = 0; ai < 2; ++ai)
#pragma unroll
            for (int m = 0; m < 4; ++m) rsv[ai][m] = rs[u.pm * BM + ai * HALF + wr * 64 + m * 16 + fr];
#pragma unroll
        for (int ai = 0; ai < 2; ++ai)
#pragma unroll
            for (int m = 0; m < 4; ++m) {
                const int row = u.pm * BM + ai * HALF + wr * 64 + m * 16 + fr;
                bf16_t* rowp = Z + (size_t)row * 12288 + pn * BM + wc * 32 + 8 * fq;
                if (pn < 16) {
                    const float pos = pos_of_row(row); const int ib = wc * 32 + 8 * fq;
                    f32x4 cs[4];
#pragma unroll
                    for (int t = 0; t < 4; ++t) { float s0, c0, s1, c1; sincos_turns(pos * rope_inv_turns(ib + 2 * t, 0.10381025f), s0, c0); sincos_turns(pos * rope_inv_turns(ib + 2 * t + 1, 0.10381025f), s1, c1); cs[t] = (f32x4){c0, s0, c1, s1}; }
                    const float sc = ((pn >= 8) ? 0.0625f : 1.0f) * rsv[ai][m];
                    f32x4 a0 = acc[ai][0][m][0], a1 = acc[ai][0][m][1], b0 = acc[ai][1][m][0], b1 = acc[ai][1][m][1], r0, r1, q0, q1;
                    r0[0] = a0[0] * cs[0][0] - b0[0] * cs[0][1]; q0[0] = b0[0] * cs[0][0] + a0[0] * cs[0][1];
                    r0[1] = a0[1] * cs[0][2] - b0[1] * cs[0][3]; q0[1] = b0[1] * cs[0][2] + a0[1] * cs[0][3];
                    r0[2] = a0[2] * cs[1][0] - b0[2] * cs[1][1]; q0[2] = b0[2] * cs[1][0] + a0[2] * cs[1][1];
                    r0[3] = a0[3] * cs[1][2] - b0[3] * cs[1][3]; q0[3] = b0[3] * cs[1][2] + a0[3] * cs[1][3];
                    r1[0] = a1[0] * cs[2][0] - b1[0] * cs[2][1]; q1[0] = b1[0] * cs[2][0] + a1[0] * cs[2][1];
                    r1[1] = a1[1] * cs[2][2] - b1[1] * cs[2][3]; q1[1] = b1[1] * cs[2][2] + a1[1] * cs[2][3];
                    r1[2] = a1[2] * cs[3][0] - b1[2] * cs[3][1]; q1[2] = b1[2] * cs[3][0] + a1[2] * cs[3][1];
                    r1[3] = a1[3] * cs[3][2] - b1[3] * cs[3][3]; q1[3] = b1[3] * cs[3][2] + a1[3] * cs[3][3];
                    *(u32x4*)(rowp) = pack8(r0 * sc, r1 * sc); *(u32x4*)(rowp + HALF) = pack8(q0 * sc, q1 * sc);
                } else {
                    const float rsc = rsv[ai][m];
#pragma unroll
                    for (int bj = 0; bj < 2; ++bj) { f32x4 v0 = acc[ai][bj][m][0] * rsc, v1 = acc[ai][bj][m][1] * rsc;
                        if (pn >= 32) {
#pragma unroll
                            for (int e = 0; e < 4; ++e) { v0[e] = silu_f(v0[e]); v1[e] = silu_f(v1[e]); } }
                        *(u32x4*)(rowp + bj * HALF) = pack8(v0, v1); }
                }
                if (m == 3) asm volatile("" ::: "memory");
            }
    }
};
struct MemKVOrder {
    int G, c;
    __device__ bool next(int i, Unit& u) const { const int idx = i * G + c; if (idx >= 16) return false; u.pm = idx >> 2; u.pn = (u.pm >> 1) * 4 + (idx & 3); u.kt0 = 0; u.nkt = 32; return true; }
};
struct EpiMemKV {
    static constexpr bool PERM = false, AFTER_DRAIN = false;
    float* ok; float* ov; bf16_t* KV;
    __device__ __forceinline__ void operator()(const f32x4 (&acc)[2][2][4][2], const Unit& u, int wr, int wc, int fr, int fq) const {
        const int layer = u.pm >> 1, pn = u.pn & 3;
        const int col0 = pn * BM + wc * 32 + 4 * fq;
        float* o = ((pn < 2) ? ok : ov) + (size_t)layer * 512 * 512; const int cb = (pn < 2) ? col0 : col0 - 512;
        bf16_t* kv = KV + (size_t)layer * 512 * 1024;
#pragma unroll
        for (int ai = 0; ai < 2; ++ai)
#pragma unroll
            for (int m = 0; m < 4; ++m) { const int row = (u.pm & 1) * BM + ai * HALF + wr * 64 + m * 16 + fr;
#pragma unroll
                for (int bj = 0; bj < 2; ++bj)
#pragma unroll
                    for (int n = 0; n < 2; ++n) { const f32x4 v = acc[ai][bj][m][n]; const int c = bj * HALF + n * 16;
                        *(f32x4*)(o + (size_t)row * 512 + cb + c) = v;
                        u32x2 w; w.x = cvt_pk_bf16(v[0], v[1]); w.y = cvt_pk_bf16(v[2], v[3]); *(u32x2*)(kv + (size_t)row * 1024 + col0 + c) = w; }
                asm volatile("" ::: "memory"); }
    }
};

template <class Epi, class Sched, bool ALIGN_EPI = false, bool SP2 = false>
__device__ __forceinline__ void gemm_phase(PG8_LAS unsigned char* lds, const Gemm g, const Sched& S, const Epi& E) {
    int tid_ = threadIdx.x; asm volatile("" : "+v"(tid_));
    const int tid = tid_, wid = __builtin_amdgcn_readfirstlane(tid >> 6), lane = tid & 63, wr = wid >> 2, wc = wid & 3, fr = lane & 15, fq = lane >> 4;
    const int K = g.K, lda = g.lda ? g.lda : K, ldb = g.ldb ? g.ldb : K; int nt; (void)K;
    unsigned voffA[2], voffB[2];
#pragma unroll
    for (int i = 0; i < 2; ++i) { int R, C; stage_rc(tid * 16 + i * 8192, R, C); const int Rb = Epi::PERM ? ((R & ~31) + perm32(R & 31)) : R;
        voffA[i] = (unsigned)(R * lda + C) * 2u; voffB[i] = (unsigned)(Rb * ldb + C) * 2u; }
    const size_t kstep = (size_t)(BK * 2);
    const size_t hstepA = (size_t)HALF * lda * 2, hstepB = (size_t)HALF * ldb * 2;
    const size_t tstepA = 2 * hstepA, tstepB = 2 * hstepB;
    const unsigned ldsw = (unsigned)wid * 1024u;
    const int aoff = lds_byte(wr * 64 + fr, fq * 8), boff = lds_byte(wc * 32 + fr, fq * 8);
#define PG8_SA(b, h) (((b) * 2 + (h)) * HTB)
#define PG8_SB(b, h) ((4 + (b) * 2 + (h)) * HTB)
#define PG8_STAGE(bufoff, gbase, voff) do { _Pragma("unroll") for (int _i = 0; _i < 2; ++_i) \
        __builtin_amdgcn_global_load_lds((const unsigned*)((const char*)(gbase) + (voff)[_i]), (PG8_LAS unsigned*)(lds + (bufoff) + ldsw + _i * 8192), 16, 0, 0); } while (0)
#define PG8_LDA(dst, b, h) do { _Pragma("unroll") for (int m = 0; m < 4; ++m) _Pragma("unroll") for (int k = 0; k < 2; ++k) dst[m][k] = *(const PG8_LAS bf16x8*)(lds + PG8_SA(b, h) + aoff + m * 2048 + k * 1024); } while (0)
#define PG8_LDB(dst, b, h) do { _Pragma("unroll") for (int n = 0; n < 2; ++n) _Pragma("unroll") for (int k = 0; k < 2; ++k) dst[n][k] = *(const PG8_LAS bf16x8*)(lds + PG8_SB(b, h) + boff + n * 2048 + k * 1024); } while (0)
#define PG8_MMA(ai, bj, At, Bt) do { __builtin_amdgcn_s_setprio(1); _Pragma("unroll") for (int m = 0; m < 4; ++m) _Pragma("unroll") for (int n = 0; n < 2; ++n) _Pragma("unroll") for (int k = 0; k < 2; ++k) \
        acc[ai][bj][m][n] = __builtin_amdgcn_mfma_f32_16x16x32_bf16(Bt[n][k], At[m][k], acc[ai][bj][m][n], 0, 0, 0); __builtin_amdgcn_s_setprio(0); } while (0)
#define PG8_WAIT_V(n) asm volatile("s_waitcnt vmcnt(" #n ")" ::: "memory")
#define PG8_WAIT_L(n) asm volatile("s_waitcnt lgkmcnt(" #n ")" ::: "memory")
#define PG8_BAR __builtin_amdgcn_s_barrier()
#define PG8_SCHED __builtin_amdgcn_sched_barrier(0)
    Unit cur, nxt; int ui = 0;
    if (!S.next(0, cur)) return;
    f32x4 acc[2][2][4][2];
#pragma unroll
    for (int a = 0; a < 2; ++a)
#pragma unroll
        for (int b = 0; b < 2; ++b)
#pragma unroll
            for (int m = 0; m < 4; ++m)
#pragma unroll
                for (int n = 0; n < 2; ++n) acc[a][b][m][n] = (f32x4){0.f, 0.f, 0.f, 0.f};
    bf16x8 At[4][2], B0[2][2], B1[2][2];
    const char* cA = (const char*)g.A + (size_t)cur.pm * tstepA + (size_t)cur.kt0 * kstep; const char* cB = (const char*)g.Bt + (size_t)cur.pn * tstepB + (size_t)cur.kt0 * kstep; nt = cur.nkt;
    if constexpr (SP2) {
        PG8_STAGE(PG8_SB(0, 0), cB, voffB); PG8_STAGE(PG8_SB(0, 1), cB + hstepB, voffB); PG8_STAGE(PG8_SA(0, 0), cA, voffA); PG8_STAGE(PG8_SA(0, 1), cA + hstepA, voffA);
        if (wr == 1) PG8_BAR;
        PG8_WAIT_V(2); PG8_BAR;
        PG8_STAGE(PG8_SB(1, 0), cB + kstep, voffB); PG8_STAGE(PG8_SA(1, 0), cA + kstep, voffA); PG8_STAGE(PG8_SB(1, 1), cB + hstepB + kstep, voffB);
        PG8_WAIT_V(6); PG8_BAR;
    } else {
        PG8_STAGE(PG8_SB(0, 0), cB, voffB); PG8_STAGE(PG8_SA(0, 0), cA, voffA); PG8_STAGE(PG8_SB(0, 1), cB + hstepB, voffB); PG8_STAGE(PG8_SA(0, 1), cA + hstepA, voffA);
        if (wr == 1) PG8_BAR;
        PG8_WAIT_V(4); PG8_BAR;
        PG8_STAGE(PG8_SB(1, 0), cB + kstep, voffB); PG8_STAGE(PG8_SA(1, 0), cA + kstep, voffA); PG8_STAGE(PG8_SB(1, 1), cB + hstepB + kstep, voffB);
        PG8_WAIT_V(6); PG8_BAR;
    }
    for (;;) {
        const bool has_next = S.next(ui + 1, nxt);
        const char* nA = has_next ? (const char*)g.A + (size_t)nxt.pm * tstepA + (size_t)nxt.kt0 * kstep : cA; const char* nB = has_next ? (const char*)g.Bt + (size_t)nxt.pn * tstepB + (size_t)nxt.kt0 * kstep : cB;
        for (int t = 0; t < nt; t += 2) {
            const bool last = (t == nt - 2);
            const char* a1 = cA + (size_t)(t + 1) * kstep;
            const char* a2 = last ? nA : cA + (size_t)(t + 2) * kstep; const char* b2 = last ? nB : cB + (size_t)(t + 2) * kstep;
            const char* a3 = a2 + kstep; const char* b3 = b2 + kstep;
            if constexpr (SP2) {
            PG8_LDB(B0, 0, 0); PG8_LDB(B1, 0, 1); PG8_SCHED; PG8_LDA(At, 0, 0); PG8_STAGE(PG8_SA(1, 1), a1 + hstepA, voffA);
            PG8_WAIT_V(8); PG8_WAIT_L(0); PG8_BAR; PG8_MMA(0, 0, At, B0); PG8_MMA(0, 1, At, B1); PG8_BAR; PG8_SCHED;
            PG8_LDA(At, 0, 1); PG8_STAGE(PG8_SB(0, 0), b2, voffB); PG8_STAGE(PG8_SB(0, 1), b2 + hstepB, voffB); PG8_STAGE(PG8_SA(0, 0), a2, voffA);
            PG8_WAIT_V(8); PG8_WAIT_L(0); PG8_BAR; PG8_MMA(1, 0, At, B0); PG8_MMA(1, 1, At, B1); PG8_BAR; PG8_SCHED;
            PG8_LDB(B0, 1, 0); PG8_LDB(B1, 1, 1); PG8_SCHED; PG8_LDA(At, 1, 0); PG8_STAGE(PG8_SA(0, 1), a2 + hstepA, voffA);
            PG8_WAIT_V(8); PG8_WAIT_L(0); PG8_BAR; PG8_MMA(0, 0, At, B0); PG8_MMA(0, 1, At, B1); PG8_BAR; PG8_SCHED;
            PG8_LDA(At, 1, 1); PG8_STAGE(PG8_SB(1, 0), b3, voffB); PG8_STAGE(PG8_SB(1, 1), b3 + hstepB, voffB); PG8_STAGE(PG8_SA(1, 0), a3, voffA);
            PG8_WAIT_V(8); PG8_WAIT_L(0); PG8_BAR; PG8_MMA(1, 0, At, B0); PG8_MMA(1, 1, At, B1); PG8_BAR; PG8_SCHED;
            } else {
            PG8_LDB(B0, 0, 0); PG8_SCHED; PG8_LDA(At, 0, 0); PG8_STAGE(PG8_SA(1, 1), a1 + hstepA, voffA);
            PG8_WAIT_L(8); PG8_BAR; PG8_WAIT_L(0); PG8_MMA(0, 0, At, B0); PG8_BAR; PG8_SCHED;
            PG8_LDB(B1, 0, 1); PG8_STAGE(PG8_SB(0, 0), b2, voffB);
            PG8_BAR; PG8_WAIT_L(0); PG8_MMA(0, 1, At, B1); PG8_BAR;
            PG8_LDA(At, 0, 1); PG8_STAGE(PG8_SA(0, 0), a2, voffA);
            PG8_BAR; PG8_WAIT_L(0); PG8_MMA(1, 0, At, B0); PG8_BAR; PG8_SCHED;
            PG8_STAGE(PG8_SB(0, 1), b2 + hstepB, voffB);
            PG8_WAIT_V(6); PG8_BAR; PG8_MMA(1, 1, At, B1); PG8_BAR;
            PG8_LDB(B0, 1, 0); PG8_SCHED; PG8_LDA(At, 1, 0); PG8_STAGE(PG8_SA(0, 1), a2 + hstepA, voffA);
            PG8_WAIT_L(8); PG8_BAR; PG8_WAIT_L(0); PG8_MMA(0, 0, At, B0); PG8_BAR; PG8_SCHED;
            PG8_LDB(B1, 1, 1); PG8_STAGE(PG8_SB(1, 0), b3, voffB);
            PG8_BAR; PG8_WAIT_L(0); PG8_MMA(0, 1, At, B1); PG8_BAR;
            PG8_LDA(At, 1, 1); PG8_STAGE(PG8_SA(1, 0), a3, voffA);
            PG8_BAR; PG8_WAIT_L(0); PG8_MMA(1, 0, At, B0); PG8_BAR; PG8_SCHED;
            PG8_STAGE(PG8_SB(1, 1), b3 + hstepB, voffB);
            PG8_WAIT_V(6); PG8_BAR; PG8_MMA(1, 1, At, B1); PG8_BAR;
            }
        }
        if constexpr (ALIGN_EPI) { if (wr == 0) PG8_BAR; }
        if constexpr (!Epi::AFTER_DRAIN) { E(acc, cur, wr, wc, fr, fq); }
        if (!has_next) break;
#pragma unroll
        for (int a = 0; a < 2; ++a)
#pragma unroll
            for (int b = 0; b < 2; ++b)
#pragma unroll
                for (int m = 0; m < 4; ++m)
#pragma unroll
                    for (int n = 0; n < 2; ++n) acc[a][b][m][n] = (f32x4){0.f, 0.f, 0.f, 0.f};
        cur = nxt; cA = nA; cB = nB; ++ui; nt = cur.nkt;
        if constexpr (ALIGN_EPI) { if (wr == 1) PG8_BAR; }
    }
    PG8_WAIT_V(0);
    if constexpr (!ALIGN_EPI) { if (wr == 0) PG8_BAR; }
    PG8_BAR;
    if constexpr (Epi::AFTER_DRAIN) { E.fused(acc, cur, wr, wc, fr, fq, lds, wid, lane); }
#undef PG8_SA
#undef PG8_SB
#undef PG8_STAGE
#undef PG8_LDA
#undef PG8_LDB
#undef PG8_MMA
#undef PG8_WAIT_V
#undef PG8_WAIT_L
#undef PG8_BAR
#undef PG8_SCHED
}
}

#define GAS __attribute__((address_space(1)))
#define LAS __attribute__((address_space(3)))
typedef unsigned short bf16;
typedef short bf16x8 __attribute__((ext_vector_type(8)));
typedef short s16x4 __attribute__((ext_vector_type(4)));
typedef float f32x4 __attribute__((ext_vector_type(4)));
typedef float f32x2 __attribute__((ext_vector_type(2)));
typedef unsigned u32x4 __attribute__((ext_vector_type(4)));
typedef unsigned u32x2 __attribute__((ext_vector_type(2)));
typedef GAS unsigned gu32;

constexpr int D = 2048, M = 9216, NP = 8192, SEQ = 4096, NS = 128, TS = 8, FF = 8192;
constexpr int AB_IN = 3584, RET_IN = 12288, MEMW = 512;
constexpr float EPS = 1e-6f;
constexpr int NWAVES = 8, NTHR = 512;

__device__ __forceinline__ float bf2f(unsigned short b) { return __uint_as_float((unsigned)b << 16); }
__device__ __forceinline__ unsigned f2bf(float f) { unsigned u = __float_as_uint(f); return (u + 0x7fffu + ((u >> 16) & 1u)) >> 16; }
__device__ __forceinline__ unsigned pk2(float lo, float hi) { return pg8::cvt_pk_bf16(lo, hi); }
__device__ __forceinline__ float wave_sum(float v) {
#pragma unroll
    for (int o = 1; o < 64; o <<= 1) v += __shfl_xor(v, o);
    return v;
}
__device__ __forceinline__ f32x4 mfma16(bf16x8 a, bf16x8 b, f32x4 c) { return __builtin_amdgcn_mfma_f32_16x16x32_bf16(a, b, c, 0, 0, 0); }
__device__ __forceinline__ bf16x8 frag_nat(const LAS bf16* base, int stride, int row0, int k0, int lane) {
    return *(const LAS bf16x8*)(base + (row0 + (lane & 15)) * stride + k0 + 8 * (lane >> 4));
}
__device__ __forceinline__ bf16x8 frag_nat_perm(const LAS bf16* base, int stride, int row0, int k0, int lane) {
    const LAS bf16* a = base + (row0 + (lane & 15)) * stride + k0 + 4 * (lane >> 4);
    const u32x2 lo = *(const LAS u32x2*)a, hi = *(const LAS u32x2*)(a + 16);
    return __builtin_bit_cast(bf16x8, (u32x4){lo.x, lo.y, hi.x, hi.y});
}
__device__ __forceinline__ s16x4 tr4(const LAS bf16* p) { return __builtin_amdgcn_ds_read_tr16_b64_v4i16((LAS s16x4*)p); }
__device__ __forceinline__ bf16x8 frag_tr(const LAS bf16* base, int stride, int k0, int r0, int lane) {
    const LAS bf16* a = base + (k0 + 8 * (lane >> 4) + ((lane & 15) >> 2)) * stride + r0 + 4 * (lane & 3);
    const s16x4 lo = tr4(a), hi = tr4(a + 4 * stride);
    return (bf16x8){lo[0], lo[1], lo[2], lo[3], hi[0], hi[1], hi[2], hi[3]};
}
__device__ __forceinline__ bf16x8 frag_tr_perm(const LAS bf16* base, int stride, int k0, int r0, int lane) {
    const LAS bf16* a = base + (k0 + 4 * (lane >> 4) + ((lane & 15) >> 2)) * stride + r0 + 4 * (lane & 3);
    const s16x4 lo = tr4(a), hi = tr4(a + 16 * stride);
    return (bf16x8){lo[0], lo[1], lo[2], lo[3], hi[0], hi[1], hi[2], hi[3]};
}
__device__ __forceinline__ bf16x8 pack_p(const f32x4& a, const f32x4& b) {
    u32x4 w; w.x = pk2(a[0], a[1]); w.y = pk2(a[2], a[3]); w.z = pk2(b[0], b[1]); w.w = pk2(b[2], b[3]);
    return __builtin_bit_cast(bf16x8, w);
}
#define WG_SYNC() do { asm volatile("s_waitcnt lgkmcnt(0)" ::: "memory"); __builtin_amdgcn_s_barrier(); asm volatile("" ::: "memory"); } while (0)

struct Frame {
    LAS unsigned char* lds;
    int tid, lane, wave, vcu, G;
};

struct f32x8 { f32x4 lo, hi; };
__device__ __forceinline__ f32x8 bf8_to_f32(const u32x4 r) { f32x8 o; o.lo = (f32x4){__uint_as_float(r.x << 16), __uint_as_float(r.x & 0xffff0000u), __uint_as_float(r.y << 16), __uint_as_float(r.y & 0xffff0000u)};
    o.hi = (f32x4){__uint_as_float(r.z << 16), __uint_as_float(r.z & 0xffff0000u), __uint_as_float(r.w << 16), __uint_as_float(r.w & 0xffff0000u)}; return o; }
__device__ __forceinline__ u32x4 f32_to_bf8(const f32x8& v) { u32x4 w; w.x = pk2(v.lo[0], v.lo[1]); w.y = pk2(v.lo[2], v.lo[3]); w.z = pk2(v.hi[0], v.hi[1]); w.w = pk2(v.hi[2], v.hi[3]); return w; }
__device__ __forceinline__ float sumsq8(const f32x8& v) { return ((v.lo[0] * v.lo[0] + v.lo[1] * v.lo[1]) + (v.lo[2] * v.lo[2] + v.lo[3] * v.lo[3])) + ((v.hi[0] * v.hi[0] + v.hi[1] * v.hi[1]) + (v.hi[2] * v.hi[2] + v.hi[3] * v.hi[3])); }
template <bool HAS_Y, int NR>
__device__ __forceinline__ void norm_rows(const Frame& F, const float* xin_p, const float* xin_s, const bf16* xin_b, const bf16* Y0, const bf16* P, int splits, const float* gpost, float* rs_out, float* xout, bf16* xout_b) {
    const int gw = F.vcu * NWAVES + F.wave, NGW = F.G * NWAVES, lane = F.lane;
    for (int base = gw; base < NP; base += NR * NGW) {
        u32x4 xr[NR][4], yr[NR][4]; f32x8 xf[NR][4];
#pragma unroll
        for (int r = 0; r < NR; ++r) { const int row = base + r * NGW, rw = row < NP ? row : base;
            if (xin_b) {
#pragma unroll
                for (int j = 0; j < 4; ++j) xr[r][j] = __builtin_nontemporal_load((const u32x4*)(xin_b + (size_t)rw * D) + lane + 64 * j);
            } else {
#pragma unroll
                for (int j = 0; j < 4; ++j) { xf[r][j].lo = __builtin_nontemporal_load((const f32x4*)(xin_p + (size_t)rw * D) + 2 * (lane + 64 * j)); xf[r][j].hi = __builtin_nontemporal_load((const f32x4*)(xin_p + (size_t)rw * D) + 2 * (lane + 64 * j) + 1); }
            }
            if (HAS_Y) {
#pragma unroll
                for (int j = 0; j < 4; ++j) yr[r][j] = __builtin_nontemporal_load((const u32x4*)(Y0 + (size_t)rw * D) + lane + 64 * j); } }
#pragma unroll
        for (int r = 0; r < NR; ++r) { const int row = base + r * NGW; const bool ok = row < NP;
            f32x8 x[4];
#pragma unroll
            for (int j = 0; j < 4; ++j) x[j] = xin_b ? bf8_to_f32(xr[r][j]) : xf[r][j];
            if (HAS_Y) {
                f32x8 y[4]; float ss = 0.f;
#pragma unroll
                for (int j = 0; j < 4; ++j) { y[j] = bf8_to_f32(yr[r][j]); ss += sumsq8(y[j]); }
                const float rs = 1.0f / sqrtf(wave_sum(ss) * (1.0f / D) + EPS);
#pragma unroll
                for (int j = 0; j < 4; ++j) { const f32x4 g0 = ((const f32x4*)gpost)[2 * (lane + 64 * j)], g1 = ((const f32x4*)gpost)[2 * (lane + 64 * j) + 1];
                    x[j].lo += y[j].lo * rs * g0; x[j].hi += y[j].hi * rs * g1;
                    if (xout && ok) { __builtin_nontemporal_store(x[j].lo, (f32x4*)(xout + (size_t)row * D) + 2 * (lane + 64 * j)); __builtin_nontemporal_store(x[j].hi, (f32x4*)(xout + (size_t)row * D) + 2 * (lane + 64 * j) + 1); } }
            }
            if (xout_b) {
#pragma unroll
                for (int j = 0; j < 4; ++j) { const u32x4 w = f32_to_bf8(x[j]); if (ok) ((u32x4*)(xout_b + (size_t)row * D))[lane + 64 * j] = w; x[j] = bf8_to_f32(w); } }
            if (rs_out) { float ss = 0.f;
#pragma unroll
                for (int j = 0; j < 4; ++j) ss += sumsq8(x[j]);
                const float rs = 1.0f / sqrtf(wave_sum(ss) * (1.0f / D) + EPS);
                if (lane == 0 && ok) rs_out[row] = rs; }
        }
    }
    for (int row = NP + gw; row < M; row += NGW) {
        f32x8 x[4];
        if (xin_b) {
#pragma unroll
            for (int j = 0; j < 4; ++j) x[j] = bf8_to_f32(__builtin_nontemporal_load((const u32x4*)(xin_b + (size_t)row * D) + lane + 64 * j));
        } else {
#pragma unroll
            for (int j = 0; j < 4; ++j) { x[j].lo = __builtin_nontemporal_load((const f32x4*)(xin_s + (size_t)(row - NP) * D) + 2 * (lane + 64 * j)); x[j].hi = __builtin_nontemporal_load((const f32x4*)(xin_s + (size_t)(row - NP) * D) + 2 * (lane + 64 * j) + 1); }
        }
        if (HAS_Y) {
            f32x8 y[4];
#pragma unroll
            for (int j = 0; j < 4; ++j) { y[j].lo = (f32x4){0.f, 0.f, 0.f, 0.f}; y[j].hi = y[j].lo; }
            if (splits == 8) {
#pragma unroll
                for (int s = 0; s < 8; ++s)
#pragma unroll
                    for (int j = 0; j < 4; ++j) { const f32x8 v = bf8_to_f32(__builtin_nontemporal_load((const u32x4*)(P + ((size_t)s * 1024 + (row - NP)) * D) + lane + 64 * j)); y[j].lo += v.lo; y[j].hi += v.hi; }
            } else {
                for (int s = 0; s < splits; ++s)
#pragma unroll
                    for (int j = 0; j < 4; ++j) { const f32x8 v = bf8_to_f32(__builtin_nontemporal_load((const u32x4*)(P + ((size_t)s * 1024 + (row - NP)) * D) + lane + 64 * j)); y[j].lo += v.lo; y[j].hi += v.hi; }
            }
            float ss = 0.f;
#pragma unroll
            for (int j = 0; j < 4; ++j) ss += sumsq8(y[j]);
            const float rs = 1.0f / sqrtf(wave_sum(ss) * (1.0f / D) + EPS);
#pragma unroll
            for (int j = 0; j < 4; ++j) { const f32x4 g0 = ((const f32x4*)gpost)[2 * (lane + 64 * j)], g1 = ((const f32x4*)gpost)[2 * (lane + 64 * j) + 1];
                x[j].lo += y[j].lo * rs * g0; x[j].hi += y[j].hi * rs * g1;
                if (xout) { __builtin_nontemporal_store(x[j].lo, (f32x4*)(xout + (size_t)row * D) + 2 * (lane + 64 * j)); __builtin_nontemporal_store(x[j].hi, (f32x4*)(xout + (size_t)row * D) + 2 * (lane + 64 * j) + 1); } }
        }
        if (xout_b) {
#pragma unroll
            for (int j = 0; j < 4; ++j) { const u32x4 w = f32_to_bf8(x[j]); ((u32x4*)(xout_b + (size_t)row * D))[lane + 64 * j] = w; x[j] = bf8_to_f32(w); } }
        if (rs_out) { float ss = 0.f;
#pragma unroll
            for (int j = 0; j < 4; ++j) ss += sumsq8(x[j]);
            const float rs = 1.0f / sqrtf(wave_sum(ss) * (1.0f / D) + EPS);
            if (lane == 0) rs_out[row] = rs; }
    }
}

__device__ __forceinline__ void norm_finish_row(f32x8 (&x)[4], const f32x8 (&y)[4], int row, int lane, const float* gpost, float* rs_out, float* xout, bf16* xout_b) {
    float ss = 0.f;
#pragma unroll
    for (int j = 0; j < 4; ++j) ss += sumsq8(y[j]);
    const float rs = 1.0f / sqrtf(wave_sum(ss) * (1.0f / D) + EPS);
#pragma unroll
    for (int j = 0; j < 4; ++j) { const f32x4 g0 = ((const f32x4*)gpost)[2 * (lane + 64 * j)], g1 = ((const f32x4*)gpost)[2 * (lane + 64 * j) + 1];
        x[j].lo += y[j].lo * rs * g0; x[j].hi += y[j].hi * rs * g1;
        if (xout) { __builtin_nontemporal_store(x[j].lo, (f32x4*)(xout + (size_t)row * D) + 2 * (lane + 64 * j)); __builtin_nontemporal_store(x[j].hi, (f32x4*)(xout + (size_t)row * D) + 2 * (lane + 64 * j) + 1); }
        if (xout_b) { const u32x4 w = f32_to_bf8(x[j]); ((u32x4*)(xout_b + (size_t)row * D))[lane + 64 * j] = w; x[j] = bf8_to_f32(w); } }
    if (rs_out) { float s2 = 0.f;
#pragma unroll
        for (int j = 0; j < 4; ++j) s2 += sumsq8(x[j]);
        const float r2 = 1.0f / sqrtf(wave_sum(s2) * (1.0f / D) + EPS);
        if (lane == 0) rs_out[row] = r2; }
}
template <bool EARLY>
__device__ __forceinline__ void norm_rows_pipe(const Frame& F, const bf16* xin_b, const bf16* Y0, const bf16* P, int splits, const float* gpost, float* rs_out, float* xout, bf16* xout_b) {
    const int gw = F.vcu * NWAVES + F.wave, NGW = F.G * NWAVES, lane = F.lane, hf = F.wave & 1;
    LAS float* xs = (LAS float*)F.lds;
    int sb = F.vcu * 4;
    u32x4 sx[2], sp[8][2];
#define NS_LOAD_A() do { const int srow_ = sb + (F.wave >> 1); const size_t so_ = (size_t)(srow_ < 1024 ? srow_ : 0) * D; \
        _Pragma("unroll") for (int j = 0; j < 2; ++j) sx[j] = __builtin_nontemporal_load((const u32x4*)(xin_b + (size_t)NP * D + so_) + lane + 64 * (2 * hf + j)); \
        _Pragma("unroll") for (int s = 0; s < 4; ++s) _Pragma("unroll") for (int j = 0; j < 2; ++j) sp[s][j] = __builtin_nontemporal_load((const u32x4*)(P + (size_t)s * 1024 * D + so_) + lane + 64 * (2 * hf + j)); } while (0)
#define NS_LOAD_B() do { const int srow_ = sb + (F.wave >> 1); const size_t so_ = (size_t)(srow_ < 1024 ? srow_ : 0) * D; \
        _Pragma("unroll") for (int s = 4; s < 8; ++s) _Pragma("unroll") for (int j = 0; j < 2; ++j) sp[s][j] = (splits == 8) ? __builtin_nontemporal_load((const u32x4*)(P + (size_t)s * 1024 * D + so_) + lane + 64 * (2 * hf + j)) : (u32x4){0u, 0u, 0u, 0u}; } while (0)
#define NS_FINISH() do { NS_LOAD_B(); const int srow_ = sb + (F.wave >> 1); const bool ok_ = srow_ < 1024; const size_t ro_ = ((size_t)NP + (ok_ ? srow_ : 0)) * D; \
        f32x8 x[2], y[2]; float ss = 0.f; \
        _Pragma("unroll") for (int j = 0; j < 2; ++j) { x[j] = bf8_to_f32(sx[j]); y[j] = bf8_to_f32(sp[0][j]); \
            _Pragma("unroll") for (int s = 1; s < 8; ++s) { const f32x8 v = bf8_to_f32(sp[s][j]); y[j].lo += v.lo; y[j].hi += v.hi; } ss += sumsq8(y[j]); } \
        ss = wave_sum(ss); if (lane == 0) xs[F.wave] = ss; WG_SYNC(); \
        const float rs = 1.0f / sqrtf((xs[F.wave] + xs[F.wave ^ 1]) * (1.0f / D) + EPS); float s2 = 0.f; \
        _Pragma("unroll") for (int j = 0; j < 2; ++j) { const int pc = lane + 64 * (2 * hf + j); const f32x4 g0 = ((const f32x4*)gpost)[2 * pc], g1 = ((const f32x4*)gpost)[2 * pc + 1]; \
            x[j].lo += y[j].lo * rs * g0; x[j].hi += y[j].hi * rs * g1; \
            if (xout && ok_) { __builtin_nontemporal_store(x[j].lo, (f32x4*)(xout + ro_) + 2 * pc); __builtin_nontemporal_store(x[j].hi, (f32x4*)(xout + ro_) + 2 * pc + 1); } \
            if (xout_b) { const u32x4 w = f32_to_bf8(x[j]); if (ok_) ((u32x4*)(xout_b + ro_))[pc] = w; x[j] = bf8_to_f32(w); } s2 += sumsq8(x[j]); } \
        s2 = wave_sum(s2); if (lane == 0) xs[8 + F.wave] = s2; WG_SYNC(); \
        if (rs_out && lane == 0 && hf == 0 && ok_) rs_out[NP + srow_] = 1.0f / sqrtf((xs[8 + F.wave] + xs[8 + (F.wave ^ 1)]) * (1.0f / D) + EPS); \
        WG_SYNC(); sb += F.G * 4; } while (0)
    for (int base = gw * 4; base < NP; base += 4 * NGW) {
        u32x4 xr[4][4], yr[4][4];
#pragma unroll
        for (int r = 0; r < 4; ++r) { const int row = base + r, rw = row < NP ? row : base;
#pragma unroll
            for (int j = 0; j < 4; ++j) { xr[r][j] = __builtin_nontemporal_load((const u32x4*)(xin_b + (size_t)rw * D) + lane + 64 * j); yr[r][j] = __builtin_nontemporal_load((const u32x4*)(Y0 + (size_t)rw * D) + lane + 64 * j); } }
#pragma unroll
        for (int r = 0; r < 2; ++r) { const int row = base + r; if (row < NP) { f32x8 x[4], y[4];
#pragma unroll
            for (int j = 0; j < 4; ++j) { x[j] = bf8_to_f32(xr[r][j]); y[j] = bf8_to_f32(yr[r][j]); }
            norm_finish_row(x, y, row, lane, gpost, rs_out, xout, xout_b); } }
        const bool last = (base + 4 * NGW >= NP) && (sb < 1024);
        if (EARLY && last) NS_LOAD_A();
#pragma unroll
        for (int r = 2; r < 4; ++r) { const int row = base + r; if (row < NP) { f32x8 x[4], y[4];
#pragma unroll
            for (int j = 0; j < 4; ++j) { x[j] = bf8_to_f32(xr[r][j]); y[j] = bf8_to_f32(yr[r][j]); }
            norm_finish_row(x, y, row, lane, gpost, rs_out, xout, xout_b); } }
        if (EARLY && last && 4 * NGW >= NP) NS_FINISH();
        else if (EARLY && last) {   }
    }
    for (; sb < 1024; sb += 0) { NS_LOAD_A(); NS_FINISH(); }
#undef NS_LOAD_A
#undef NS_LOAD_B
#undef NS_FINISH
}

__device__ __forceinline__ void transpose_item(const float* W, int K, int N, bf16* WT, LAS float* scr, int item, int lane, const float* gain = nullptr, int ldw = 0) {
    const int nblk = N / 64, kb = item / nblk, nb = item % nblk, k0 = 64 * kb, n0 = 64 * nb;
    f32x4 v[16];
#pragma unroll
    for (int i = 0; i < 16; ++i) v[i] = __builtin_nontemporal_load((const f32x4*)(W + (size_t)(k0 + 4 * i + (lane >> 4)) * N + n0 + 4 * (lane & 15)));
#pragma unroll
    for (int i = 0; i < 16; ++i) { LAS float* s = scr + (4 * i + (lane >> 4)) * 65 + 4 * (lane & 15); const float gk = gain ? gain[k0 + 4 * i + (lane >> 4)] : 1.0f; s[0] = v[i][0] * gk; s[1] = v[i][1] * gk; s[2] = v[i][2] * gk; s[3] = v[i][3] * gk; }
    asm volatile("s_waitcnt lgkmcnt(0)" ::: "memory");
    const int c = lane & 7;
#pragma unroll
    for (int j = 0; j < 8; ++j) { const int n = (lane >> 3) + 8 * j; const LAS float* s = scr + (8 * c) * 65 + n;
        u32x4 o; o.x = pk2(s[0 * 65], s[1 * 65]); o.y = pk2(s[2 * 65], s[3 * 65]); o.z = pk2(s[4 * 65], s[5 * 65]); o.w = pk2(s[6 * 65], s[7 * 65]);
        *(u32x4*)(WT + (size_t)(n0 + n) * (ldw ? ldw : K) + k0 + 8 * c) = o; }
    asm volatile("s_waitcnt lgkmcnt(0)" ::: "memory");
}
__device__ __forceinline__ void transpose_strided(const float* W, int K, int N, bf16* WT, LAS float* scr, int it0, int stride, int nit, int lane, const float* gain = nullptr, int ldw = 0) {
    const int nblk = N / 64, ldo = ldw ? ldw : K;
#define TR_LOAD(v, item) do { const int kb_ = (item) / nblk, nb_ = (item) - kb_ * nblk; _Pragma("unroll") for (int i = 0; i < 16; ++i) v[i] = __builtin_nontemporal_load((const f32x4*)(W + (size_t)(64 * kb_ + 4 * i + (lane >> 4)) * N + 64 * nb_ + 4 * (lane & 15))); } while (0)
#define TR_STORE(v, item) do { const int kb_ = (item) / nblk, nb_ = (item) - kb_ * nblk, k0 = 64 * kb_, n0 = 64 * nb_; \
        _Pragma("unroll") for (int i = 0; i < 16; ++i) { LAS float* s = scr + (4 * i + (lane >> 4)) * 65 + 4 * (lane & 15); const float gk = gain ? gain[k0 + 4 * i + (lane >> 4)] : 1.0f; s[0] = v[i][0] * gk; s[1] = v[i][1] * gk; s[2] = v[i][2] * gk; s[3] = v[i][3] * gk; } \
        asm volatile("s_waitcnt lgkmcnt(0)" ::: "memory"); \
        _Pragma("unroll") for (int j = 0; j < 8; ++j) { const int n = (lane >> 3) + 8 * j, c = lane & 7; const LAS float* s = scr + (8 * c) * 65 + n; \
            u32x4 o; o.x = pk2(s[0 * 65], s[1 * 65]); o.y = pk2(s[2 * 65], s[3 * 65]); o.z = pk2(s[4 * 65], s[5 * 65]); o.w = pk2(s[6 * 65], s[7 * 65]); \
            *(u32x4*)(WT + (size_t)(n0 + n) * ldo + k0 + 8 * c) = o; } \
        asm volatile("s_waitcnt lgkmcnt(0)" ::: "memory"); } while (0)
    int it = it0; if (it >= nit) return;
    f32x4 va[16], vb[16];
    TR_LOAD(va, it);
    for (;;) {
        int itn = it + stride; bool hn = itn < nit;
        if (hn) TR_LOAD(vb, itn);
        TR_STORE(va, it);
        if (!hn) break;
        it = itn; itn = it + stride; hn = itn < nit;
        if (hn) TR_LOAD(va, itn);
        TR_STORE(vb, it);
        if (!hn) break;
        it = itn;
    }
#undef TR_LOAD
#undef TR_STORE
}
struct WJob { const float* W; bf16* WT; int K, N; };
constexpr float LOG2E = 1.4426950408889634f;
__device__ __forceinline__ void swa_prompt_unit(const Frame& F, int b, int c, int kh, const bf16* Q, const bf16* K, const bf16* V, const float* sinks, bf16* CAT) {
    LAS bf16* Ks = (LAS bf16*)F.lds; LAS bf16* Vs = Ks + 256 * 72;
    const int lane = F.lane, kg = lane >> 4, w = F.wave;
    const int rowbase = b * SEQ + (c - 1) * 128;
#pragma unroll
    for (int i = 0; i < 4; ++i) { const int idx = F.tid + NTHR * i, r = idx >> 3, ch = idx & 7;
        u32x4 kv = (u32x4){0u, 0u, 0u, 0u}, vv = kv;
        if (c > 0 || r >= 128) { kv = *(const u32x4*)(K + (size_t)(rowbase + r) * 256 + kh * 64 + ch * 8); vv = *(const u32x4*)(V + (size_t)(rowbase + r) * 256 + kh * 64 + ch * 8); }
        *(LAS u32x4*)(Ks + r * 72 + ch * 8) = kv; *(LAS u32x4*)(Vs + r * 72 + ch * 8) = vv; }
    WG_SYNC();
    const int hq = kh * 4 + (w >> 1);
    const float sink2 = sinks[hq] * LOG2E;
    for (int mb = 0; mb < 4; ++mb) {
        const int i0 = (w & 1) * 64 + mb * 16, qrow = b * SEQ + c * 128 + i0 + (lane & 15), tb = 2 * (i0 >> 5), tq = i0 + (lane & 15);
        bf16x8 bq[2];
#pragma unroll
        for (int ks = 0; ks < 2; ++ks) bq[ks] = *(const bf16x8*)(Q + (size_t)qrow * 1024 + hq * 64 + ks * 32 + 8 * kg);
        f32x4 st[10]; float mx = -1e30f;
#pragma unroll
        for (int t = 0; t < 10; ++t) { f32x4 a = (f32x4){0.f, 0.f, 0.f, 0.f};
#pragma unroll
            for (int ks = 0; ks < 2; ++ks) a = mfma16(frag_nat(Ks, 72, (tb + t) * 16, ks * 32, lane), bq[ks], a);
#pragma unroll
            for (int r = 0; r < 4; ++r) { const int j = (tb + t) * 16 + 4 * kg + r; const bool ok = (j > tq) && (j <= tq + 128) && (c > 0 || j >= 128);
                a[r] = ok ? a[r] * (0.125f * LOG2E) : -1e30f; mx = fmaxf(mx, a[r]); }
            st[t] = a; }
        mx = fmaxf(mx, __shfl_xor(mx, 16)); mx = fmaxf(mx, __shfl_xor(mx, 32)); mx = fmaxf(mx, sink2);
        float sum = 0.f;
#pragma unroll
        for (int t = 0; t < 10; ++t)
#pragma unroll
            for (int r = 0; r < 4; ++r) { const float p = __builtin_amdgcn_exp2f(st[t][r] - mx); st[t][r] = p; sum += p; }
        sum += __shfl_xor(sum, 16); sum += __shfl_xor(sum, 32);
        const float inv = 1.0f / (sum + __builtin_amdgcn_exp2f(sink2 - mx));
        f32x4 o[4];
#pragma unroll
        for (int dt = 0; dt < 4; ++dt) o[dt] = (f32x4){0.f, 0.f, 0.f, 0.f};
#pragma unroll
        for (int s = 0; s < 5; ++s) { const bf16x8 pb = pack_p(st[2 * s], st[2 * s + 1]);
#pragma unroll
            for (int dt = 0; dt < 4; ++dt) o[dt] = mfma16(frag_tr_perm(Vs, 72, (tb + 2 * s) * 16, dt * 16, lane), pb, o[dt]); }
#pragma unroll
        for (int dt = 0; dt < 4; ++dt) { u32x2 wv; wv.x = pk2(o[dt][0] * inv, o[dt][1] * inv); wv.y = pk2(o[dt][2] * inv, o[dt][3] * inv);
            *(u32x2*)(CAT + (size_t)qrow * 2048 + hq * 64 + dt * 16 + 4 * kg) = wv; }
    }
    WG_SYNC();
}
__device__ __forceinline__ void gate_prompt_unit(const Frame& F, int b, int c, int g, const bf16* ZU, const bf16* ZV, const long long* zvstat, const float* lng, const float* lnb, const float* w_s, const float* b_s, bf16* CAT) {
    LAS bf16* Ws = (LAS bf16*)F.lds; LAS bf16* Zs = Ws + 128 * 136;
    const int lane = F.lane, kg = lane >> 4, w = F.wave;
#pragma unroll
    for (int i = 0; i < 8; ++i) { const int idx = F.tid + NTHR * i, r = idx >> 5, j4 = (idx & 31) * 4;
        f32x4 v = *(const f32x4*)(w_s + ((size_t)g * 128 + r) * 128 + j4);
#pragma unroll
        for (int e = 0; e < 4; ++e) if (j4 + e > r) v[e] = 0.f;
        u32x2 wv; wv.x = pk2(v[0], v[1]); wv.y = pk2(v[2], v[3]); *(LAS u32x2*)(Ws + r * 136 + j4) = wv; }
#pragma unroll
    for (int i = 0; i < 8; ++i) { const int idx = F.tid + NTHR * i, r = idx >> 5, ch = idx & 31, col = g * 256 + ch * 8, row = b * SEQ + c * 128 + r;
        const u32x4 raw = *(const u32x4*)(ZV + (size_t)row * 1024 + col);
        const float mean = (float)zvstat[2 * row] * (1.0f / (1024.0f * 16777216.0f)), var = (float)zvstat[2 * row + 1] * (1.0f / (1024.0f * 16777216.0f)) - mean * mean, rstd = 1.0f / sqrtf(fmaxf(var, 0.f) + EPS);
        const f32x4 g0 = *(const f32x4*)(lng + col), g1 = *(const f32x4*)(lng + col + 4), b0 = *(const f32x4*)(lnb + col), b1 = *(const f32x4*)(lnb + col + 4);
        float z[8];
#pragma unroll
        for (int e = 0; e < 4; ++e) { z[2 * e] = __uint_as_float(raw[e] << 16); z[2 * e + 1] = __uint_as_float(raw[e] & 0xffff0000u); }
        u32x4 o;
        o.x = pk2((z[0] - mean) * rstd * g0[0] + b0[0], (z[1] - mean) * rstd * g0[1] + b0[1]); o.y = pk2((z[2] - mean) * rstd * g0[2] + b0[2], (z[3] - mean) * rstd * g0[3] + b0[3]);
        o.z = pk2((z[4] - mean) * rstd * g1[0] + b1[0], (z[5] - mean) * rstd * g1[1] + b1[1]); o.w = pk2((z[6] - mean) * rstd * g1[2] + b1[2], (z[7] - mean) * rstd * g1[3] + b1[3]);
        *(LAS u32x4*)(Zs + r * 264 + ch * 8) = o; }
    WG_SYNC();
    const int i0 = 16 * w, nst = (w >> 1) + 1;
    f32x4 acc[16];
#pragma unroll
    for (int dt = 0; dt < 16; ++dt) acc[dt] = (f32x4){0.f, 0.f, 0.f, 0.f};
    for (int s = 0; s < nst; ++s) { const bf16x8 bw = frag_nat(Ws, 136, i0, 32 * s, lane);
#pragma unroll
        for (int dt = 0; dt < 16; ++dt) acc[dt] = mfma16(frag_tr(Zs, 264, 32 * s, dt * 16, lane), bw, acc[dt]); }
    const int row = b * SEQ + c * 128 + i0 + (lane & 15); const float bs = b_s[g * 128 + i0 + (lane & 15)];
#pragma unroll
    for (int dt = 0; dt < 16; ++dt) { const int col = g * 256 + dt * 16 + 4 * kg; const u32x2 zu = *(const u32x2*)(ZU + (size_t)row * 1024 + col);
        u32x2 wv; wv.x = pk2(__uint_as_float(zu.x << 16) * (acc[dt][0] + bs), __uint_as_float(zu.x & 0xffff0000u) * (acc[dt][1] + bs));
        wv.y = pk2(__uint_as_float(zu.y << 16) * (acc[dt][2] + bs), __uint_as_float(zu.y & 0xffff0000u) * (acc[dt][3] + bs));
        *(u32x2*)(CAT + (size_t)row * 2048 + 1024 + col) = wv; }
    WG_SYNC();
}
__device__ __forceinline__ void gate_sample_unit(const Frame& F, int n, int half, const bf16* ZU, const bf16* ZV, const long long* zvstat, const float* lng, const float* lnb, const float* w_s, const float* b_s, bf16* CAT, float* ogv) {
#pragma unroll
    for (int cc = half; cc < half + 1; ++cc) { const int col = F.tid + NTHR * cc, g = col >> 8; const float lg = lng[col], lb = lnb[col];
        float z[8];
#pragma unroll
        for (int j = 0; j < 8; ++j) { const int row = NP + n * 8 + j;
            const float mean = (float)zvstat[2 * row] * (1.0f / (1024.0f * 16777216.0f)), var = (float)zvstat[2 * row + 1] * (1.0f / (1024.0f * 16777216.0f)) - mean * mean, rstd = 1.0f / sqrtf(fmaxf(var, 0.f) + EPS);
            z[j] = (bf2f(ZV[(size_t)row * 1024 + col]) - mean) * rstd * lg + lb; ogv[(size_t)(n * 8 + j) * 1024 + col] = z[j]; }
#pragma unroll
        for (int i = 0; i < 8; ++i) { float mixed = b_s[g * 128 + i];
#pragma unroll
            for (int j = 0; j <= i; ++j) mixed += w_s[((size_t)g * 128 + i) * 128 + j] * z[j];
            const int row = NP + n * 8 + i; CAT[(size_t)row * 2048 + 1024 + col] = (bf16)f2bf(bf2f(ZU[(size_t)row * 1024 + col]) * mixed); } }
}
__device__ __forceinline__ void swa_sample_unit(const Frame& F, int n, int khp, const bf16* Q, const bf16* K, const bf16* V, const float* ck, const float* cv, const float* sinks, bf16* CAT, float* oks, float* ovs) {
    LAS bf16* Ks = (LAS bf16*)F.lds; LAS bf16* Vs = Ks + 2 * 144 * 72;
    const int lane = F.lane, kg = lane >> 4, w = F.wave;
#pragma unroll
    for (int i = 0; i < 8; ++i) { const int idx = F.tid + NTHR * i, j = idx >> 5, f4 = idx & 31, khl = f4 >> 4, d = (f4 & 15) * 4;
        const size_t off = (((size_t)n * 128 + j) * 4 + 2 * khp) * 64 + f4 * 4;
        const f32x4 kv = *(const f32x4*)(ck + off), vv = *(const f32x4*)(cv + off);
        u32x2 a; a.x = pk2(kv[0], kv[1]); a.y = pk2(kv[2], kv[3]); *(LAS u32x2*)(Ks + (khl * 144 + j) * 72 + d) = a;
        u32x2 c2; c2.x = pk2(vv[0], vv[1]); c2.y = pk2(vv[2], vv[3]); *(LAS u32x2*)(Vs + (khl * 160 + j) * 72 + d) = c2;
        if (j >= 8) { const size_t oo = (((size_t)n * 128 + j - 8) * 4 + 2 * khp) * 64 + f4 * 4; *(f32x4*)(oks + oo) = kv; *(f32x4*)(ovs + oo) = vv; } }
    if (F.tid < 128) { const int t = F.tid >> 4, khl = (F.tid >> 3) & 1, ch = F.tid & 7; const size_t off = (size_t)(NP + n * 8 + t) * 256 + (2 * khp + khl) * 64 + ch * 8;
        *(LAS u32x4*)(Ks + (khl * 144 + 128 + t) * 72 + ch * 8) = *(const u32x4*)(K + off); *(LAS u32x4*)(Vs + (khl * 160 + 128 + t) * 72 + ch * 8) = *(const u32x4*)(V + off); }
    else if (F.tid < 128 + 64 * 2) { const int x = F.tid - 128, khl = x >> 6, r = 136 + ((x & 63) >> 3), ch = x & 7; *(LAS u32x4*)(Ks + (khl * 144 + r) * 72 + ch * 8) = (u32x4){0u, 0u, 0u, 0u}; }
    for (int x = F.tid; x < 2 * 24 * 8; x += NTHR) { const int khl = x / 192, r = 136 + ((x % 192) >> 3), ch = x & 7; *(LAS u32x4*)(Vs + (khl * 160 + r) * 72 + ch * 8) = (u32x4){0u, 0u, 0u, 0u}; }
    WG_SYNC();
    if (w < 4) {
        const int khl = w >> 1, kh = 2 * khp + khl, t = lane & 7, head = kh * 4 + 2 * (w & 1) + ((lane & 15) >> 3), qrow = NP + n * 8 + t;
        const LAS bf16* Kh = Ks + khl * 144 * 72; const LAS bf16* Vh = Vs + khl * 160 * 72;
        const float sink2 = sinks[head] * LOG2E;
        bf16x8 bq[2];
#pragma unroll
        for (int ks = 0; ks < 2; ++ks) bq[ks] = *(const bf16x8*)(Q + (size_t)qrow * 1024 + head * 64 + ks * 32 + 8 * kg);
        f32x4 st[10]; float mx = -1e30f;
#pragma unroll
        for (int tt = 0; tt < 9; ++tt) { f32x4 a = (f32x4){0.f, 0.f, 0.f, 0.f};
#pragma unroll
            for (int ks = 0; ks < 2; ++ks) a = mfma16(frag_nat(Kh, 72, tt * 16, ks * 32, lane), bq[ks], a);
#pragma unroll
            for (int r = 0; r < 4; ++r) { const int j = tt * 16 + 4 * kg + r; const bool ok = (j > t) && (j <= t + 128);
                a[r] = ok ? a[r] * (0.125f * LOG2E) : -1e30f; mx = fmaxf(mx, a[r]); }
            st[tt] = a; }
        st[9] = (f32x4){-1e30f, -1e30f, -1e30f, -1e30f};
        mx = fmaxf(mx, __shfl_xor(mx, 16)); mx = fmaxf(mx, __shfl_xor(mx, 32)); mx = fmaxf(mx, sink2);
        float sum = 0.f;
#pragma unroll
        for (int tt = 0; tt < 10; ++tt)
#pragma unroll
            for (int r = 0; r < 4; ++r) { const float p = __builtin_amdgcn_exp2f(st[tt][r] - mx); st[tt][r] = p; sum += p; }
        sum += __shfl_xor(sum, 16); sum += __shfl_xor(sum, 32);
        const float inv = 1.0f / (sum + __builtin_amdgcn_exp2f(sink2 - mx));
        f32x4 o[4];
#pragma unroll
        for (int dt = 0; dt < 4; ++dt) o[dt] = (f32x4){0.f, 0.f, 0.f, 0.f};
#pragma unroll
        for (int s = 0; s < 5; ++s) { const bf16x8 pb = pack_p(st[2 * s], st[2 * s + 1]);
#pragma unroll
            for (int dt = 0; dt < 4; ++dt) o[dt] = mfma16(frag_tr_perm(Vh, 72, 32 * s, dt * 16, lane), pb, o[dt]); }
#pragma unroll
        for (int dt = 0; dt < 4; ++dt) { u32x2 wv; wv.x = pk2(o[dt][0] * inv, o[dt][1] * inv); wv.y = pk2(o[dt][2] * inv, o[dt][3] * inv);
            *(u32x2*)(CAT + (size_t)qrow * 2048 + head * 64 + dt * 16 + 4 * kg) = wv; }
    }
    WG_SYNC();
}

constexpr size_t QSEG = (size_t)132 * 1024 * 1024 / 2;
__device__ __forceinline__ bf16x8 ldq2(const bf16* p) {
    const u32x4 a = *(const u32x4*)p, b = *(const u32x4*)(p + QSEG); u32x4 o;
#pragma unroll
    for (int e = 0; e < 4; ++e) o[e] = pk2(__uint_as_float(a[e] << 16) + __uint_as_float(b[e] << 16), __uint_as_float(a[e] & 0xffff0000u) + __uint_as_float(b[e] & 0xffff0000u));
    return __builtin_bit_cast(bf16x8, o);
}
__device__ __forceinline__ void mem_attn_wave(const LAS bf16* Ks, const LAS bf16* Vs, const bf16* qptr  , bf16* optr, bool store, int lane) {
    const int kg = lane >> 4;
    bf16x8 bq[4];
#pragma unroll
    for (int ks = 0; ks < 4; ++ks) bq[ks] = ldq2(qptr + ks * 32 + 8 * kg);
    f32x4 st[16]; float mx = -1e30f;
#pragma unroll
    for (int t = 0; t < 16; ++t) { f32x4 a = (f32x4){0.f, 0.f, 0.f, 0.f};
#pragma unroll
        for (int ks = 0; ks < 4; ++ks) a = mfma16(frag_nat(Ks, 136, t * 16, ks * 32, lane), bq[ks], a);
#pragma unroll
        for (int r = 0; r < 4; ++r) { a[r] *= (0.08838834764831845f * LOG2E); mx = fmaxf(mx, a[r]); }
        st[t] = a; }
    mx = fmaxf(mx, __shfl_xor(mx, 16)); mx = fmaxf(mx, __shfl_xor(mx, 32));
    float sum = 0.f;
#pragma unroll
    for (int t = 0; t < 16; ++t)
#pragma unroll
        for (int r = 0; r < 4; ++r) { const float p = __builtin_amdgcn_exp2f(st[t][r] - mx); st[t][r] = p; sum += p; }
    sum += __shfl_xor(sum, 16); sum += __shfl_xor(sum, 32);
    const float inv = 1.0f / sum;
    f32x4 o[8];
#pragma unroll
    for (int dt = 0; dt < 8; ++dt) o[dt] = (f32x4){0.f, 0.f, 0.f, 0.f};
#pragma unroll
    for (int s = 0; s < 8; ++s) { const bf16x8 pb = pack_p(st[2 * s], st[2 * s + 1]);
#pragma unroll
        for (int dt = 0; dt < 8; ++dt) o[dt] = mfma16(frag_tr_perm(Vs, 136, 32 * s, dt * 16, lane), pb, o[dt]); }
    if (store) {
#pragma unroll
        for (int dt = 0; dt < 8; ++dt) { u32x2 wv; wv.x = pk2(o[dt][0] * inv, o[dt][1] * inv); wv.y = pk2(o[dt][2] * inv, o[dt][3] * inv); *(u32x2*)(optr + dt * 16 + 4 * kg) = wv; } }
}
__device__ __forceinline__ void mem_prompt_unit(const Frame& F, int b, int h, int qb, const bf16* QM, const bf16* KV, bf16* OM) {
    LAS bf16* Ks = (LAS bf16*)F.lds; LAS bf16* Vs = Ks + 256 * 136;
#pragma unroll
    for (int i = 0; i < 8; ++i) { const int idx = F.tid + NTHR * i, r = idx >> 4, ch = idx & 15; const size_t off = (size_t)(b * 256 + r) * 1024 + h * 128 + ch * 8;
        *(LAS u32x4*)(Ks + r * 136 + ch * 8) = *(const u32x4*)(KV + off); *(LAS u32x4*)(Vs + r * 136 + ch * 8) = *(const u32x4*)(KV + off + 512); }
    WG_SYNC();
    const size_t row = (size_t)b * SEQ + qb * 128 + F.wave * 16 + (F.lane & 15);
    mem_attn_wave(Ks, Vs, QM + row * 512 + h * 128, OM + row * 512 + h * 128, true, F.lane);
    WG_SYNC();
}
__device__ __forceinline__ void mem_sample_units(const Frame& F, int u0, int ustride, const bf16* QM, const float* ck, const float* cv, bf16* OM) {
    LAS bf16* Ks = (LAS bf16*)F.lds; LAS bf16* Vs = Ks + 256 * 136; LAS bf16* Pb = Vs + 256 * 136; LAS float* smax = (LAS float*)(Pb + 8 * 264); LAS float* ssum = smax + 64;
    const int lane = F.lane, kg = lane >> 4, w = F.wave, q = lane & 7;
    f32x4 kv[16], vv[16];
#define MS_LOAD(u_) do { const int n_ = (u_) >> 2, h_ = (u_) & 3; _Pragma("unroll") for (int i = 0; i < 16; ++i) { const int idx = F.tid + NTHR * i, r = idx >> 5, f4 = idx & 31; const size_t off = (((size_t)n_ * 256 + r) * 4 + h_) * 128 + f4 * 4; \
            kv[i] = __builtin_nontemporal_load((const f32x4*)(ck + off)); vv[i] = __builtin_nontemporal_load((const f32x4*)(cv + off)); } } while (0)
    if (u0 < 512) MS_LOAD(u0);
    for (int u = u0; u < 512; u += ustride) {
        const int n = u >> 2, h = u & 3;
#pragma unroll
        for (int i = 0; i < 16; ++i) { const int idx = F.tid + NTHR * i, r = idx >> 5, f4 = idx & 31;
            u32x2 a; a.x = pk2(kv[i][0], kv[i][1]); a.y = pk2(kv[i][2], kv[i][3]); *(LAS u32x2*)(Ks + r * 136 + f4 * 4) = a;
            u32x2 c2; c2.x = pk2(vv[i][0], vv[i][1]); c2.y = pk2(vv[i][2], vv[i][3]); *(LAS u32x2*)(Vs + r * 136 + f4 * 4) = c2; }
        if (u + ustride < 512) MS_LOAD(u + ustride);
        const size_t row = (size_t)NP + n * 8 + q;
        bf16x8 bq[4];
#pragma unroll
        for (int ks = 0; ks < 4; ++ks) bq[ks] = ldq2(QM + row * 512 + h * 128 + ks * 32 + 8 * kg);
        WG_SYNC();
        f32x4 st[2]; float mx = -1e30f;
#pragma unroll
        for (int t = 0; t < 2; ++t) { f32x4 a = (f32x4){0.f, 0.f, 0.f, 0.f};
#pragma unroll
            for (int ks = 0; ks < 4; ++ks) a = mfma16(frag_nat(Ks, 136, (2 * w + t) * 16, ks * 32, lane), bq[ks], a);
#pragma unroll
            for (int r = 0; r < 4; ++r) { a[r] *= (0.08838834764831845f * LOG2E); mx = fmaxf(mx, a[r]); }
            st[t] = a; }
        mx = fmaxf(mx, __shfl_xor(mx, 16)); mx = fmaxf(mx, __shfl_xor(mx, 32));
        if (lane < 8) smax[w * 8 + lane] = mx;
        WG_SYNC();
        float gm = smax[q];
#pragma unroll
        for (int ww = 1; ww < 8; ++ww) gm = fmaxf(gm, smax[ww * 8 + q]);
        float sum = 0.f;
#pragma unroll
        for (int t = 0; t < 2; ++t)
#pragma unroll
            for (int r = 0; r < 4; ++r) { const float p = __builtin_amdgcn_exp2f(st[t][r] - gm); sum += p; if ((lane & 15) < 8) Pb[q * 264 + (2 * w + t) * 16 + 4 * kg + r] = (bf16)f2bf(p); }
        sum += __shfl_xor(sum, 16); sum += __shfl_xor(sum, 32);
        if (lane < 8) ssum[w * 8 + lane] = sum;
        WG_SYNC();
        float tot = ssum[q];
#pragma unroll
        for (int ww = 1; ww < 8; ++ww) tot += ssum[ww * 8 + q];
        f32x4 o = (f32x4){0.f, 0.f, 0.f, 0.f};
#pragma unroll
        for (int s2 = 0; s2 < 8; ++s2) o = mfma16(frag_tr(Vs, 136, 32 * s2, w * 16, lane), *(const LAS bf16x8*)(Pb + q * 264 + 32 * s2 + 8 * kg), o);
        if ((lane & 15) < 8) { const float inv = 1.0f / tot; u32x2 wv; wv.x = pk2(o[0] * inv, o[1] * inv); wv.y = pk2(o[2] * inv, o[3] * inv); *(u32x2*)(OM + row * 512 + h * 128 + w * 16 + 4 * kg) = wv; }
        WG_SYNC();
    }
#undef MS_LOAD
}
constexpr int ES = 64, NE = ES / 16;
__device__ __forceinline__ float ret_lg2(int h) { return log2f(1.0f - exp2f(-5.0f - (float)h)); }
__device__ __forceinline__ void ret_prompt_scan(const Frame& F, int b, int h, int es, const bf16* ZR, bf16* OR, unsigned long long* SS, float* ostate) {
    constexpr int VST = ES + 8, NV = ES / 32;
    LAS bf16* Ks = (LAS bf16*)F.lds; LAS bf16* Vs = Ks + 128 * 264; LAS bf16* Vd = Vs + 128 * VST; LAS bf16* Ss = Vd + 128 * VST;
    constexpr int SST = 264;
    const int lane = F.lane, kg = lane >> 4, w = F.wave, tid = F.tid;
    const int it = (w < 4) ? w : 11 - w;
    const float lg2 = ret_lg2(h);
    const int e0 = es * ES;
    bf16x8 qf[8]; u32x4 kpre[8], vpre[NV];
    const size_t rb = (size_t)b * SEQ;
#define RET_LOAD_KV(c_, tid) do { \
        const unsigned kl_off = (unsigned)(((tid) >> 5) * RET_IN + ((tid) & 31) * 8) * 2u; \
        const char* kb_ = (const char*)(ZR + (rb + (size_t)(c_) * 128) * RET_IN + 2048 + h * 256); \
        _Pragma("unroll") for (int i = 0; i < 8; ++i) kpre[i] = *(const u32x4*)(kb_ + (size_t)i * (16 * RET_IN * 2) + kl_off); \
        _Pragma("unroll") for (int i = 0; i < NV; ++i) { const int idx = tid + NTHR * i, r = idx / (ES / 8), ch = idx % (ES / 8); vpre[i] = *(const u32x4*)(ZR + (rb + (c_) * 128 + r) * RET_IN + 4096 + h * 512 + e0 + ch * 8); } } while (0)
#define RET_LOAD_Q(c_, lane) do { const unsigned q_off = (unsigned)((16 * it + ((lane) & 15)) * RET_IN + 8 * ((lane) >> 4)) * 2u; const char* qb_ = (const char*)(ZR + (rb + (size_t)(c_) * 128) * RET_IN + h * 256); \
        _Pragma("unroll") for (int ks = 0; ks < 8; ++ks) qf[ks] = *(const bf16x8*)(qb_ + ks * 64 + q_off); } while (0)
#define RET_STORE_KV(tid) do { \
        const unsigned kl_lds = (unsigned)(((tid) >> 5) * 264 + ((tid) & 31) * 8) * 2u; \
        _Pragma("unroll") for (int i = 0; i < 8; ++i) *(LAS u32x4*)((LAS char*)Ks + kl_lds + i * (16 * 264 * 2)) = kpre[i]; \
        _Pragma("unroll") for (int i = 0; i < NV; ++i) { const int idx = tid + NTHR * i, r = idx / (ES / 8), ch = idx % (ES / 8); *(LAS u32x4*)(Vs + r * VST + ch * 8) = vpre[i]; \
          const float dk = __builtin_amdgcn_exp2f(lg2 * (float)(127 - r)); u32x4 o; \
          _Pragma("unroll") for (int e = 0; e < 4; ++e) o[e] = pk2(__uint_as_float(vpre[i][e] << 16) * dk, __uint_as_float(vpre[i][e] & 0xffff0000u) * dk); \
          *(LAS u32x4*)(Vd + r * VST + ch * 8) = o; } } while (0)
    for (int x = tid; x < ES * SST / 8; x += NTHR) *(LAS u32x4*)(Ss + x * 8) = (u32x4){0u, 0u, 0u, 0u};
    f32x4 sacc[2][NE];
#pragma unroll
    for (int a = 0; a < 2; ++a)
#pragma unroll
        for (int e = 0; e < NE; ++e) sacc[a][e] = (f32x4){0.f, 0.f, 0.f, 0.f};
    const float g128 = __builtin_amdgcn_exp2f(lg2 * 128.0f);
    RET_LOAD_KV(0, tid); RET_LOAD_Q(0, lane); RET_STORE_KV(tid);
    WG_SYNC();
    if (__builtin_amdgcn_readfirstlane(tid) >= 256) __builtin_amdgcn_s_setprio(1);
    f32x4 oi[NE];
#pragma unroll
    for (int e = 0; e < NE; ++e) oi[e] = (f32x4){0.f, 0.f, 0.f, 0.f};
    for (int c = 0; c < 32; ++c) {
        int ln = lane, tc = tid; asm volatile("" : "+v"(ln), "+v"(tc));
        const int kg = ln >> 4, iq = 16 * it + (ln & 15);
        const float giq = __builtin_amdgcn_exp2f(lg2 * (float)iq);
        float gkr[4];
#pragma unroll
        for (int r = 0; r < 4; ++r) gkr[r] = __builtin_amdgcn_exp2f(lg2 * (float)(-(4 * kg + r)));
        if (c + 1 < 32) RET_LOAD_KV(c + 1, tc);
#pragma unroll
        for (int s = 0; s < 4; ++s) if (2 * s <= it) { asm volatile("" ::: "memory");
            f32x4 a2[2];
#pragma unroll
            for (int hh = 0; hh < 2; ++hh) { const int jt = 2 * s + hh; f32x4 a = (f32x4){0.f, 0.f, 0.f, 0.f};
                if (jt <= it) {
#pragma unroll
                    for (int ks = 0; ks < 8; ++ks) a = mfma16(frag_nat(Ks, 264, jt * 16, ks * 32, ln), qf[ks], a);
                    const float gj = giq * __builtin_amdgcn_exp2f(lg2 * (float)(-16 * jt));
#pragma unroll
                    for (int r = 0; r < 4; ++r) a[r] *= gj * gkr[r];
                    if (jt == it) {
#pragma unroll
                        for (int r = 0; r < 4; ++r) if (4 * kg + r > (ln & 15)) a[r] = 0.f; } }
                a2[hh] = a; }
            const bf16x8 pb = pack_p(a2[0], a2[1]);
#pragma unroll
            for (int e = 0; e < NE; ++e) oi[e] = mfma16(frag_tr_perm(Vs, VST, 32 * s, e * 16, ln), pb, oi[e]); }
        if (c + 1 < 32) RET_LOAD_Q(c + 1, ln);
        const size_t orow = rb + c * 128 + iq; float ssq = 0.f;
#pragma unroll
        for (int e = 0; e < NE; ++e) { const f32x4 o = oi[e]; ssq += (o[0] * o[0] + o[1] * o[1]) + (o[2] * o[2] + o[3] * o[3]);
            u32x2 wv; wv.x = pk2(o[0], o[1]); wv.y = pk2(o[2], o[3]); *(u32x2*)(OR + orow * 4096 + h * 512 + e0 + e * 16 + 4 * kg) = wv; }
        ssq += __shfl_xor(ssq, 16); ssq += __shfl_xor(ssq, 32);
        if (kg == 0) atomicAdd(SS + orow * 8 + h, (unsigned long long)__float2ll_rn(ssq * 16777216.0f));
#pragma unroll
        for (int a = 0; a < 2; ++a)
#pragma unroll
            for (int e = 0; e < NE; ++e) sacc[a][e] *= g128;
#pragma unroll
        for (int s = 0; s < 4; ++s) { asm volatile("" ::: "memory");
            bf16x8 vf[NE];
#pragma unroll
            for (int e = 0; e < NE; ++e) vf[e] = frag_tr(Vd, VST, 32 * s, e * 16, ln);
#pragma unroll
            for (int a = 0; a < 2; ++a) { const bf16x8 kf = frag_tr(Ks, 264, 32 * s, (2 * w + a) * 16, ln);
#pragma unroll
                for (int e = 0; e < NE; ++e) sacc[a][e] = mfma16(kf, vf[e], sacc[a][e]); } }
#pragma unroll
        for (int a = 0; a < 2; ++a)
#pragma unroll
            for (int e = 0; e < NE; ++e)
                { u32x2 wv; wv.x = pk2(sacc[a][e][0], sacc[a][e][1]); wv.y = pk2(sacc[a][e][2], sacc[a][e][3]);
                  *(LAS u32x2*)(Ss + (e * 16 + (ln & 15)) * SST + (2 * w + a) * 16 + 4 * kg) = wv; }
        WG_SYNC();
        if (c + 1 < 32) {
            RET_STORE_KV(tc);
#pragma unroll
            for (int e = 0; e < NE; ++e) oi[e] = (f32x4){0.f, 0.f, 0.f, 0.f};
#pragma unroll
            for (int ks = 0; ks < 8; ++ks) { if ((ks & 1) == 0) asm volatile("" ::: "memory");
#pragma unroll
                for (int e = 0; e < NE; ++e) oi[e] = mfma16(frag_nat(Ss, SST, e * 16, 32 * ks, ln), qf[ks], oi[e]); }
            { const float qd = __builtin_amdgcn_exp2f(lg2 * (float)(iq + 1));
#pragma unroll
              for (int e = 0; e < NE; ++e) oi[e] *= qd; }
        }
        WG_SYNC();
    }
#undef RET_LOAD_KV
#undef RET_LOAD_Q
#undef RET_STORE_KV
#pragma unroll
    for (int a = 0; a < 2; ++a)
#pragma unroll
        for (int e = 0; e < NE; ++e)
#pragma unroll
            for (int r = 0; r < 4; ++r) ostate[(((size_t)b * 8 + h) * 256 + (2 * w + a) * 16 + 4 * kg + r) * 512 + e0 + e * 16 + (lane & 15)] = sacc[a][e][r];
    __builtin_amdgcn_s_setprio(0);
}
__device__ __forceinline__ void ret_sample_pass(const Frame& F, int unit0, const bf16* ZR, const float* state, float* ostate, bf16* OR, unsigned long long* SS) {
    const int grp = F.wave >> 2, dq = (F.wave >> 1) & 1, t = (F.wave & 1) * 64 + F.lane, t256 = dq * 128 + t, unit = unit0 + grp, n = unit >> 3, h = unit & 7;
    LAS float* qk = (LAS float*)F.lds + grp * (256 * 16 + 64 + 8 * 128 * 4); LAS float* sc = qk + 256 * 16; LAS f32x4* red = (LAS f32x4*)(sc + 64);
    const float lg2 = ret_lg2(h);
    const size_t r0 = (size_t)NP + n * 8;
#pragma unroll 4
    for (int x = t256; x < 8 * 256; x += 256) { const int i = x >> 8, d = x & 255;
        qk[d * 16 + i] = bf2f(ZR[(r0 + i) * RET_IN + h * 256 + d]);
        qk[d * 16 + 8 + i] = bf2f(ZR[(r0 + i) * RET_IN + 2048 + h * 256 + d]) * __builtin_amdgcn_exp2f(lg2 * (float)(7 - i)); }
    float v[8][4];
#pragma unroll
    for (int j = 0; j < 8; ++j) { const u32x2 raw = *(const u32x2*)(ZR + (r0 + j) * RET_IN + 4096 + h * 512 + 4 * t);
        v[j][0] = __uint_as_float(raw.x << 16); v[j][1] = __uint_as_float(raw.x & 0xffff0000u); v[j][2] = __uint_as_float(raw.y << 16); v[j][3] = __uint_as_float(raw.y & 0xffff0000u); }
    WG_SYNC();
    const float g8 = __builtin_amdgcn_exp2f(lg2 * 8.0f);
    const __amdgpu_buffer_rsrc_t rs_in = __builtin_amdgcn_make_buffer_rsrc((void*)(state + ((size_t)n * 8 + h) * 256 * 512), 0, 256 * 2048, 0x00020000);
    const __amdgpu_buffer_rsrc_t rs_out = __builtin_amdgcn_make_buffer_rsrc((void*)(ostate + ((size_t)n * 8 + h) * 256 * 512), 0, 256 * 2048, 0x00020000);
    const int loff = t * 16, dbase = dq * 128;
    f32x4 acc[8];
#pragma unroll
    for (int i = 0; i < 8; ++i) acc[i] = (f32x4){0.f, 0.f, 0.f, 0.f};
    constexpr int RB = 4;
    f32x4 bufA[RB], bufB[RB];
#define RS_LD(buf, d0_) do { _Pragma("unroll") for (int u = 0; u < RB; ++u) buf[u] = __builtin_bit_cast(f32x4, __builtin_amdgcn_raw_buffer_load_b128(rs_in, loff, (dbase + (d0_) + u) * 2048, 2)); } while (0)
#define RS_CP(buf, d0_) do { _Pragma("unroll") for (int u = 0; u < RB; ++u) { __builtin_amdgcn_sched_barrier(0); const LAS f32x4* qp = (const LAS f32x4*)(qk + (dbase + (d0_) + u) * 16); const f32x4 q0 = qp[0], q1 = qp[1], k0 = qp[2], k1 = qp[3]; \
            const f32x4 sv = buf[u]; f32x4 s1 = sv * g8; \
            _Pragma("unroll") for (int e = 0; e < 4; ++e) { \
                s1[e] += k0[0] * v[0][e] + k0[1] * v[1][e] + k0[2] * v[2][e] + k0[3] * v[3][e] + k1[0] * v[4][e] + k1[1] * v[5][e] + k1[2] * v[6][e] + k1[3] * v[7][e]; \
                acc[0][e] += q0[0] * sv[e]; acc[1][e] += q0[1] * sv[e]; acc[2][e] += q0[2] * sv[e]; acc[3][e] += q0[3] * sv[e]; \
                acc[4][e] += q1[0] * sv[e]; acc[5][e] += q1[1] * sv[e]; acc[6][e] += q1[2] * sv[e]; acc[7][e] += q1[3] * sv[e]; } \
            __builtin_amdgcn_raw_buffer_store_b128(__builtin_bit_cast(u32x4, s1), rs_out, loff, (dbase + (d0_) + u) * 2048, 2); } } while (0)
    RS_LD(bufA, 0);
#pragma unroll 1
    for (int d0 = 0; d0 < 128; d0 += 2 * RB) {
        RS_LD(bufB, d0 + RB);
        RS_CP(bufA, d0);
        if (d0 + 2 * RB < 128) RS_LD(bufA, d0 + 2 * RB);
        RS_CP(bufB, d0 + RB);
    }
#undef RS_LD
#undef RS_CP
    { int t3 = t256; asm volatile("" : "+v"(t3)); const int pr = t3 >> 2, i = pr >> 3, j = pr & 7, qd = t3 & 3; float s = 0.f;
      for (int d = qd * 64; d < qd * 64 + 64; ++d) s += qk[d * 16 + i] * qk[d * 16 + 8 + j];
      s += __shfl_xor(s, 1); s += __shfl_xor(s, 2);
      if (qd == 0) sc[i * 8 + j] = (j <= i) ? s * __builtin_amdgcn_exp2f(lg2 * (float)((i - j) - (7 - j))) : 0.f; }
    int t2 = t; asm volatile("" : "+v"(t2));
    if (dq == 1) {
#pragma unroll
        for (int i = 0; i < 8; ++i) red[i * 128 + t2] = acc[i]; }
    WG_SYNC();
    if (dq == 0) {
#pragma unroll
        for (int i = 0; i < 8; ++i) { f32x4 o = (acc[i] + red[i * 128 + t2]) * __builtin_amdgcn_exp2f(lg2 * (float)(i + 1));
#pragma unroll
            for (int j = 0; j <= i; ++j) { const float s = sc[i * 8 + j];
#pragma unroll
                for (int e = 0; e < 4; ++e) o[e] += s * v[j][e]; }
            u32x2 wv; wv.x = pk2(o[0], o[1]); wv.y = pk2(o[2], o[3]); *(u32x2*)(OR + (r0 + i) * 4096 + h * 512 + 4 * t2) = wv;
            float ssq = (o[0] * o[0] + o[1] * o[1]) + (o[2] * o[2] + o[3] * o[3]); ssq = wave_sum(ssq);
            if ((t2 & 63) == 0) atomicAdd(SS + (r0 + i) * 8 + h, (unsigned long long)__float2ll_rn(ssq * 16777216.0f)); } }
    WG_SYNC();
}
template <int NR>
__device__ __forceinline__ void ret_norm_rows(const Frame& F, const bf16* OR, const bf16* ZR, const unsigned long long* SS, bf16* YG) {
    const int gw = F.vcu * NWAVES + F.wave, NGW = F.G * NWAVES, lane = F.lane;
    for (int base = gw; base < 2 * M; base += NR * NGW) {
        u32x4 o[NR][4], g[NR][4];
#pragma unroll
        for (int r = 0; r < NR; ++r) { const int it = base + r * NGW, iw = it < 2 * M ? it : base, row = iw >> 1, c0 = (iw & 1) * 2048;
#pragma unroll
            for (int j = 0; j < 4; ++j) { const int col = c0 + (lane + 64 * j) * 8; o[r][j] = __builtin_nontemporal_load((const u32x4*)(OR + (size_t)row * 4096 + col)); g[r][j] = __builtin_nontemporal_load((const u32x4*)(ZR + (size_t)row * RET_IN + 8192 + col)); } }
#pragma unroll
        for (int r = 0; r < NR; ++r) { const int it = base + r * NGW; if (it >= 2 * M) break; const int row = it >> 1, c0 = (it & 1) * 2048;
#pragma unroll
            for (int j = 0; j < 4; ++j) { const int col = c0 + (lane + 64 * j) * 8, h = col >> 9; const float rs = 1.0f / sqrtf((float)SS[(size_t)row * 8 + h] * (1.0f / (512.0f * 16777216.0f)) + EPS); u32x4 y;
#pragma unroll
                for (int e = 0; e < 4; ++e) y[e] = pk2(__uint_as_float(o[r][j][e] << 16) * rs * __uint_as_float(g[r][j][e] << 16), __uint_as_float(o[r][j][e] & 0xffff0000u) * rs * __uint_as_float(g[r][j][e] & 0xffff0000u));
                *(u32x4*)(YG + (size_t)row * 4096 + col) = y; } }
    }
}
constexpr size_t MiB = 1u << 20;
constexpr size_t WS_CTL = 0, CTL_ZERO_BYTES = 32 * 1024;
constexpr size_t CTL_QUEUE = 1024, CTL_TQ = 2048, CTL_ZVSTAT = 256 * 1024, CTL_SS = 512 * 1024, CTL_BAR = 8 * 1024;
constexpr size_t WS_ROPE_A = 2 * MiB, WS_ROPE_R = 3 * MiB;
constexpr size_t WS_WT = 8 * MiB;
constexpr size_t WT_ABIN = WS_WT, WT_ABOUT = WT_ABIN + 14 * MiB, WT_RETIN = WT_ABOUT + 8 * MiB, WT_RETOUT = WT_RETIN + 48 * MiB, WT_MEMQ = WT_RETOUT + 16 * MiB,
                 WT_MEMKV = WT_MEMQ + 4 * MiB, WT_MEMO = WT_MEMKV + 8 * MiB, WT_UP = WT_MEMO + 4 * MiB, WT_DOWN = WT_UP + 64 * MiB, WT_END = WT_DOWN + 64 * MiB;
constexpr size_t WS_H = 240 * MiB, WS_Y0 = 276 * MiB, WS_Y1 = 348 * MiB, WS_BIG = 420 * MiB, WS_CAT = 636 * MiB, WS_OR = 708 * MiB, WS_QM = 780 * MiB, WS_OM = 789 * MiB, WS_HM = 798 * MiB, WS_MKV = 802 * MiB, WS_XB = 804 * MiB, WS_RS = 840 * MiB, WS_WTD = 842 * MiB, WS_QM2 = 912 * MiB, WS_END = 922 * MiB;
static_assert((WS_QM2 - WS_QM) / 2 == QSEG, "q partial distance");
static_assert(WT_END <= WS_H, "weights fit");
constexpr size_t BIG_Q = 0, BIG_K = 18 * MiB, BIG_V = BIG_K + 9216 * 256 * 2, BIG_ZU = 27 * MiB, BIG_ZV = 45 * MiB;
constexpr size_t O_X = 0, O_SKP = 18874368, O_SVP = 18939904, O_SKS = 19005440, O_SVS = 23199744, O_GV = 27394048, O_RP = 28442624, O_RS = 30539776, O_MK = 164757504, O_MV = 165281792, O_END = 165806080;
constexpr int LDFF = FF + 64;
constexpr int LDS_BYTES = 147456, MISC_OFF = LDS_BYTES - 512;

#define XB_TMO      128
#define XB_XCNT(j)  (256  + 64 * (j))
#define XB_XSUB(j)  (1280 + 64 * (j))
#define XB_XGEN(j)  (2304 + 64 * (j))
#define XB_TOP      3328
#define XB_TOPGEN   3392
#define XCD_BAR_WORDS 3456
#define XB_SPIN_CAP (1u << 18)

__device__ __forceinline__ unsigned xb_ld(unsigned* p)              { return __hip_atomic_load(p, __ATOMIC_RELAXED, __HIP_MEMORY_SCOPE_AGENT); }
__device__ __forceinline__ unsigned xb_add(unsigned* p, unsigned v) { return __hip_atomic_fetch_add(p, v, __ATOMIC_RELAXED, __HIP_MEMORY_SCOPE_AGENT); }
__device__ __forceinline__ unsigned xb_xcc_id() { return (unsigned)__builtin_amdgcn_s_getreg((3 << 11) | 20) & 0xFu; }
#define XB_SPIN(cond, bar) do { unsigned _sp = 0; while (cond) { __builtin_amdgcn_s_sleep(1); \
    if ((++_sp & 255u) == 0u) { if (xb_ld(&(bar)[XB_TMO])) break; if (_sp > XB_SPIN_CAP) { atomicAdd(&(bar)[XB_TMO], 1u); break; } } } } while (0)

struct XcdBarrier {
    unsigned* bar; unsigned x;
    volatile LAS unsigned* st;
};

__device__ __forceinline__ XcdBarrier xcd_barrier_post(unsigned* bar, volatile LAS unsigned* st) {
    XcdBarrier b; b.bar = bar; b.x = xb_xcc_id(); b.st = st;
    if (threadIdx.x == 0) (void)xb_add(&bar[XB_XCNT(b.x)], 1u);
    return b;
}
__device__ __forceinline__ void xcd_barrier_complete(unsigned* bar, unsigned x, unsigned& nloc, unsigned& nx) {
    const unsigned G = gridDim.x * gridDim.y * gridDim.z;
    unsigned sum, cnt, mine, sp = 0u;
    for (;;) {
        sum = 0u; cnt = 0u; mine = 0u;
#pragma unroll
        for (unsigned j = 0; j < 16; ++j) { const unsigned c = xb_ld(&bar[XB_XCNT(j)]); sum += c; cnt += (c > 0u) ? 1u : 0u; mine = (j == x) ? c : mine; }
        if (sum == G) break;
        __builtin_amdgcn_s_sleep(1);
        if ((++sp & 255u) == 0u) { if (xb_ld(&bar[XB_TMO])) break; if (sp > XB_SPIN_CAP) { atomicAdd(&bar[XB_TMO], 1u); break; } }
    }
    nloc = mine > 0u ? mine : 1u; nx = cnt > 0u ? cnt : 1u;
}

__device__ __forceinline__ void xcd_barrier(const XcdBarrier& b) {
    asm volatile("s_waitcnt vmcnt(0)" ::: "memory");
    __syncthreads();
    if (threadIdx.x == 0) {
        unsigned* bar = b.bar;
        __builtin_amdgcn_s_waitcnt(0);
        unsigned nloc = b.st[0], nx = b.st[1];
        if (nloc == 0u) { xcd_barrier_complete(bar, b.x, nloc, nx); b.st[0] = nloc; b.st[1] = nx; }
        const unsigned old = xb_add(&bar[XB_XSUB(b.x)], 1u);
        const unsigned gen = old / nloc;
        if (old + 1u == (gen + 1u) * nloc) {
            __builtin_amdgcn_fence(__ATOMIC_RELEASE, "agent");
            asm volatile("s_waitcnt vmcnt(0)" ::: "memory");
            const unsigned og = xb_add(&bar[XB_TOP], 1u);
            const unsigned tg = og / nx;
            if (og + 1u == (tg + 1u) * nx) xb_add(&bar[XB_TOPGEN], 1u);
            else XB_SPIN(xb_ld(&bar[XB_TOPGEN]) == tg, bar);
            __builtin_amdgcn_fence(__ATOMIC_ACQUIRE, "agent");
            xb_add(&bar[XB_XGEN(b.x)], 1u);
            asm volatile("s_waitcnt vmcnt(0)" ::: "memory");
        } else {
            XB_SPIN(xb_ld(&bar[XB_XGEN(b.x)]) == gen, bar);
            __builtin_amdgcn_fence(__ATOMIC_ACQUIRE, "agent");
            asm volatile("s_waitcnt vmcnt(0)" ::: "memory");
        }
    }
    __syncthreads();
}

struct Args {
    const float *x_prompt, *x_sample, *cache_swa_k, *cache_swa_v, *state_ret, *cache_mem_k, *cache_mem_v, *mem_prompt;
    const float *norm_mix_pre, *norm_mix_post, *norm_mem, *norm_x_pre, *norm_x_post, *norm_ffn_pre, *norm_ffn_post;
    const float *w_ab_in, *w_ab_out, *swa_sinks, *gmlp_ln_g, *gmlp_ln_b, *gmlp_w_s, *gmlp_b_s, *w_ret_in, *w_ret_out, *w_mem_q, *w_mem_k, *w_mem_v, *w_mem_o, *w_ffn_up, *w_ffn_down;
    float* out; unsigned char* ws; int ph_lo, ph_hi, li, pad;
};
#ifndef PHASE_MASK
#define PHASE_MASK 0xFFFFFFFFu
#endif
#define EN(b) (((PHASE_MASK) >> (b)) & 1u)
#ifndef DUPMASK
#define DUPMASK 0u
#endif
#define REPS(b) ((((DUPMASK) >> (b)) & 1u) ? 2 : 1)
#define DUMMY(ptr_t, p_) (dup_ ? (ptr_t)(ws + WS_END + 64 * MiB) : (p_))
constexpr int N_PHASES = 25;

#define CAS __attribute__((address_space(4)))
#define KARGS ((const CAS Args*)__builtin_amdgcn_kernarg_segment_ptr())
#define ARG(f) (*(const float* const volatile CAS*)&(KARGS->f))
#define ARGI(f) (*(const int volatile CAS*)&(KARGS->f))
#define ARG_OUT() (*(float* const volatile CAS*)&(KARGS->out))
#define ARG_WS() (*(unsigned char* const volatile CAS*)&(KARGS->ws))
__global__ void __launch_bounds__(NTHR, 2) fwd(Args a_unused) {
    extern __shared__ __attribute__((aligned(16))) unsigned char lds_raw[];
    Frame F0; F0.lds = (LAS unsigned char*)lds_raw; F0.tid = threadIdx.x; F0.lane = F0.tid & 63; F0.wave = __builtin_amdgcn_readfirstlane(F0.tid >> 6);
    F0.G = gridDim.x; { const int bx = blockIdx.x; F0.vcu = (F0.G % 8 == 0) ? (bx % 8) * (F0.G / 8) + bx / 8 : bx; }
    volatile LAS unsigned* MISC = (volatile LAS unsigned*)(F0.lds + MISC_OFF);
    if (F0.tid < 128) MISC[F0.tid] = 0u;
    __syncthreads();
    const XcdBarrier bar = xcd_barrier_post((unsigned*)(ARG_WS() + WS_CTL + CTL_BAR) + ARGI(li) * XCD_BAR_WORDS, MISC + 8);
    const int lo = ARGI(ph_lo), hi = ARGI(ph_hi);
#define IN(k) (lo <= (k) && (k) < hi)
#define SEAM(k) do { if (IN(k) && IN((k) + 1)) xcd_barrier(bar); } while (0)
#define GW (F.vcu * NWAVES + F.wave)
#define NGW (F.G * NWAVES)
#define IDLE_TJOB(c0_, Wp, WTp, K_, N_, Gp, LDW) do { if ((int)blockIdx.x >= (c0_)) { const int nit_ = ((K_) / 64) * ((N_) / 64), nw_ = ((int)F.G - (c0_)) * NWAVES; const float* W_ = (Wp); bf16* WT_ = (bf16*)(WTp); \
        LAS float* scr_ = (LAS float*)(F.lds + F.wave * 16640); transpose_strided(W_, K_, N_, WT_, scr_, ((int)blockIdx.x - (c0_)) * NWAVES + F.wave, nw_, nit_, F.lane, (Gp), (LDW)); } } while (0)
#define PHASE_FRAME Frame P = F0; asm volatile("" : "+v"(P.tid), "+s"(P.wave), "+s"(P.vcu), "+s"(P.G)); P.lane = P.tid & 63

    if (EN(0) && IN(0)) { for (int rep_ = 0; rep_ < REPS(0); ++rep_) { PHASE_FRAME; const Frame& F = P; const bool dup_ = (rep_ != 0); (void)dup_; if (dup_) __syncthreads();
        unsigned char* ws = ARG_WS();
        LAS float* scr = (LAS float*)(F.lds + F.wave * 16640);
        const int gw = GW, ngw = NGW;
        { u32x4* z1 = (u32x4*)(ws + WS_CTL + CTL_ZVSTAT); u32x4* z2 = (u32x4*)(ws + WS_CTL + CTL_SS);
          for (int x = F.vcu * NTHR + F.tid; x < M * 2 * 8 / 16; x += F.G * NTHR) z1[x] = (u32x4){0u, 0u, 0u, 0u};
          for (int x = F.vcu * NTHR + F.tid; x < M * 8 * 8 / 16; x += F.G * NTHR) z2[x] = (u32x4){0u, 0u, 0u, 0u}; }
        int base = 0;
#define TJOB(Wp, WTp, K_, N_, Gp) do { const int nit = ((K_) / 64) * ((N_) / 64); int it = gw - (base % ngw); if (it < 0) it += ngw; const float* W_ = (Wp); bf16* WT_ = (bf16*)(WTp); \
            const float* G_ = (Gp); transpose_strided(W_, K_, N_, WT_, scr, it, ngw, nit, F.lane, G_, 0); base += nit; } while (0)
        TJOB(ARG(w_ab_in), ws + WT_ABIN, D, AB_IN, ARG(norm_mix_pre));
        TJOB(ARG(w_ab_out), ws + WT_ABOUT, D, D, (const float*)nullptr);
#pragma unroll 1
        for (int l = 0; l < 2; ++l) {
            TJOB(ARG(w_mem_q) + (size_t)l * D * MEMW, ws + WT_MEMQ + (size_t)l * MEMW * D * 2, D, MEMW, ARG(norm_x_pre) + (size_t)l * D);
            TJOB(ARG(w_mem_k) + (size_t)l * D * MEMW, ws + WT_MEMKV + (size_t)(2 * l) * MEMW * D * 2, D, MEMW, (const float*)nullptr);
            TJOB(ARG(w_mem_v) + (size_t)l * D * MEMW, ws + WT_MEMKV + (size_t)(2 * l + 1) * MEMW * D * 2, D, MEMW, (const float*)nullptr);
            TJOB(ARG(w_mem_o) + (size_t)l * MEMW * D, ws + WT_MEMO + (size_t)l * D * MEMW * 2, MEMW, D, (const float*)nullptr);
        }
#undef TJOB
        norm_rows<false, 4>(F, ARG(x_prompt), ARG(x_sample), nullptr, nullptr, nullptr, 0, nullptr, (float*)(ws + WS_RS), nullptr, (bf16*)(ws + WS_XB));
        { const float* memp = ARG(mem_prompt); const float* nmem = ARG(norm_mem); bf16* HM = (bf16*)(ws + WS_HM);
        for (int r2 = (gw + ngw - 1024 % ngw) % ngw; r2 < 1024; r2 += ngw) { const int l = r2 >> 9, row = r2 & 511;     const float* xr = memp + (size_t)row * D; const float* g = nmem + (size_t)l * D;
            f32x4 xv[8]; float ss = 0.f;
#pragma unroll
            for (int j = 0; j < 8; ++j) { xv[j] = ((const f32x4*)xr)[F.lane + 64 * j]; ss += (xv[j][0] * xv[j][0] + xv[j][1] * xv[j][1]) + (xv[j][2] * xv[j][2] + xv[j][3] * xv[j][3]); }
            const float rs = 1.0f / sqrtf(wave_sum(ss) * (1.0f / D) + EPS);
#pragma unroll
            for (int j = 0; j < 8; ++j) { const f32x4 gg = ((const f32x4*)g)[F.lane + 64 * j]; const f32x4 h = xv[j] * rs * gg; u32x2 w; w.x = pk2(h[0], h[1]); w.y = pk2(h[2], h[3]);
                ((u32x2*)(HM + (size_t)r2 * D))[F.lane + 64 * j] = w; } } }
    } }
    SEAM(0);

#pragma unroll 1
    for (int layer = 0; layer < 2; ++layer) {
        const int pb = 1 + 12 * layer;
        if (layer == 0) {
            if (EN(1) && IN(pb + 0)) { for (int rep_ = 0; rep_ < REPS(1); ++rep_) { PHASE_FRAME; const Frame& F = P; const bool dup_ = (rep_ != 0); (void)dup_; if (dup_) __syncthreads();
                unsigned char* ws = ARG_WS(); float* out = ARG_OUT(); bf16* BIG = (bf16*)(ws + WS_BIG);
                pg8::Gemm g{(const bf16*)(ws + WS_XB), (const bf16*)(ws + WT_ABIN), M, AB_IN, D}; pg8::StaticOrder S; S.init(M, AB_IN, D, F.G, (int)blockIdx.x);
                pg8::EpiAbIn E{BIG, out, (const float*)(ws + WS_RS), DUMMY(unsigned long long*, (unsigned long long*)(ws + WS_CTL + CTL_ZVSTAT))};
                static_assert(pg8::EpiAbIn::OK == BIG_K / 2 && pg8::EpiAbIn::OV == BIG_V / 2 && pg8::EpiAbIn::OZU == BIG_ZU / 2 && pg8::EpiAbIn::OZV == BIG_ZV / 2 && pg8::EpiAbIn::OKP == O_SKP && pg8::EpiAbIn::OVS == O_SVS, "maps");
                pg8::gemm_phase<pg8::EpiAbIn, pg8::StaticOrder, true, true>(F.lds, g, S, E);
            } }
            SEAM(pb + 0);
            if (IN(pb + 1)) {
                const bool sample_first = ((blockIdx.x >> 3) & 1) != 0;
#pragma unroll 1
                for (int step = 0; step < 2; ++step) {
                  if ((step == 0) != sample_first) {
                if (EN(2)) { for (int rep_ = 0; rep_ < REPS(2); ++rep_) { PHASE_FRAME; const Frame& F = P; const bool dup_ = (rep_ != 0); (void)dup_; if (dup_) __syncthreads();     unsigned char* ws = ARG_WS(); const bf16* BIG = (const bf16*)(ws + WS_BIG); const float* sinks = ARG(swa_sinks);
                    for (int u = F.vcu; u < 256; u += F.G) swa_prompt_unit(F, u >> 7, (u >> 2) & 31, u & 3, BIG + BIG_Q / 2, BIG + BIG_K / 2, BIG + BIG_V / 2, sinks, (bf16*)(ws + WS_CAT)); } }
                if (EN(3)) { for (int rep_ = 0; rep_ < REPS(3); ++rep_) { PHASE_FRAME; const Frame& F = P; const bool dup_ = (rep_ != 0); (void)dup_; if (dup_) __syncthreads();     unsigned char* ws = ARG_WS(); const bf16* BIG = (const bf16*)(ws + WS_BIG);
                    const float *lng = ARG(gmlp_ln_g), *lnb = ARG(gmlp_ln_b), *wsp = ARG(gmlp_w_s), *bsp = ARG(gmlp_b_s);
                    for (int u = F.vcu; u < 256; u += F.G) gate_prompt_unit(F, u >> 7, (u >> 2) & 31, u & 3, BIG + BIG_ZU / 2, BIG + BIG_ZV / 2, (const long long*)(ws + WS_CTL + CTL_ZVSTAT), lng, lnb, wsp, bsp, (bf16*)(ws + WS_CAT)); } }
                  } else {
                if (EN(4)) { for (int rep_ = 0; rep_ < REPS(4); ++rep_) { PHASE_FRAME; const Frame& F = P; const bool dup_ = (rep_ != 0); (void)dup_; if (dup_) __syncthreads();     unsigned char* ws = ARG_WS(); float* out = ARG_OUT(); const bf16* BIG = (const bf16*)(ws + WS_BIG); const float *ck = ARG(cache_swa_k), *cv = ARG(cache_swa_v), *sinks = ARG(swa_sinks);
                    for (int u = F.vcu; u < 256; u += F.G) swa_sample_unit(F, u >> 1, u & 1, BIG + BIG_Q / 2, BIG + BIG_K / 2, BIG + BIG_V / 2, ck, cv, sinks, (bf16*)(ws + WS_CAT), out + O_SKS, out + O_SVS); } }
                if (EN(5)) { for (int rep_ = 0; rep_ < REPS(5); ++rep_) { PHASE_FRAME; const Frame& F = P; const bool dup_ = (rep_ != 0); (void)dup_; if (dup_) __syncthreads();     unsigned char* ws = ARG_WS(); float* out = ARG_OUT(); const bf16* BIG = (const bf16*)(ws + WS_BIG);
                    const float *lng = ARG(gmlp_ln_g), *lnb = ARG(gmlp_ln_b), *wsp = ARG(gmlp_w_s), *bsp = ARG(gmlp_b_s);
                    for (int u = F.vcu; u < 256; u += F.G) gate_sample_unit(F, u >> 1, u & 1, BIG + BIG_ZU / 2, BIG + BIG_ZV / 2, (const long long*)(ws + WS_CTL + CTL_ZVSTAT), lng, lnb, wsp, bsp, (bf16*)(ws + WS_CAT), out + O_GV); } }
                  }
                }
            }
            SEAM(pb + 1);
            if (EN(6) && IN(pb + 3)) { for (int rep_ = 0; rep_ < REPS(6); ++rep_) { PHASE_FRAME; const Frame& F = P; const bool dup_ = (rep_ != 0); (void)dup_; if (dup_) __syncthreads();
                unsigned char* ws = ARG_WS();
                pg8::Gemm g{(const bf16*)(ws + WS_CAT), (const bf16*)(ws + WT_ABOUT), M, D, D}; pg8::PanelK S; S.init(D, F.G, F.vcu);
                pg8::EpiPart E{(bf16*)(ws + WS_Y0), (bf16*)(ws + WS_Y1)};
                pg8::gemm_phase<pg8::EpiPart, pg8::PanelK, true, true>(F.lds, g, S, E);
            } }
        } else {
            if (EN(7) && IN(pb + 0)) { for (int rep_ = 0; rep_ < REPS(7); ++rep_) { PHASE_FRAME; const Frame& F = P; const bool dup_ = (rep_ != 0); (void)dup_; if (dup_) __syncthreads();
                unsigned char* ws = ARG_WS();
                pg8::Gemm g{(const bf16*)(ws + WS_XB), (const bf16*)(ws + WT_RETIN), M, RET_IN, D}; pg8::StaticOrder S; S.init(M, RET_IN, D, F.G, (int)blockIdx.x);
                pg8::EpiRetIn E{(bf16*)(ws + WS_BIG), (const float*)(ws + WS_RS)};
                pg8::gemm_phase<pg8::EpiRetIn, pg8::StaticOrder, true, true>(F.lds, g, S, E);
            } }
            SEAM(pb + 0);
            if (IN(pb + 1)) {
                const int bx = blockIdx.x; const bool halves = (F0.G % 16 == 0);
                const int role = halves ? ((bx >> 3) & 1) : 0, rank = halves ? ((bx & 7) + 8 * (bx >> 4)) : bx, nrole0 = halves ? F0.G / 2 : F0.G;
                if (EN(9) && role == 0) { for (int rep_ = 0; rep_ < REPS(9); ++rep_) { PHASE_FRAME; const Frame& F = P; const bool dup_ = (rep_ != 0); (void)dup_; if (dup_) __syncthreads();     unsigned char* ws = ARG_WS(); float* out = ARG_OUT();
#ifdef SCAN_DELAY_TICKS
                    { const unsigned long long t0_ = __builtin_amdgcn_s_memrealtime(); while (__builtin_amdgcn_s_memrealtime() - t0_ < SCAN_DELAY_TICKS) __builtin_amdgcn_s_sleep(8); }
#endif
                    for (int u = rank; u < 128; u += nrole0) ret_prompt_scan(F, u >> 6, (u >> 3) & 7, u & 7, (const bf16*)(ws + WS_BIG), (bf16*)(ws + WS_OR), DUMMY(unsigned long long*, (unsigned long long*)(ws + WS_CTL + CTL_SS)), out + O_RP); } }
                if (EN(8)) { for (int rep_ = 0; rep_ < REPS(8); ++rep_) { PHASE_FRAME; const Frame& F = P; const bool dup_ = (rep_ != 0); (void)dup_; if (dup_) __syncthreads();     unsigned char* ws = ARG_WS(); float* out = ARG_OUT(); const float* st = ARG(state_ret);
                    unsigned* qctr = (unsigned*)(ws + WS_CTL + CTL_QUEUE) + (dup_ ? 64 : 0); volatile LAS unsigned* qw = (volatile LAS unsigned*)(F.lds + MISC_OFF + 64);
                    for (;;) {
                        if (F.tid == 0) qw[0] = atomicAdd(qctr, 1u);
                        __syncthreads();
                        const unsigned pss = (unsigned)__builtin_amdgcn_readfirstlane((int)qw[0]);
                        __syncthreads();
                        if (pss >= 512u) break;
                        ret_sample_pass(F, (int)pss * 2, (const bf16*)(ws + WS_BIG), st, out + O_RS, (bf16*)(ws + WS_OR), DUMMY(unsigned long long*, (unsigned long long*)(ws + WS_CTL + CTL_SS))); } } }
            }
            SEAM(pb + 1);
            if (EN(10) && IN(pb + 2)) { for (int rep_ = 0; rep_ < REPS(10); ++rep_) { PHASE_FRAME; const Frame& F = P; const bool dup_ = (rep_ != 0); (void)dup_; if (dup_) __syncthreads();     unsigned char* ws = ARG_WS(); ret_norm_rows<5>(F, (const bf16*)(ws + WS_OR), (const bf16*)(ws + WS_BIG), (const unsigned long long*)(ws + WS_CTL + CTL_SS), (bf16*)(ws + WS_CAT)); } }
            SEAM(pb + 2);
            if (EN(11) && IN(pb + 3)) { for (int rep_ = 0; rep_ < REPS(11); ++rep_) { PHASE_FRAME; const Frame& F = P; const bool dup_ = (rep_ != 0); (void)dup_; if (dup_) __syncthreads();
                unsigned char* ws = ARG_WS();
                pg8::Gemm g{(const bf16*)(ws + WS_CAT), (const bf16*)(ws + WT_RETOUT), M, D, 4096}; pg8::PanelK S; S.init(4096, F.G, F.vcu);
                pg8::EpiPart E{(bf16*)(ws + WS_Y0), (bf16*)(ws + WS_Y1)};
                pg8::gemm_phase<pg8::EpiPart, pg8::PanelK, true, true>(F.lds, g, S, E);
            } }
        }
        SEAM(pb + 3);
        if (EN(12) && IN(pb + 4)) { for (int rep_ = 0; rep_ < REPS(12); ++rep_) { PHASE_FRAME; const Frame& F = P; const bool dup_ = (rep_ != 0); (void)dup_; if (dup_) __syncthreads();
            unsigned char* ws = ARG_WS(); float* X = ARG_OUT() + O_X;
            pg8::PanelK S; S.init(layer == 0 ? D : 4096, F.G, 0);
            bf16* XB = (bf16*)(ws + WS_XB); (void)X;
            norm_rows_pipe<true>(F, XB, (const bf16*)(ws + WS_Y0), (const bf16*)(ws + WS_Y1), S.splits, ARG(norm_mix_post) + (size_t)layer * D, DUMMY(float*, (float*)(ws + WS_RS)), nullptr, DUMMY(bf16*, XB));
        } }
        SEAM(pb + 4);
        if (IN(pb + 5)) {
            if (EN(13)) { for (int rep_ = 0; rep_ < REPS(13); ++rep_) { PHASE_FRAME; const Frame& F = P; const bool dup_ = (rep_ != 0); (void)dup_; if (dup_) __syncthreads();     unsigned char* ws = ARG_WS();
              pg8::Gemm g{(const bf16*)(ws + WS_XB), (const bf16*)(ws + WT_MEMQ) + (size_t)layer * MEMW * D, M, MEMW, D}; pg8::SplitK2 S; S.init(D, F.G, (int)blockIdx.x);
              pg8::EpiBf16<0> E{(bf16*)(ws + WS_QM), MEMW, (const float*)(ws + WS_RS), QSEG};
              pg8::gemm_phase<pg8::EpiBf16<0>, pg8::SplitK2, true, true>(F.lds, g, S, E); } }
            if (EN(14) && layer == 0) { for (int rep_ = 0; rep_ < REPS(14); ++rep_) { PHASE_FRAME; const Frame& F = P; const bool dup_ = (rep_ != 0); (void)dup_; if (dup_) __syncthreads();     unsigned char* ws = ARG_WS(); float* out = ARG_OUT();
                pg8::Gemm g{(const bf16*)(ws + WS_HM), (const bf16*)(ws + WT_MEMKV), 1024, 2048, D}; pg8::MemKVOrder S{F.G, (int)((blockIdx.x + F.G - (144 % F.G)) % F.G)};
                pg8::EpiMemKV E{out + O_MK, out + O_MV, (bf16*)(ws + WS_MKV)};
                pg8::gemm_phase<pg8::EpiMemKV, pg8::MemKVOrder, true, true>(F.lds, g, S, E);
            } }
            if (EN(22)) { for (int rep_ = 0; rep_ < REPS(22); ++rep_) { PHASE_FRAME; const Frame& F = P; const bool dup_ = (rep_ != 0); if (dup_) __syncthreads(); unsigned char* ws = ARG_WS();
                unsigned* tq = (unsigned*)(ws + WS_CTL + CTL_TQ) + layer * 64 + (dup_ ? 128 : 0); LAS float* scr = (LAS float*)(F.lds + F.wave * 16640);
                const int n_up = (D / 64) * (FF / 64), n_dn = (layer == 0) ? n_up : 0, n_ro = (layer == 0) ? (4096 / 64) * (D / 64) : 0, n_all = n_up + n_dn + n_ro;
                const float* w_up = ARG(w_ffn_up) + (size_t)layer * D * FF; const float* w_dn = ARG(w_ffn_down) + (size_t)layer * FF * D; const float* w_ro = ARG(w_ret_out); const float* g_up = ARG(norm_ffn_pre) + (size_t)layer * D;
                volatile LAS unsigned* tqw = (volatile LAS unsigned*)(F.lds + MISC_OFF + 96);
#define TQ_RUN(qi, Wp, K_, N_, WTp, Gp, LDW, NIT) do { const int nit_ = (NIT); const float* W_ = (Wp); bf16* WT_ = (bf16*)(WTp); const float* G_ = (Gp); \
                    for (;;) { if (F.tid == 0) tqw[0] = atomicAdd(tq + (qi) * 16, 64u); __syncthreads(); const int base = __builtin_amdgcn_readfirstlane((int)tqw[0]); __syncthreads(); if (base >= nit_) break; \
                        transpose_strided(W_, K_, N_, WT_, scr, base + F.wave, 8, (base + 64 < nit_) ? base + 64 : nit_, F.lane, G_, (LDW)); } } while (0)
                TQ_RUN(0, w_up, D, FF, ws + WT_UP + (size_t)layer * FF * D * 2, g_up, 0, n_up);
                if (layer == 0) { TQ_RUN(1, w_dn, FF, D, ws + WS_WTD, (const float*)nullptr, LDFF, n_dn); TQ_RUN(2, w_ro, 4096, D, ws + WT_RETOUT, (const float*)nullptr, 0, n_ro); }
#undef TQ_RUN
                (void)n_all; } }
        }
        SEAM(pb + 5);
        if (IN(pb + 6)) {
            { const bool sample_first = ((blockIdx.x >> 3) & 1) != 0;
#pragma unroll 1
              for (int step = 0; step < 2; ++step) {
                  if ((step == 0) != sample_first) { if (EN(15)) { PHASE_FRAME; const Frame& F = P; unsigned char* ws = ARG_WS();
                      for (int u = F.vcu; u < 256; u += F.G) mem_prompt_unit(F, u >> 7, (u >> 5) & 3, u & 31, (const bf16*)(ws + WS_QM), (const bf16*)(ws + WS_MKV) + (size_t)layer * 512 * 1024, (bf16*)(ws + WS_OM)); } }
                  else { if (EN(16)) { PHASE_FRAME; const Frame& F = P; unsigned char* ws = ARG_WS(); const float* ck = ARG(cache_mem_k) + (size_t)layer * NS * 256 * 512; const float* cv = ARG(cache_mem_v) + (size_t)layer * NS * 256 * 512;
                      mem_sample_units(F, F.vcu, F.G, (const bf16*)(ws + WS_QM), ck, cv, (bf16*)(ws + WS_OM)); } } } }
        }
        SEAM(pb + 6);
        if (EN(17) && IN(pb + 7)) { for (int rep_ = 0; rep_ < REPS(17); ++rep_) { PHASE_FRAME; const Frame& F = P; const bool dup_ = (rep_ != 0); (void)dup_; if (dup_) __syncthreads();
            unsigned char* ws = ARG_WS();
            pg8::Gemm g{(const bf16*)(ws + WS_OM), (const bf16*)(ws + WT_MEMO) + (size_t)layer * D * MEMW, M, D, MEMW}; pg8::PanelK S; S.init(MEMW, F.G, F.vcu);
            pg8::EpiPart E{(bf16*)(ws + WS_Y0), (bf16*)(ws + WS_Y1)};
            pg8::gemm_phase<pg8::EpiPart, pg8::PanelK, true, true>(F.lds, g, S, E);
        } }
        SEAM(pb + 7);
        if (EN(18) && IN(pb + 8)) { for (int rep_ = 0; rep_ < REPS(18); ++rep_) { PHASE_FRAME; const Frame& F = P; const bool dup_ = (rep_ != 0); (void)dup_; if (dup_) __syncthreads();     unsigned char* ws = ARG_WS(); float* X = ARG_OUT() + O_X;
            bf16* XB = (bf16*)(ws + WS_XB); (void)X;
            norm_rows_pipe<true>(F, XB, (const bf16*)(ws + WS_Y0), (const bf16*)(ws + WS_Y1), 4, ARG(norm_x_post) + (size_t)layer * D, DUMMY(float*, (float*)(ws + WS_RS)), nullptr, DUMMY(bf16*, XB)); } }
        SEAM(pb + 8);
        if (EN(19) && IN(pb + 9)) { for (int rep_ = 0; rep_ < REPS(19); ++rep_) { PHASE_FRAME; const Frame& F = P; const bool dup_ = (rep_ != 0); (void)dup_; if (dup_) __syncthreads();
            unsigned char* ws = ARG_WS();
            pg8::Gemm g{(const bf16*)(ws + WS_XB), (const bf16*)(ws + WT_UP) + (size_t)layer * FF * D, M, FF, D}; pg8::StaticOrder S; S.init(M, FF, D, F.G, (int)blockIdx.x);
            pg8::EpiBf16<2> E{(bf16*)(ws + WS_BIG), LDFF, (const float*)(ws + WS_RS)};
            pg8::gemm_phase<pg8::EpiBf16<2>, pg8::StaticOrder, true, true>(F.lds, g, S, E);
            { const int c0 = (F.G > 128) ? 128 : 0;
              if (layer == 0) IDLE_TJOB(c0, ARG(w_ret_in), ws + WT_RETIN, D, RET_IN, ARG(norm_mix_pre) + D, 0);
              else IDLE_TJOB(c0, ARG(w_ffn_down) + (size_t)FF * D, ws + WS_WTD + (size_t)D * LDFF * 2, FF, D, (const float*)nullptr, LDFF); }
        } }
        SEAM(pb + 9);
        if (EN(20) && IN(pb + 10)) { for (int rep_ = 0; rep_ < REPS(20); ++rep_) { PHASE_FRAME; const Frame& F = P; const bool dup_ = (rep_ != 0); (void)dup_; if (dup_) __syncthreads();
            unsigned char* ws = ARG_WS();
            pg8::Gemm g{(const bf16*)(ws + WS_BIG), (const bf16*)(ws + WS_WTD) + (size_t)layer * D * LDFF, M, D, FF, LDFF, LDFF}; pg8::PanelK S; S.init(FF, F.G, F.vcu);
            pg8::EpiPart E{(bf16*)(ws + WS_Y0), (bf16*)(ws + WS_Y1)};
            pg8::gemm_phase<pg8::EpiPart, pg8::PanelK, true, true>(F.lds, g, S, E);
        } }
        SEAM(pb + 10);
        if (EN(21) && IN(pb + 11)) { for (int rep_ = 0; rep_ < REPS(21); ++rep_) { PHASE_FRAME; const Frame& F = P; const bool dup_ = (rep_ != 0); (void)dup_; if (dup_) __syncthreads();     unsigned char* ws = ARG_WS(); float* X = ARG_OUT() + O_X;
            pg8::PanelK S; S.init(FF, F.G, 0);
            bf16* XB = (bf16*)(ws + WS_XB);
            norm_rows_pipe<false>(F, XB, (const bf16*)(ws + WS_Y0), (const bf16*)(ws + WS_Y1), S.splits, ARG(norm_ffn_post) + (size_t)layer * D, layer == 0 ? DUMMY(float*, (float*)(ws + WS_RS)) : (float*)nullptr,
                            layer == 0 ? (float*)nullptr : DUMMY(float*, X), layer == 0 ? DUMMY(bf16*, XB) : (bf16*)nullptr); } }
        if (layer == 0) SEAM(pb + 11);
    }
#undef IN
#undef SEAM
}

#ifndef MK_N_LAUNCHES
#define MK_N_LAUNCHES 1
#endif
extern "C" void kernel_launch(void* const* d_in, const int* in_sizes, int n_in, void* d_out, int out_size, void* d_ws, size_t ws_size, hipStream_t stream) {
    static int grid = 0;
    if (grid == 0) {
        if (n_in != 30 || out_size != (int)O_END || ws_size < WS_END) { fprintf(stderr, "kernel_launch: unexpected shapes (n_in %d, out %d, ws %zu)\n", n_in, out_size, ws_size); grid = -1; return; }
        int dev = 0, cus = 0, per_cu = 0;
        if (hipGetDevice(&dev) != hipSuccess || hipDeviceGetAttribute(&cus, hipDeviceAttributeMultiprocessorCount, dev) != hipSuccess) { grid = -1; return; }
        if (hipFuncSetAttribute((const void*)fwd, hipFuncAttributeMaxDynamicSharedMemorySize, LDS_BYTES) != hipSuccess) { fprintf(stderr, "kernel_launch: hipFuncSetAttribute failed\n"); grid = -1; return; }
        if (hipOccupancyMaxActiveBlocksPerMultiprocessor(&per_cu, (const void*)fwd, NTHR, LDS_BYTES) != hipSuccess || per_cu < 1) fprintf(stderr, "kernel_launch: occupancy query says %d\n", per_cu);
        (void)hipGetLastError();
        grid = cus;
    }
    if (grid < 0) return;
    (void)hipMemsetAsync((char*)d_ws + WS_CTL, 0, CTL_ZERO_BYTES, stream);
    Args a{};
    const float** p = (const float**)&a;
    for (int i = 0; i < 30; ++i) p[i] = (const float*)d_in[i];
    a.out = (float*)d_out; a.ws = (unsigned char*)d_ws; a.pad = 0;
    for (int li = 0; li < MK_N_LAUNCHES; ++li) {
        a.ph_lo = (MK_N_LAUNCHES == 1) ? 0 : li; a.ph_hi = (MK_N_LAUNCHES == 1) ? N_PHASES : li + 1; a.li = li;
        hipLaunchKernelGGL(fwd, dim3(grid), dim3(NTHR), LDS_BYTES, stream, a);
    }
}
```

```cpp
#include <hip/hip_runtime.h>
#include <cstdio>
#include <cstdint>

namespace pg8 {
#define PG8_LAS __attribute__((address_space(3)))
typedef unsigned short bf16_t;
typedef short bf16x8 __attribute__((ext_vector_type(8)));
typedef float f32x4 __attribute__((ext_vector_type(4)));
typedef unsigned u32x4 __attribute__((ext_vector_type(4)));
typedef unsigned u32x2 __attribute__((ext_vector_type(2)));
constexpr int BM = 256, BK = 64, HALF = 128, HTB = HALF * BK * 2  , STAGE_BYTES = 8 * HTB, NXCD = 8, WGM = 8;

__host__ __device__ __forceinline__ int lds_byte(int r, int c) { const int st = (r >> 4) * 2 + (c >> 5), rr = r & 15, cc = c & 31, ob = rr * 64 + cc * 2; return st * 1024 + (ob ^ (((ob >> 9) & 1) << 5)); }
__host__ __device__ __forceinline__ void stage_rc(int b, int& R, int& C) { const int st = b / 1024, sb = b % 1024, swz = sb ^ (((sb >> 9) & 1) << 5); R = (st >> 1) * 16 + swz / 64; C = (st & 1) * 32 + (swz % 64) / 2; }
__host__ __device__ __forceinline__ int perm32(int rho) { const int n = rho >> 4, i = rho & 15; return 8 * (i >> 2) + 4 * n + (i & 3); }

struct Unit { int pm, pn, kt0, nkt; };
struct Gemm { const bf16_t* A; const bf16_t* Bt; int M, N, K; int lda = 0, ldb = 0; };

struct StaticOrder {
    int nM, nN, nwg, G, c, nkt;
    __device__ void init(int M, int N, int K, int G_, int c_) { nM = M / BM; nN = N / BM; nwg = nM * nN; G = G_; c = c_; nkt = K / BK; }
    __device__ bool next(int i, Unit& u) const {
        const int L = i * G + c; if (L >= nwg) return false;
        int wgid = L; { const int q = nwg >> 3, r = nwg & 7, xcd = wgid & 7, off = wgid >> 3; wgid = (xcd < r ? xcd * (q + 1) : r * (q + 1) + (xcd - r) * q) + off; }
        const int nig = WGM * nN, gid = wgid / nig, rem = wgid - gid * nig, fm = gid * WGM; const bool full = (nM - fm) >= WGM;
        u.pm = fm + (full ? (rem & 7) : (rem & 3)); u.pn = full ? (rem >> 3) : (rem >> 2); u.kt0 = 0; u.nkt = nkt; return true;
    }
};
struct StreamK {
    int dpu, nN, w; long S, total;
    __device__ void init(int M, int N, int K, int G_, int w_) { dpu = K / (2 * BK); nN = N / BM; total = (long)(M / BM) * nN * dpu; S = (total + G_ - 1) / G_; w = w_; }
    __device__ bool next(int i, Unit& u) const {
        long pos = (long)w * S; long end = pos + S; if (end > total) end = total;
        for (int k = 0;; ++k) {
            if (pos >= end) return false;
            const int un = (int)(pos / dpu), off = (int)(pos % dpu); long len = dpu - off; if (len > end - pos) len = end - pos;
            if (k == i) { u.pm = un / nN; u.pn = un % nN; u.kt0 = 2 * off; u.nkt = 2 * (int)len; return true; }
            pos += len;
        }
    }
    __device__ static bool split(int pm, int pn, int nN_, int dpu_, long S_) { const long a = (long)(pm * nN_ + pn) * dpu_; return (a / S_) != ((a + dpu_ - 1) / S_); }
};

struct SplitK2 {
    int G, c, nkt;
    __device__ void init(int K, int G_, int c_) { G = G_; c = c_; nkt = K / BK; }
    __device__ bool next(int i, Unit& u) const { const int idx = i * G + c; if (idx >= 144) return false; const int un = idx >> 1; u.pm = un >> 1; u.pn = un & 1; u.kt0 = (idx & 1) * (nkt >> 1); u.nkt = nkt >> 1; return true; }
};
struct PanelK {
    int w, G, nkt, ls;
    int splits;
    __device__ void init(int K, int G_, int w_) { w = w_; G = G_; nkt = K / BK; ls = (nkt >= 16) ? 3 : 2; splits = 1 << ls; }
    __device__ bool next(int i, Unit& u) const {
        int np = 0; for (int x = w; x < 256; x += G) ++np;
        if (i < np) { const int un = w + i * G; u.pm = un >> 3; u.pn = un & 7; u.kt0 = 0; u.nkt = nkt; return true; }
        const int idx = w + (i - np) * G; if (idx >= (32 << ls)) return false;
        const int ns = nkt >> ls, seg = (idx >> 3) & (splits - 1);
        u.pm = 32 + (idx >> (3 + ls)); u.pn = idx & 7; u.kt0 = seg * ns; u.nkt = ns; return true;
    }
};

typedef float f32x2_cv __attribute__((ext_vector_type(2))); typedef __bf16 bf16x2_cv __attribute__((ext_vector_type(2)));
__device__ __forceinline__ unsigned cvt_pk_bf16(float lo, float hi) { const f32x2_cv v = {lo, hi}; const bf16x2_cv b = __builtin_convertvector(v, bf16x2_cv); return __builtin_bit_cast(unsigned, b); }

constexpr int MROWS = 9216, NPROMPT = 8192, SEQ = 4096;
__device__ __forceinline__ float pos_of_row(int row) { return (float)(row < NPROMPT ? (row & (SEQ - 1)) : 8192 + ((row - NPROMPT) & 7)); }
__device__ __forceinline__ float rope_inv_turns(int i, float inv_half_log2theta) { return __builtin_amdgcn_exp2f(-(float)i * inv_half_log2theta) * 0.15915494309189535f; }
__device__ __forceinline__ void sincos_turns(float t, float& sn, float& cs) { const float f = __builtin_amdgcn_fractf(t); sn = __builtin_amdgcn_sinf(f); cs = __builtin_amdgcn_cosf(f); }
__device__ __forceinline__ float gelu_tanh(float x) {
    const float u = 0.7978845608028654f * (x + 0.044715f * x * x * x);
    return x * __builtin_amdgcn_rcpf(1.0f + __builtin_amdgcn_exp2f(-2.885390081777927f * u));
}
__device__ __forceinline__ float silu_f(float x) { return x * __builtin_amdgcn_rcpf(1.0f + __builtin_amdgcn_exp2f(-1.4426950408889634f * x)); }
__device__ __forceinline__ u32x4 pack8(const f32x4& a, const f32x4& b) { u32x4 w; w.x = cvt_pk_bf16(a[0], a[1]); w.y = cvt_pk_bf16(a[2], a[3]); w.z = cvt_pk_bf16(b[0], b[1]); w.w = cvt_pk_bf16(b[2], b[3]); return w; }

struct EpiPart {
    static constexpr bool PERM = true, AFTER_DRAIN = false;
    bf16_t* Y; bf16_t* P;
    __device__ __forceinline__ void operator()(const f32x4 (&acc)[2][2][4][2], const Unit& u, int wr, int wc, int fr, int fq) const {
        bf16_t* base = (u.pm < 32) ? Y + (size_t)u.pm * BM * 2048 : P + ((size_t)(u.kt0 >> __builtin_ctz(u.nkt)) * 1024 + (size_t)(u.pm - 32) * BM) * 2048;
        const int col0 = u.pn * BM + wc * 32 + 8 * fq;
#pragma unroll
        for (int ai = 0; ai < 2; ++ai)
#pragma unroll
            for (int m = 0; m < 4; ++m) { bf16_t* rowp = base + (size_t)(ai * HALF + wr * 64 + m * 16 + fr) * 2048 + col0;
#pragma unroll
                for (int bj = 0; bj < 2; ++bj) *(u32x4*)(rowp + bj * HALF) = pack8(acc[ai][bj][m][0], acc[ai][bj][m][1]);
                if (m == 3) asm volatile("" ::: "memory"); }
    }
};
template <int ACT> struct EpiBf16 {
    static constexpr bool PERM = true, AFTER_DRAIN = false;
    bf16_t* O; int ldc; const float* rs;
    size_t seg_stride = 0;
    __device__ __forceinline__ void operator()(const f32x4 (&acc)[2][2][4][2], const Unit& u, int wr, int wc, int fr, int fq) const {
        const int col0 = u.pn * BM + wc * 32 + 8 * fq;
        float rsv[2][4];
#pragma unroll
        for (int ai = 0; ai < 2; ++ai)
#pragma unroll
            for (int m = 0; m < 4; ++m) rsv[ai][m] = rs[u.pm * BM + ai * HALF + wr * 64 + m * 16 + fr];
#pragma unroll
        for (int ai = 0; ai < 2; ++ai)
#pragma unroll
            for (int m = 0; m < 4; ++m) { const int row = u.pm * BM + ai * HALF + wr * 64 + m * 16 + fr; const float scale = rsv[ai][m]; bf16_t* rowp = O + (u.kt0 ? seg_stride : 0) + (size_t)row * ldc + col0;
#pragma unroll
                for (int bj = 0; bj < 2; ++bj) { f32x4 v0 = acc[ai][bj][m][0], v1 = acc[ai][bj][m][1];
                    if (ACT == 2) {
#pragma unroll
                        for (int e = 0; e < 4; ++e) { const float a = fmaxf(v0[e] * scale, 0.f), b = fmaxf(v1[e] * scale, 0.f); v0[e] = a * a; v1[e] = b * b; } }
                    else { v0 = v0 * scale; v1 = v1 * scale; }
                    *(u32x4*)(rowp + bj * HALF) = pack8(v0, v1); }
                if (m == 3) asm volatile("" ::: "memory"); }
    }
};
struct EpiAbIn {
    static constexpr bool PERM = true, AFTER_DRAIN = false;
    bf16_t* big; float* out;
    const float* rs;
    unsigned long long* zvstat;
    static constexpr size_t OQ = 0, OK = 9437184, OV = OK + 2359296, OZU = 14155776, OZV = 23592960;
    static constexpr size_t OKP = 18874368, OVP = 18939904, OKS = 19005440, OVS = 23199744;
    __device__ __forceinline__ void operator()(const f32x4 (&acc)[2][2][4][2], const Unit& u, int wr, int wc, int fr, int fq) const {
        const int pn = u.pn;
        bf16_t* const Q = big + OQ; bf16_t* const K = big + OK; bf16_t* const V = big + OV; bf16_t* const ZU = big + OZU; bf16_t* const ZV = big + OZV;
        float* const okp = out + OKP; float* const ovp = out + OVP; float* const oks = out + OKS; float* const ovs = out + OVS;
        float rsv[2][4];
#pragma unroll
        for (int ai = 0; ai < 2; ++ai)
#pragma unroll
            for (int m = 0; m < 4; ++m) rsv[ai][m] = rs[u.pm * BM + ai * HALF + wr * 64 + m * 16 + fr];
#pragma unroll
        for (int ai = 0; ai < 2; ++ai)
#pragma unroll
            for (int m = 0; m < 4; ++m) {
                const int row = u.pm * BM + ai * HALF + wr * 64 + m * 16 + fr; const float rsc = rsv[ai][m];
                if (pn < 5) {
                    const float pos = pos_of_row(row);
#pragma unroll
                    for (int bj = 0; bj < 2; ++bj) { f32x4 v0 = acc[ai][bj][m][0] * rsc, v1 = acc[ai][bj][m][1] * rsc;
                        if ((wc & 1) == 0) {
                            const float sg = (fq == 0) ? -1.f : 1.f;
#pragma unroll
                            for (int e = 0; e < 4; ++e) { const float p0 = __shfl_xor(v0[e], 16), p1 = __shfl_xor(v1[e], 16); float sn, cs;
                                constexpr float IT[8] = {1.591549431e-01f, 3.086376340e-02f, 5.985185713e-03f, 1.160663641e-03f, 2.250790790e-04f, 4.364795279e-05f, 8.464330808e-06f, 1.641426263e-06f};
                                sincos_turns(pos * IT[e], sn, cs); const float r0 = v0[e] * cs + sg * p0 * sn;
                                sincos_turns(pos * IT[4 + e], sn, cs); const float r1 = v1[e] * cs + sg * p1 * sn;
                                if (fq < 2) { v0[e] = r0; v1[e] = r1; } }
                        }
                        const int c = bj * HALF + wc * 32 + 8 * fq;
                        if (pn < 4) *(u32x4*)(Q + (size_t)row * 1024 + pn * BM + c) = pack8(v0, v1);
                        else { *(u32x4*)(K + (size_t)row * 256 + c) = pack8(v0, v1);
                            float* o = nullptr;
                            if (row < NPROMPT) { const int s = row & (SEQ - 1); if (s >= SEQ - 128) o = okp + ((size_t)(row >> 12) * 128 + (s - (SEQ - 128))) * 256 + c; }
                            else { const int r = row - NPROMPT; o = oks + ((size_t)(r >> 3) * 128 + 120 + (r & 7)) * 256 + c; }
                            if (o) { *(f32x4*)o = v0; *(f32x4*)(o + 4) = v1; } }
                    }
                } else if (pn == 5) {
#pragma unroll
                    for (int bj = 0; bj < 2; ++bj) { const f32x4 v0 = acc[ai][bj][m][0] * rsc, v1 = acc[ai][bj][m][1] * rsc; const int c = bj * HALF + wc * 32 + 8 * fq;
                        *(u32x4*)(V + (size_t)row * 256 + c) = pack8(v0, v1);
                        float* o = nullptr;
                        if (row < NPROMPT) { const int s = row & (SEQ - 1); if (s >= SEQ - 128) o = ovp + ((size_t)(row >> 12) * 128 + (s - (SEQ - 128))) * 256 + c; }
                        else { const int r = row - NPROMPT; o = ovs + ((size_t)(r >> 3) * 128 + 120 + (r & 7)) * 256 + c; }
                        if (o) { *(f32x4*)o = v0; *(f32x4*)(o + 4) = v1; } }
                } else {
                    float s1 = 0.f, s2 = 0.f;
#pragma unroll
                    for (int bj = 0; bj < 2; ++bj) { f32x4 v0 = acc[ai][bj][m][0] * rsc, v1 = acc[ai][bj][m][1] * rsc;
#pragma unroll
                        for (int e = 0; e < 4; ++e) { v0[e] = gelu_tanh(v0[e]); v1[e] = gelu_tanh(v1[e]); s1 += v0[e] + v1[e]; s2 += v0[e] * v0[e] + v1[e] * v1[e]; }
                        const int c = bj * HALF + wc * 32 + 8 * fq;
                        if (pn < 10) *(u32x4*)(ZU + (size_t)row * 1024 + (pn - 6) * BM + c) = pack8(v0, v1);
                        else *(u32x4*)(ZV + (size_t)row * 1024 + (pn - 10) * BM + c) = pack8(v0, v1); }
                    if (pn >= 10) { s1 += __shfl_xor(s1, 16); s1 += __shfl_xor(s1, 32); s2 += __shfl_xor(s2, 16); s2 += __shfl_xor(s2, 32);
                        if (fq == 0) { atomicAdd(zvstat + 2 * row, (unsigned long long)(long long)__float2ll_rn(s1 * 16777216.0f)); atomicAdd(zvstat + 2 * row + 1, (unsigned long long)(long long)__float2ll_rn(s2 * 16777216.0f)); } }
                }
                if (m & 1) asm volatile("" ::: "memory");
            }
    }
};
struct EpiRetIn {
    static constexpr bool PERM = true, AFTER_DRAIN = false;
    bf16_t* Z; const float* rs;
    __device__ __forceinline__ void operator()(const f32x4 (&acc)[2][2][4][2], const Unit& u, int wr, int wc, int fr, int fq) const {
        const int pn = u.pn;
        float rsv[2][4];
#pragma unroll
        for (int ai = 0; ai < 2; ++ai)
#pragma unroll
            for (int m = 0; m < 4; ++m) rsv[ai][m] = rs[u.pm * BM + ai * HALF + wr * 64 + m * 16 + fr];
#pragma unroll
        for (int ai = 0; ai < 2; ++ai)
#pragma unroll
            for (int m = 0; m < 4; ++m) {
                const int row = u.pm * BM + ai * HALF + wr * 64 + m * 16 + fr;
                bf16_t* rowp = Z + (size_t)row * 12288 + pn * BM + wc * 32 + 8 * fq;
                if (pn < 16) {
                    const float pos = pos_of_row(row); const int ib = wc * 32 + 8 * fq;
                    f32x4 cs[4];
#pragma unroll
                    for (int t = 0; t < 4; ++t) { float s0, c0, s1, c1; sincos_turns(pos * rope_inv_turns(ib + 2 * t, 0.10381025f), s0, c0); sincos_turns(pos * rope_inv_turns(ib + 2 * t + 1, 0.10381025f), s1, c1); cs[t] = (f32x4){c0, s0, c1, s1}; }
                    const float sc = ((pn >= 8) ? 0.0625f : 1.0f) * rsv[ai][m];
                    f32x4 a0 = acc[ai][0][m][0], a1 = acc[ai][0][m][1], b0 = acc[ai][1][m][0], b1 = acc[ai][1][m][1], r0, r1, q0, q1;
                    r0[0] = a0[0] * cs[0][0] - b0[0] * cs[0][1]; q0[0] = b0[0] * cs[0][0] + a0[0] * cs[0][1];
                    r0[1] = a0[1] * cs[0][2] - b0[1] * cs[0][3]; q0[1] = b0[1] * cs[0][2] + a0[1] * cs[0][3];
                    r0[2] = a0[2] * cs[1][0] - b0[2] * cs[1][1]; q0[2] = b0[2] * cs[1][0] + a0[2] * cs[1][1];
                    r0[3] = a0[3] * cs[1][2] - b0[3] * cs[1][3]; q0[3] = b0[3] * cs[1][2] + a0[3] * cs[1][3];
                    r1[0] = a1[0] * cs[2][0] - b1[0] * cs[2][1]; q1[0] = b1[0] * cs[2][0] + a1[0] * cs[2][1];
                    r1[1] = a1[1] * cs[2][2] - b1[1] * cs[2][3]; q1[1] = b1[1] * cs[2][2] + a1[1] * cs[2][3];
                    r1[2] = a1[2] * cs[3][0] - b1[2] * cs[3][1]; q1[2] = b1[2] * cs[3][0] + a1[2] * cs[3][1];
                    r1[3] = a1[3] * cs[3][2] - b1[3] * cs[3][3]; q1[3] = b1[3] * cs[3][2] + a1[3] * cs[3][3];
                    *(u32x4*)(rowp) = pack8(r0 * sc, r1 * sc); *(u32x4*)(rowp + HALF) = pack8(q0 * sc, q1 * sc);
                } else {
                    const float rsc = rsv[ai][m];
#pragma unroll
                    for (int bj = 0; bj < 2; ++bj) { f32x4 v0 = acc[ai][bj][m][0] * rsc, v1 = acc[ai][bj][m][1] * rsc;
                        if (pn >= 32) {
#pragma unroll
                            for (int e = 0; e < 4; ++e) { v0[e] = silu_f(v0[e]); v1[e] = silu_f(v1[e]); } }
                        *(u32x4*)(rowp + bj * HALF) = pack8(v0, v1); }
                }
                if (m == 3) asm volatile("" ::: "memory");
            }
    }
};
struct MemKVOrder {
    int G, c;
    __device__ bool next(int i, Unit& u) const { const int idx = i * G + c; if (idx >= 16) return false; u.pm = idx >> 2; u.pn = (u.pm >> 1) * 4 + (idx & 3); u.kt0 = 0; u.nkt = 32; return true; }
};
struct EpiMemKV {
    static constexpr bool PERM = false, AFTER_DRAIN = false;
    float* ok; float* ov; bf16_t* KV;
    __device__ __forceinline__ void operator()(const f32x4 (&acc)[2][2][4][2], const Unit& u, int wr, int wc, int fr, int fq) const {
        const int layer = u.pm >> 1, pn = u.pn & 3;
        const int col0 = pn * BM + wc * 32 + 4 * fq;
        float* o = ((pn < 2) ? ok : ov) + (size_t)layer * 512 * 512; const int cb = (pn < 2) ? col0 : col0 - 512;
        bf16_t* kv = KV + (size_t)layer * 512 * 1024;
#pragma unroll
        for (int ai = 0; ai < 2; ++ai)
#pragma unroll
            for (int m = 0; m < 4; ++m) { const int row = (u.pm & 1) * BM + ai * HALF + wr * 64 + m * 16 + fr;
#pragma unroll
                for (int bj = 0; bj < 2; ++bj)
#pragma unroll
                    for (int n = 0; n < 2; ++n) { const f32x4 v = acc[ai][bj][m][n]; const int c = bj * HALF + n * 16;
                        *(f32x4*)(o + (size_t)row * 512 + cb + c) = v;
                        u32x2 w; w.x = cvt_pk_bf16(v[0], v[1]); w.y = cvt_pk_bf16(v[2], v[3]); *(u32x2*)(kv + (size_t)row * 1024 + col0 + c) = w; }
                asm volatile("" ::: "memory"); }
    }
};

template <class Epi, class Sched, bool ALIGN_EPI = false, bool SP2 = false>
__device__ __forceinline__ void gemm_phase(PG8_LAS unsigned char* lds, const Gemm g, const Sched& S, const Epi& E) {
    int tid_ = threadIdx.x; asm volatile("" : "+v"(tid_));
    const int tid = tid_, wid = __builtin_amdgcn_readfirstlane(tid >> 6), lane = tid & 63, wr = wid >> 2, wc = wid & 3, fr = lane & 15, fq = lane >> 4;
    const int K = g.K, lda = g.lda ? g.lda : K, ldb = g.ldb ? g.ldb : K; int nt; (void)K;
    unsigned voffA[2], voffB[2];
#pragma unroll
    for (int i = 0; i < 2; ++i) { int R, C; stage_rc(tid * 16 + i * 8192, R, C); const int Rb = Epi::PERM ? ((R & ~31) + perm32(R & 31)) : R;
        voffA[i] = (unsigned)(R * lda + C) * 2u; voffB[i] = (unsigned)(Rb * ldb + C) * 2u; }
    const size_t kstep = (size_t)(BK * 2);
    const size_t hstepA = (size_t)HALF * lda * 2, hstepB = (size_t)HALF * ldb * 2;
    const size_t tstepA = 2 * hstepA, tstepB = 2 * hstepB;
    const unsigned ldsw = (unsigned)wid * 1024u;
    const int aoff = lds_byte(wr * 64 + fr, fq * 8), boff = lds_byte(wc * 32 + fr, fq * 8);
#define PG8_SA(b, h) (((b) * 2 + (h)) * HTB)
#define PG8_SB(b, h) ((4 + (b) * 2 + (h)) * HTB)
#define PG8_STAGE(bufoff, gbase, voff) do { _Pragma("unroll") for (int _i = 0; _i < 2; ++_i) \
        __builtin_amdgcn_global_load_lds((const unsigned*)((const char*)(gbase) + (voff)[_i]), (PG8_LAS unsigned*)(lds + (bufoff) + ldsw + _i * 8192), 16, 0, 0); } while (0)
#define PG8_LDA(dst, b, h) do { _Pragma("unroll") for (int m = 0; m < 4; ++m) _Pragma("unroll") for (int k = 0; k < 2; ++k) dst[m][k] = *(const PG8_LAS bf16x8*)(lds + PG8_SA(b, h) + aoff + m * 2048 + k * 1024); } while (0)
#define PG8_LDB(dst, b, h) do { _Pragma("unroll") for (int n = 0; n < 2; ++n) _Pragma("unroll") for (int k = 0; k < 2; ++k) dst[n][k] = *(const PG8_LAS bf16x8*)(lds + PG8_SB(b, h) + boff + n * 2048 + k * 1024); } while (0)
#define PG8_MMA(ai, bj, At, Bt) do { __builtin_amdgcn_s_setprio(1); _Pragma("unroll") for (int m = 0; m < 4; ++m) _Pragma("unroll") for (int n = 0; n < 2; ++n) _Pragma("unroll") for (int k = 0; k < 2; ++k) \
        acc[ai][bj][m][n] = __builtin_amdgcn_mfma_f32_16x16x32_bf16(Bt[n][k], At[m][k], acc[ai][bj][m][n], 0, 0, 0); __builtin_amdgcn_s_setprio(0); } while (0)
#define PG8_WAIT_V(n) asm volatile("s_waitcnt vmcnt(" #n ")" ::: "memory")
#define PG8_WAIT_L(n) asm volatile("s_waitcnt lgkmcnt(" #n ")" ::: "memory")
#define PG8_BAR __builtin_amdgcn_s_barrier()
#define PG8_SCHED __builtin_amdgcn_sched_barrier(0)
    Unit cur, nxt; int ui = 0;
    if (!S.next(0, cur)) return;
    f32x4 acc[2][2][4][2];
#pragma unroll
    for (int a = 0; a < 2; ++a)
#pragma unroll
        for (int b = 0; b < 2; ++b)
#pragma unroll
            for (int m = 0; m < 4; ++m)
#pragma unroll
                for (int n = 0; n < 2; ++n) acc[a][b][m][n] = (f32x4){0.f, 0.f, 0.f, 0.f};
    bf16x8 At[4][2], B0[2][2], B1[2][2];
    const char* cA = (const char*)g.A + (size_t)cur.pm * tstepA + (size_t)cur.kt0 * kstep; const char* cB = (const char*)g.Bt + (size_t)cur.pn * tstepB + (size_t)cur.kt0 * kstep; nt = cur.nkt;
    if constexpr (SP2) {
        PG8_STAGE(PG8_SB(0, 0), cB, voffB); PG8_STAGE(PG8_SB(0, 1), cB + hstepB, voffB); PG8_STAGE(PG8_SA(0, 0), cA, voffA); PG8_STAGE(PG8_SA(0, 1), cA + hstepA, voffA);
        if (wr == 1) PG8_BAR;
        PG8_WAIT_V(2); PG8_BAR;
        PG8_STAGE(PG8_SB(1, 0), cB + kstep, voffB); PG8_STAGE(PG8_SA(1, 0), cA + kstep, voffA); PG8_STAGE(PG8_SB(1, 1), cB + hstepB + kstep, voffB);
        PG8_WAIT_V(6); PG8_BAR;
    } else {
        PG8_STAGE(PG8_SB(0, 0), cB, voffB); PG8_STAGE(PG8_SA(0, 0), cA, voffA); PG8_STAGE(PG8_SB(0, 1), cB + hstepB, voffB); PG8_STAGE(PG8_SA(0, 1), cA + hstepA, voffA);
        if (wr == 1) PG8_BAR;
        PG8_WAIT_V(4); PG8_BAR;
        PG8_STAGE(PG8_SB(1, 0), cB + kstep, voffB); PG8_STAGE(PG8_SA(1, 0), cA + kstep, voffA); PG8_STAGE(PG8_SB(1, 1), cB + hstepB + kstep, voffB);
        PG8_WAIT_V(6); PG8_BAR;
    }
    for (;;) {
        const bool has_next = S.next(ui + 1, nxt);
        const char* nA = has_next ? (const char*)g.A + (size_t)nxt.pm * tstepA + (size_t)nxt.kt0 * kstep : cA; const char* nB = has_next ? (const char*)g.Bt + (size_t)nxt.pn * tstepB + (size_t)nxt.kt0 * kstep : cB;
        for (int t = 0; t < nt; t += 2) {
            const bool last = (t == nt - 2);
            const char* a1 = cA + (size_t)(t + 1) * kstep;
            const char* a2 = last ? nA : cA + (size_t)(t + 2) * kstep; const char* b2 = last ? nB : cB + (size_t)(t + 2) * kstep;
            const char* a3 = a2 + kstep; const char* b3 = b2 + kstep;
            if constexpr (SP2) {
            PG8_LDB(B0, 0, 0); PG8_LDB(B1, 0, 1); PG8_SCHED; PG8_LDA(At, 0, 0); PG8_STAGE(PG8_SA(1, 1), a1 + hstepA, voffA);
            PG8_WAIT_V(8); PG8_WAIT_L(0); PG8_BAR; PG8_MMA(0, 0, At, B0); PG8_MMA(0, 1, At, B1); PG8_BAR; PG8_SCHED;
            PG8_LDA(At, 0, 1); PG8_STAGE(PG8_SB(0, 0), b2, voffB); PG8_STAGE(PG8_SB(0, 1), b2 + hstepB, voffB); PG8_STAGE(PG8_SA(0, 0), a2, voffA);
            PG8_WAIT_V(8); PG8_WAIT_L(0); PG8_BAR; PG8_MMA(1, 0, At, B0); PG8_MMA(1, 1, At, B1); PG8_BAR; PG8_SCHED;
            PG8_LDB(B0, 1, 0); PG8_LDB(B1, 1, 1); PG8_SCHED; PG8_LDA(At, 1, 0); PG8_STAGE(PG8_SA(0, 1), a2 + hstepA, voffA);
            PG8_WAIT_V(8); PG8_WAIT_L(0); PG8_BAR; PG8_MMA(0, 0, At, B0); PG8_MMA(0, 1, At, B1); PG8_BAR; PG8_SCHED;
            PG8_LDA(At, 1, 1); PG8_STAGE(PG8_SB(1, 0), b3, voffB); PG8_STAGE(PG8_SB(1, 1), b3 + hstepB, voffB); PG8_STAGE(PG8_SA(1, 0), a3, voffA);
            PG8_WAIT_V(8); PG8_WAIT_L(0); PG8_BAR; PG8_MMA(1, 0, At, B0); PG8_MMA(1, 1, At, B1); PG8_BAR; PG8_SCHED;
            } else {
            PG8_LDB(B0, 0, 0); PG8_SCHED; PG8_LDA(At, 0, 0); PG8_STAGE(PG8_SA(1, 1), a1 + hstepA, voffA);
            PG8_WAIT_L(8); PG8_BAR; PG8_WAIT_L(0); PG8_MMA(0, 0, At, B0); PG8_BAR; PG8_SCHED;
            PG8_LDB(B1, 0, 1); PG8_STAGE(PG8_SB(0, 0), b2, voffB);
            PG8_BAR; PG8_WAIT_L(0); PG8_MMA(0, 1, At, B1); PG8_BAR;
            PG8_LDA(At, 0, 1); PG8_STAGE(PG8_SA(0, 0), a2, voffA);
            PG8_BAR; PG8_WAIT_L(0); PG8_MMA(1, 0, At, B0); PG8_BAR; PG8_SCHED;
            PG8_STAGE(PG8_SB(0, 1), b2 + hstepB, voffB);
            PG8_WAIT_V(6); PG8_BAR; PG8_MMA(1, 1, At, B1); PG8_BAR;
            PG8_LDB(B0, 1, 0); PG8_SCHED; PG8_LDA(At, 1, 0); PG8_STAGE(PG8_SA(0, 1), a2 + hstepA, voffA);
            PG8_WAIT_L(8); PG8_BAR; PG8_WAIT_L(0); PG8_MMA(0, 0, At, B0); PG8_BAR; PG8_SCHED;
            PG8_LDB(B1, 1, 1); PG8_STAGE(PG8_SB(1, 0), b3, voffB);
            PG8_BAR; PG8_WAIT_L(0); PG8_MMA(0, 1, At, B1); PG8_BAR;
            PG8_LDA(At, 1, 1); PG8_STAGE(PG8_SA(1, 0), a3, voffA);
            PG8_BAR; PG8_WAIT_L(0); PG8_MMA(1, 0, At, B0); PG8_BAR; PG8_SCHED;
            PG8_STAGE(PG8_SB(1, 1), b3 + hstepB, voffB);
            PG8_WAIT_V(6); PG8_BAR; PG8_MMA(1, 1, At, B1); PG8_BAR;
            }
        }
        if constexpr (ALIGN_EPI) { if (wr == 0) PG8_BAR; }
        if constexpr (!Epi::AFTER_DRAIN) { E(acc, cur, wr, wc, fr, fq); }
        if (!has_next) break;
#pragma unroll
        for (int a = 0; a < 2; ++a)
#pragma unroll
            for (int b = 0; b < 2; ++b)
#pragma unroll
                for (int m = 0; m < 4; ++m)
#pragma unroll
                    for (int n = 0; n < 2; ++n) acc[a][b][m][n] = (f32x4){0.f, 0.f, 0.f, 0.f};
        cur = nxt; cA = nA; cB = nB; ++ui; nt = cur.nkt;
        if constexpr (ALIGN_EPI) { if (wr == 1) PG8_BAR; }
    }
    PG8_WAIT_V(0);
    if constexpr (!ALIGN_EPI) { if (wr == 0) PG8_BAR; }
    PG8_BAR;
    if constexpr (Epi::AFTER_DRAIN) { E.fused(acc, cur, wr, wc, fr, fq, lds, wid, lane); }
#undef PG8_SA
#undef PG8_SB
#undef PG8_STAGE
#undef PG8_LDA
#undef PG8_LDB
#undef PG8_MMA
#undef PG8_WAIT_V
#undef PG8_WAIT_L
#undef PG8_BAR
#undef PG8_SCHED
}
}

#define GAS __attribute__((address_space(1)))
#define LAS __attribute__((address_space(3)))
typedef unsigned short bf16;
typedef short bf16x8 __attribute__((ext_vector_type(8)));
typedef short s16x4 __attribute__((ext_vector_type(4)));
typedef float f32x4 __attribute__((ext_vector_type(4)));
typedef float f32x2 __attribute__((ext_vector_type(2)));
typedef unsigned u32x4 __attribute__((ext_vector_type(4)));
typedef unsigned u32x2 __attribute__((ext_vector_type(2)));
typedef GAS unsigned gu32;

constexpr int D = 2048, M = 9216, NP = 8192, SEQ = 4096, NS = 128, TS = 8, FF = 8192;
constexpr int AB_IN = 3584, RET_IN = 12288, MEMW = 512;
constexpr float EPS = 1e-6f;
constexpr int NWAVES = 8, NTHR = 512;

__device__ __forceinline__ float bf2f(unsigned short b) { return __uint_as_float((unsigned)b << 16); }
__device__ __forceinline__ unsigned f2bf(float f) { unsigned u = __float_as_uint(f); return (u + 0x7fffu + ((u >> 16) & 1u)) >> 16; }
__device__ __forceinline__ unsigned pk2(float lo, float hi) { return pg8::cvt_pk_bf16(lo, hi); }
__device__ __forceinline__ float wave_sum(float v) {
#pragma unroll
    for (int o = 1; o < 64; o <<= 1) v += __shfl_xor(v, o);
    return v;
}
__device__ __forceinline__ f32x4 mfma16(bf16x8 a, bf16x8 b, f32x4 c) { return __builtin_amdgcn_mfma_f32_16x16x32_bf16(a, b, c, 0, 0, 0); }
__device__ __forceinline__ bf16x8 frag_nat(const LAS bf16* base, int stride, int row0, int k0, int lane) {
    return *(const LAS bf16x8*)(base + (row0 + (lane & 15)) * stride + k0 + 8 * (lane >> 4));
}
__device__ __forceinline__ bf16x8 frag_nat_perm(const LAS bf16* base, int stride, int row0, int k0, int lane) {
    const LAS bf16* a = base + (row0 + (lane & 15)) * stride + k0 + 4 * (lane >> 4);
    const u32x2 lo = *(const LAS u32x2*)a, hi = *(const LAS u32x2*)(a + 16);
    return __builtin_bit_cast(bf16x8, (u32x4){lo.x, lo.y, hi.x, hi.y});
}
__device__ __forceinline__ s16x4 tr4(const LAS bf16* p) { return __builtin_amdgcn_ds_read_tr16_b64_v4i16((LAS s16x4*)p); }
__device__ __forceinline__ bf16x8 frag_tr(const LAS bf16* base, int stride, int k0, int r0, int lane) {
    const LAS bf16* a = base + (k0 + 8 * (lane >> 4) + ((lane & 15) >> 2)) * stride + r0 + 4 * (lane & 3);
    const s16x4 lo = tr4(a), hi = tr4(a + 4 * stride);
    return (bf16x8){lo[0], lo[1], lo[2], lo[3], hi[0], hi[1], hi[2], hi[3]};
}
__device__ __forceinline__ bf16x8 frag_tr_perm(const LAS bf16* base, int stride, int k0, int r0, int lane) {
    const LAS bf16* a = base + (k0 + 4 * (lane >> 4) + ((lane & 15) >> 2)) * stride + r0 + 4 * (lane & 3);
    const s16x4 lo = tr4(a), hi = tr4(a + 16 * stride);
    return (bf16x8){lo[0], lo[1], lo[2], lo[3], hi[0], hi[1], hi[2], hi[3]};
}
__device__ __forceinline__ bf16x8 pack_p(const f32x4& a, const f32x4& b) {
    u32x4 w; w.x = pk2(a[0], a[1]); w.y = pk2(a[2], a[3]); w.z = pk2(b[0], b[1]); w.w = pk2(b[2], b[3]);
    return __builtin_bit_cast(bf16x8, w);
}
#define WG_SYNC() do { asm volatile("s_waitcnt lgkmcnt(0)" ::: "memory"); __builtin_amdgcn_s_barrier(); asm volatile("" ::: "memory"); } while (0)

struct Frame {
    LAS unsigned char* lds;
    int tid, lane, wave, vcu, G;
};

struct f32x8 { f32x4 lo, hi; };
__device__ __forceinline__ f32x8 bf8_to_f32(const u32x4 r) { f32x8 o; o.lo = (f32x4){__uint_as_float(r.x << 16), __uint_as_float(r.x & 0xffff0000u), __uint_as_float(r.y << 16), __uint_as_float(r.y & 0xffff0000u)};
    o.hi = (f32x4){__uint_as_float(r.z << 16), __uint_as_float(r.z & 0xffff0000u), __uint_as_float(r.w << 16), __uint_as_float(r.w & 0xffff0000u)}; return o; }
__device__ __forceinline__ u32x4 f32_to_bf8(const f32x8& v) { u32x4 w; w.x = pk2(v.lo[0], v.lo[1]); w.y = pk2(v.lo[2], v.lo[3]); w.z = pk2(v.hi[0], v.hi[1]); w.w = pk2(v.hi[2], v.hi[3]); return w; }
__device__ __forceinline__ float sumsq8(const f32x8& v) { return ((v.lo[0] * v.lo[0] + v.lo[1] * v.lo[1]) + (v.lo[2] * v.lo[2] + v.lo[3] * v.lo[3])) + ((v.hi[0] * v.hi[0] + v.hi[1] * v.hi[1]) + (v.hi[2] * v.hi[2] + v.hi[3] * v.hi[3])); }
template <bool HAS_Y, int NR>
__device__ __forceinline__ void norm_rows(const Frame& F, const float* xin_p, const float* xin_s, const bf16* xin_b, const bf16* Y0, const bf16* P, int splits, const float* gpost, float* rs_out, float* xout, bf16* xout_b) {
    const int gw = F.vcu * NWAVES + F.wave, NGW = F.G * NWAVES, lane = F.lane;
    for (int base = gw; base < NP; base += NR * NGW) {
        u32x4 xr[NR][4], yr[NR][4]; f32x8 xf[NR][4];
#pragma unroll
        for (int r = 0; r < NR; ++r) { const int row = base + r * NGW, rw = row < NP ? row : base;
            if (xin_b) {
#pragma unroll
                for (int j = 0; j < 4; ++j) xr[r][j] = __builtin_nontemporal_load((const u32x4*)(xin_b + (size_t)rw * D) + lane + 64 * j);
            } else {
#pragma unroll
                for (int j = 0; j < 4; ++j) { xf[r][j].lo = __builtin_nontemporal_load((const f32x4*)(xin_p + (size_t)rw * D) + 2 * (lane + 64 * j)); xf[r][j].hi = __builtin_nontemporal_load((const f32x4*)(xin_p + (size_t)rw * D) + 2 * (lane + 64 * j) + 1); }
            }
            if (HAS_Y) {
#pragma unroll
                for (int j = 0; j < 4; ++j) yr[r][j] = __builtin_nontemporal_load((const u32x4*)(Y0 + (size_t)rw * D) + lane + 64 * j); } }
#pragma unroll
        for (int r = 0; r < NR; ++r) { const int row = base + r * NGW; const bool ok = row < NP;
            f32x8 x[4];
#pragma unroll
            for (int j = 0; j < 4; ++j) x[j] = xin_b ? bf8_to_f32(xr[r][j]) : xf[r][j];
            if (HAS_Y) {
                f32x8 y[4]; float ss = 0.f;
#pragma unroll
                for (int j = 0; j < 4; ++j) { y[j] = bf8_to_f32(yr[r][j]); ss += sumsq8(y[j]); }
                const float rs = 1.0f / sqrtf(wave_sum(ss) * (1.0f / D) + EPS);
#pragma unroll
                for (int j = 0; j < 4; ++j) { const f32x4 g0 = ((const f32x4*)gpost)[2 * (lane + 64 * j)], g1 = ((const f32x4*)gpost)[2 * (lane + 64 * j) + 1];
                    x[j].lo += y[j].lo * rs * g0; x[j].hi += y[j].hi * rs * g1;
                    if (xout && ok) { __builtin_nontemporal_store(x[j].lo, (f32x4*)(xout + (size_t)row * D) + 2 * (lane + 64 * j)); __builtin_nontemporal_store(x[j].hi, (f32x4*)(xout + (size_t)row * D) + 2 * (lane + 64 * j) + 1); } }
            }
            if (xout_b) {
#pragma unroll
                for (int j = 0; j < 4; ++j) { const u32x4 w = f32_to_bf8(x[j]); if (ok) ((u32x4*)(xout_b + (size_t)row * D))[lane + 64 * j] = w; x[j] = bf8_to_f32(w); } }
            if (rs_out) { float ss = 0.f;
#pragma unroll
                for (int j = 0; j < 4; ++j) ss += sumsq8(x[j]);
                const float rs = 1.0f / sqrtf(wave_sum(ss) * (1.0f / D) + EPS);
                if (lane == 0 && ok) rs_out[row] = rs; }
        }
    }
    for (int row = NP + gw; row < M; row += NGW) {
        f32x8 x[4];
        if (xin_b) {
#pragma unroll
            for (int j = 0; j < 4; ++j) x[j] = bf8_to_f32(__builtin_nontemporal_load((const u32x4*)(xin_b + (size_t)row * D) + lane + 64 * j));
        } else {
#pragma unroll
            for (int j = 0; j < 4; ++j) { x[j].lo = __builtin_nontemporal_load((const f32x4*)(xin_s + (size_t)(row - NP) * D) + 2 * (lane + 64 * j)); x[j].hi = __builtin_nontemporal_load((const f32x4*)(xin_s + (size_t)(row - NP) * D) + 2 * (lane + 64 * j) + 1); }
        }
        if (HAS_Y) {
            f32x8 y[4];
#pragma unroll
            for (int j = 0; j < 4; ++j) { y[j].lo = (f32x4){0.f, 0.f, 0.f, 0.f}; y[j].hi = y[j].lo; }
            if (splits == 8) {
#pragma unroll
                for (int s = 0; s < 8; ++s)
#pragma unroll
                    for (int j = 0; j < 4; ++j) { const f32x8 v = bf8_to_f32(__builtin_nontemporal_load((const u32x4*)(P + ((size_t)s * 1024 + (row - NP)) * D) + lane + 64 * j)); y[j].lo += v.lo; y[j].hi += v.hi; }
            } else {
                for (int s = 0; s < splits; ++s)
#pragma unroll
                    for (int j = 0; j < 4; ++j) { const f32x8 v = bf8_to_f32(__builtin_nontemporal_load((const u32x4*)(P + ((size_t)s * 1024 + (row - NP)) * D) + lane + 64 * j)); y[j].lo += v.lo; y[j].hi += v.hi; }
            }
            float ss = 0.f;
#pragma unroll
            for (int j = 0; j < 4; ++j) ss += sumsq8(y[j]);
            const float rs = 1.0f / sqrtf(wave_sum(ss) * (1.0f / D) + EPS);
#pragma unroll
            for (int j = 0; j < 4; ++j) { const f32x4 g0 = ((const f32x4*)gpost)[2 * (lane + 64 * j)], g1 = ((const f32x4*)gpost)[2 * (lane + 64 * j) + 1];
                x[j].lo += y[j].lo * rs * g0; x[j].hi += y[j].hi * rs * g1;
                if (xout) { __builtin_nontemporal_store(x[j].lo, (f32x4*)(xout + (size_t)row * D) + 2 * (lane + 64 * j)); __builtin_nontemporal_store(x[j].hi, (f32x4*)(xout + (size_t)row * D) + 2 * (lane + 64 * j) + 1); } }
        }
        if (xout_b) {
#pragma unroll
            for (int j = 0; j < 4; ++j) { const u32x4 w = f32_to_bf8(x[j]); ((u32x4*)(xout_b + (size_t)row * D))[lane + 64 * j] = w; x[j] = bf8_to_f32(w); } }
        if (rs_out) { float ss = 0.f;
#pragma unroll
            for (int j = 0; j < 4; ++j) ss += sumsq8(x[j]);
            const float rs = 1.0f / sqrtf(wave_sum(ss) * (1.0f / D) + EPS);
            if (lane == 0) rs_out[row] = rs; }
    }
}

__device__ __forceinline__ void norm_finish_row(f32x8 (&x)[4], const f32x8 (&y)[4], int row, int lane, const float* gpost, float* rs_out, float* xout, bf16* xout_b) {
    float ss = 0.f;
#pragma unroll
    for (int j = 0; j < 4; ++j) ss += sumsq8(y[j]);
    const float rs = 1.0f / sqrtf(wave_sum(ss) * (1.0f / D) + EPS);
#pragma unroll
    for (int j = 0; j < 4; ++j) { const f32x4 g0 = ((const f32x4*)gpost)[2 * (lane + 64 * j)], g1 = ((const f32x4*)gpost)[2 * (lane + 64 * j) + 1];
        x[j].lo += y[j].lo * rs * g0; x[j].hi += y[j].hi * rs * g1;
        if (xout) { __builtin_nontemporal_store(x[j].lo, (f32x4*)(xout + (size_t)row * D) + 2 * (lane + 64 * j)); __builtin_nontemporal_store(x[j].hi, (f32x4*)(xout + (size_t)row * D) + 2 * (lane + 64 * j) + 1); }
        if (xout_b) { const u32x4 w = f32_to_bf8(x[j]); ((u32x4*)(xout_b + (size_t)row * D))[lane + 64 * j] = w; x[j] = bf8_to_f32(w); } }
    if (rs_out) { float s2 = 0.f;
#pragma unroll
        for (int j = 0; j < 4; ++j) s2 += sumsq8(x[j]);
        const float r2 = 1.0f / sqrtf(wave_sum(s2) * (1.0f / D) + EPS);
        if (lane == 0) rs_out[row] = r2; }
}
template <bool EARLY>
__device__ __forceinline__ void norm_rows_pipe(const Frame& F, const bf16* xin_b, const bf16* Y0, const bf16* P, int splits, const float* gpost, float* rs_out, float* xout, bf16* xout_b) {
    const int gw = F.vcu * NWAVES + F.wave, NGW = F.G * NWAVES, lane = F.lane, hf = F.wave & 1;
    LAS float* xs = (LAS float*)F.lds;
    int sb = F.vcu * 4;
    u32x4 sx[2], sp[8][2];
#define NS_LOAD_A() do { const int srow_ = sb + (F.wave >> 1); const size_t so_ = (size_t)(srow_ < 1024 ? srow_ : 0) * D; \
        _Pragma("unroll") for (int j = 0; j < 2; ++j) sx[j] = __builtin_nontemporal_load((const u32x4*)(xin_b + (size_t)NP * D + so_) + lane + 64 * (2 * hf + j)); \
        _Pragma("unroll") for (int s = 0; s < 4; ++s) _Pragma("unroll") for (int j = 0; j < 2; ++j) sp[s][j] = __builtin_nontemporal_load((const u32x4*)(P + (size_t)s * 1024 * D + so_) + lane + 64 * (2 * hf + j)); } while (0)
#define NS_LOAD_B() do { const int srow_ = sb + (F.wave >> 1); const size_t so_ = (size_t)(srow_ < 1024 ? srow_ : 0) * D; \
        _Pragma("unroll") for (int s = 4; s < 8; ++s) _Pragma("unroll") for (int j = 0; j < 2; ++j) sp[s][j] = (splits == 8) ? __builtin_nontemporal_load((const u32x4*)(P + (size_t)s * 1024 * D + so_) + lane + 64 * (2 * hf + j)) : (u32x4){0u, 0u, 0u, 0u}; } while (0)
#define NS_FINISH() do { NS_LOAD_B(); const int srow_ = sb + (F.wave >> 1); const bool ok_ = srow_ < 1024; const size_t ro_ = ((size_t)NP + (ok_ ? srow_ : 0)) * D; \
        f32x8 x[2], y[2]; float ss = 0.f; \
        _Pragma("unroll") for (int j = 0; j < 2; ++j) { x[j] = bf8_to_f32(sx[j]); y[j] = bf8_to_f32(sp[0][j]); \
            _Pragma("unroll") for (int s = 1; s < 8; ++s) { const f32x8 v = bf8_to_f32(sp[s][j]); y[j].lo += v.lo; y[j].hi += v.hi; } ss += sumsq8(y[j]); } \
        ss = wave_sum(ss); if (lane == 0) xs[F.wave] = ss; WG_SYNC(); \
        const float rs = 1.0f / sqrtf((xs[F.wave] + xs[F.wave ^ 1]) * (1.0f / D) + EPS); float s2 = 0.f; \
        _Pragma("unroll") for (int j = 0; j < 2; ++j) { const int pc = lane + 64 * (2 * hf + j); const f32x4 g0 = ((const f32x4*)gpost)[2 * pc], g1 = ((const f32x4*)gpost)[2 * pc + 1]; \
            x[j].lo += y[j].lo * rs * g0; x[j].hi += y[j].hi * rs * g1; \
            if (xout && ok_) { __builtin_nontemporal_store(x[j].lo, (f32x4*)(xout + ro_) + 2 * pc); __builtin_nontemporal_store(x[j].hi, (f32x4*)(xout + ro_) + 2 * pc + 1); } \
            if (xout_b) { const u32x4 w = f32_to_bf8(x[j]); if (ok_) ((u32x4*)(xout_b + ro_))[pc] = w; x[j] = bf8_to_f32(w); } s2 += sumsq8(x[j]); } \
        s2 = wave_sum(s2); if (lane == 0) xs[8 + F.wave] = s2; WG_SYNC(); \
        if (rs_out && lane == 0 && hf == 0 && ok_) rs_out[NP + srow_] = 1.0f / sqrtf((xs[8 + F.wave] + xs[8 + (F.wave ^ 1)]) * (1.0f / D) + EPS); \
        WG_SYNC(); sb += F.G * 4; } while (0)
    for (int base = gw * 4; base < NP; base += 4 * NGW) {
        u32x4 xr[4][4], yr[4][4];
#pragma unroll
        for (int r = 0; r < 4; ++r) { const int row = base + r, rw = row < NP ? row : base;
#pragma unroll
            for (int j = 0; j < 4; ++j) { xr[r][j] = __builtin_nontemporal_load((const u32x4*)(xin_b + (size_t)rw * D) + lane + 64 * j); yr[r][j] = __builtin_nontemporal_load((const u32x4*)(Y0 + (size_t)rw * D) + lane + 64 * j); } }
#pragma unroll
        for (int r = 0; r < 2; ++r) { const int row = base + r; if (row < NP) { f32x8 x[4], y[4];
#pragma unroll
            for (int j = 0; j < 4; ++j) { x[j] = bf8_to_f32(xr[r][j]); y[j] = bf8_to_f32(yr[r][j]); }
            norm_finish_row(x, y, row, lane, gpost, rs_out, xout, xout_b); } }
        const bool last = (base + 4 * NGW >= NP) && (sb < 1024);
        if (EARLY && last) NS_LOAD_A();
#pragma unroll
        for (int r = 2; r < 4; ++r) { const int row = base + r; if (row < NP) { f32x8 x[4], y[4];
#pragma unroll
            for (int j = 0; j < 4; ++j) { x[j] = bf8_to_f32(xr[r][j]); y[j] = bf8_to_f32(yr[r][j]); }
            norm_finish_row(x, y, row, lane, gpost, rs_out, xout, xout_b); } }
        if (EARLY && last && 4 * NGW >= NP) NS_FINISH();
        else if (EARLY && last) {   }
    }
    for (; sb < 1024; sb += 0) { NS_LOAD_A(); NS_FINISH(); }
#undef NS_LOAD_A
#undef NS_LOAD_B
#undef NS_FINISH
}

__device__ __forceinline__ void transpose_item(const float* W, int K, int N, bf16* WT, LAS float* scr, int item, int lane, const float* gain = nullptr, int ldw = 0) {
    const int nblk = N / 64, kb = item / nblk, nb = item % nblk, k0 = 64 * kb, n0 = 64 * nb;
    f32x4 v[16];
#pragma unroll
    for (int i = 0; i < 16; ++i) v[i] = __builtin_nontemporal_load((const f32x4*)(W + (size_t)(k0 + 4 * i + (lane >> 4)) * N + n0 + 4 * (lane & 15)));
#pragma unroll
    for (int i = 0; i < 16; ++i) { LAS float* s = scr + (4 * i + (lane >> 4)) * 65 + 4 * (lane & 15); const float gk = gain ? gain[k0 + 4 * i + (lane >> 4)] : 1.0f; s[0] = v[i][0] * gk; s[1] = v[i][1] * gk; s[2] = v[i][2] * gk; s[3] = v[i][3] * gk; }
    asm volatile("s_waitcnt lgkmcnt(0)" ::: "memory");
    const int c = lane & 7;
#pragma unroll
    for (int j = 0; j < 8; ++j) { const int n = (lane >> 3) + 8 * j; const LAS float* s = scr + (8 * c) * 65 + n;
        u32x4 o; o.x = pk2(s[0 * 65], s[1 * 65]); o.y = pk2(s[2 * 65], s[3 * 65]); o.z = pk2(s[4 * 65], s[5 * 65]); o.w = pk2(s[6 * 65], s[7 * 65]);
        *(u32x4*)(WT + (size_t)(n0 + n) * (ldw ? ldw : K) + k0 + 8 * c) = o; }
    asm volatile("s_waitcnt lgkmcnt(0)" ::: "memory");
}
__device__ __forceinline__ void transpose_strided(const float* W, int K, int N, bf16* WT, LAS float* scr, int it0, int stride, int nit, int lane, const float* gain = nullptr, int ldw = 0) {
    const int nblk = N / 64, ldo = ldw ? ldw : K;
#define TR_LOAD(v, item) do { const int kb_ = (item) / nblk, nb_ = (item) - kb_ * nblk; _Pragma("unroll") for (int i = 0; i < 16; ++i) v[i] = __builtin_nontemporal_load((const f32x4*)(W + (size_t)(64 * kb_ + 4 * i + (lane >> 4)) * N + 64 * nb_ + 4 * (lane & 15))); } while (0)
#define TR_STORE(v, item) do { const int kb_ = (item) / nblk, nb_ = (item) - kb_ * nblk, k0 = 64 * kb_, n0 = 64 * nb_; \
        _Pragma("unroll") for (int i = 0; i < 16; ++i) { LAS float* s = scr + (4 * i + (lane >> 4)) * 65 + 4 * (lane & 15); const float gk = gain ? gain[k0 + 4 * i + (lane >> 4)] : 1.0f; s[0] = v[i][0] * gk; s[1] = v[i][1] * gk; s[2] = v[i][2] * gk; s[3] = v[i][3] * gk; } \
        asm volatile("s_waitcnt lgkmcnt(0)" ::: "memory"); \
        _Pragma("unroll") for (int j = 0; j < 8; ++j) { const int n = (lane >> 3) + 8 * j, c = lane & 7; const LAS float* s = scr + (8 * c) * 65 + n; \
            u32x4 o; o.x = pk2(s[0 * 65], s[1 * 65]); o.y = pk2(s[2 * 65], s[3 * 65]); o.z = pk2(s[4 * 65], s[5 * 65]); o.w = pk2(s[6 * 65], s[7 * 65]); \
            *(u32x4*)(WT + (size_t)(n0 + n) * ldo + k0 + 8 * c) = o; } \
        asm volatile("s_waitcnt lgkmcnt(0)" ::: "memory"); } while (0)
    int it = it0; if (it >= nit) return;
    f32x4 va[16], vb[16];
    TR_LOAD(va, it);
    for (;;) {
        int itn = it + stride; bool hn = itn < nit;
        if (hn) TR_LOAD(vb, itn);
        TR_STORE(va, it);
        if (!hn) break;
        it = itn; itn = it + stride; hn = itn < nit;
        if (hn) TR_LOAD(va, itn);
        TR_STORE(vb, it);
        if (!hn) break;
        it = itn;
    }
#undef TR_LOAD
#undef TR_STORE
}
struct WJob { const float* W; bf16* WT; int K, N; };
constexpr float LOG2E = 1.4426950408889634f;
__device__ __forceinline__ void swa_prompt_unit(const Frame& F, int b, int c, int kh, const bf16* Q, const bf16* K, const bf16* V, const float* sinks, bf16* CAT) {
    LAS bf16* Ks = (LAS bf16*)F.lds; LAS bf16* Vs = Ks + 256 * 72;
    const int lane = F.lane, kg = lane >> 4, w = F.wave;
    const int rowbase = b * SEQ + (c - 1) * 128;
#pragma unroll
    for (int i = 0; i < 4; ++i) { const int idx = F.tid + NTHR * i, r = idx >> 3, ch = idx & 7;
        u32x4 kv = (u32x4){0u, 0u, 0u, 0u}, vv = kv;
        if (c > 0 || r >= 128) { kv = *(const u32x4*)(K + (size_t)(rowbase + r) * 256 + kh * 64 + ch * 8); vv = *(const u32x4*)(V + (size_t)(rowbase + r) * 256 + kh * 64 + ch * 8); }
        *(LAS u32x4*)(Ks + r * 72 + ch * 8) = kv; *(LAS u32x4*)(Vs + r * 72 + ch * 8) = vv; }
    WG_SYNC();
    const int hq = kh * 4 + (w >> 1);
    const float sink2 = sinks[hq] * LOG2E;
    for (int mb = 0; mb < 4; ++mb) {
        const int i0 = (w & 1) * 64 + mb * 16, qrow = b * SEQ + c * 128 + i0 + (lane & 15), tb = 2 * (i0 >> 5), tq = i0 + (lane & 15);
        bf16x8 bq[2];
#pragma unroll
        for (int ks = 0; ks < 2; ++ks) bq[ks] = *(const bf16x8*)(Q + (size_t)qrow * 1024 + hq * 64 + ks * 32 + 8 * kg);
        f32x4 st[10]; float mx = -1e30f;
#pragma unroll
        for (int t = 0; t < 10; ++t) { f32x4 a = (f32x4){0.f, 0.f, 0.f, 0.f};
#pragma unroll
            for (int ks = 0; ks < 2; ++ks) a = mfma16(frag_nat(Ks, 72, (tb + t) * 16, ks * 32, lane), bq[ks], a);
#pragma unroll
            for (int r = 0; r < 4; ++r) { const int j = (tb + t) * 16 + 4 * kg + r; const bool ok = (j > tq) && (j <= tq + 128) && (c > 0 || j >= 128);
                a[r] = ok ? a[r] * (0.125f * LOG2E) : -1e30f; mx = fmaxf(mx, a[r]); }
            st[t] = a; }
        mx = fmaxf(mx, __shfl_xor(mx, 16)); mx = fmaxf(mx, __shfl_xor(mx, 32)); mx = fmaxf(mx, sink2);
        float sum = 0.f;
#pragma unroll
        for (int t = 0; t < 10; ++t)
#pragma unroll
            for (int r = 0; r < 4; ++r) { const float p = __builtin_amdgcn_exp2f(st[t][r] - mx); st[t][r] = p; sum += p; }
        sum += __shfl_xor(sum, 16); sum += __shfl_xor(sum, 32);
        const float inv = 1.0f / (sum + __builtin_amdgcn_exp2f(sink2 - mx));
        f32x4 o[4];
#pragma unroll
        for (int dt = 0; dt < 4; ++dt) o[dt] = (f32x4){0.f, 0.f, 0.f, 0.f};
#pragma unroll
        for (int s = 0; s < 5; ++s) { const bf16x8 pb = pack_p(st[2 * s], st[2 * s + 1]);
#pragma unroll
            for (int dt = 0; dt < 4; ++dt) o[dt] = mfma16(frag_tr_perm(Vs, 72, (tb + 2 * s) * 16, dt * 16, lane), pb, o[dt]); }
#pragma unroll
        for (int dt = 0; dt < 4; ++dt) { u32x2 wv; wv.x = pk2(o[dt][0] * inv, o[dt][1] * inv); wv.y = pk2(o[dt][2] * inv, o[dt][3] * inv);
            *(u32x2*)(CAT + (size_t)qrow * 2048 + hq * 64 + dt * 16 + 4 * kg) = wv; }
    }
    WG_SYNC();
}
__device__ __forceinline__ void gate_prompt_unit(const Frame& F, int b, int c, int g, const bf16* ZU, const bf16* ZV, const long long* zvstat, const float* lng, const float* lnb, const float* w_s, const float* b_s, bf16* CAT) {
    LAS bf16* Ws = (LAS bf16*)F.lds; LAS bf16* Zs = Ws + 128 * 136;
    const int lane = F.lane, kg = lane >> 4, w = F.wave;
#pragma unroll
    for (int i = 0; i < 8; ++i) { const int idx = F.tid + NTHR * i, r = idx >> 5, j4 = (idx & 31) * 4;
        f32x4 v = *(const f32x4*)(w_s + ((size_t)g * 128 + r) * 128 + j4);
#pragma unroll
        for (int e = 0; e < 4; ++e) if (j4 + e > r) v[e] = 0.f;
        u32x2 wv; wv.x = pk2(v[0], v[1]); wv.y = pk2(v[2], v[3]); *(LAS u32x2*)(Ws + r * 136 + j4) = wv; }
#pragma unroll
    for (int i = 0; i < 8; ++i) { const int idx = F.tid + NTHR * i, r = idx >> 5, ch = idx & 31, col = g * 256 + ch * 8, row = b * SEQ + c * 128 + r;
        const u32x4 raw = *(const u32x4*)(ZV + (size_t)row * 1024 + col);
        const float mean = (float)zvstat[2 * row] * (1.0f / (1024.0f * 16777216.0f)), var = (float)zvstat[2 * row + 1] * (1.0f / (1024.0f * 16777216.0f)) - mean * mean, rstd = 1.0f / sqrtf(fmaxf(var, 0.f) + EPS);
        const f32x4 g0 = *(const f32x4*)(lng + col), g1 = *(const f32x4*)(lng + col + 4), b0 = *(const f32x4*)(lnb + col), b1 = *(const f32x4*)(lnb + col + 4);
        float z[8];
#pragma unroll
        for (int e = 0; e < 4; ++e) { z[2 * e] = __uint_as_float(raw[e] << 16); z[2 * e + 1] = __uint_as_float(raw[e] & 0xffff0000u); }
        u32x4 o;
        o.x = pk2((z[0] - mean) * rstd * g0[0] + b0[0], (z[1] - mean) * rstd * g0[1] + b0[1]); o.y = pk2((z[2] - mean) * rstd * g0[2] + b0[2], (z[3] - mean) * rstd * g0[3] + b0[3]);
        o.z = pk2((z[4] - mean) * rstd * g1[0] + b1[0], (z[5] - mean) * rstd * g1[1] + b1[1]); o.w = pk2((z[6] - mean) * rstd * g1[2] + b1[2], (z[7] - mean) * rstd * g1[3] + b1[3]);
        *(LAS u32x4*)(Zs + r * 264 + ch * 8) = o; }
    WG_SYNC();
    const int i0 = 16 * w, nst = (w >> 1) + 1;
    f32x4 acc[16];
#pragma unroll
    for (int dt = 0; dt < 16; ++dt) acc[dt] = (f32x4){0.f, 0.f, 0.f, 0.f};
    for (int s = 0; s < nst; ++s) { const bf16x8 bw = frag_nat(Ws, 136, i0, 32 * s, lane);
#pragma unroll
        for (int dt = 0; dt < 16; ++dt) acc[dt] = mfma16(frag_tr(Zs, 264, 32 * s, dt * 16, lane), bw, acc[dt]); }
    const int row = b * SEQ + c * 128 + i0 + (lane & 15); const float bs = b_s[g * 128 + i0 + (lane & 15)];
#pragma unroll
    for (int dt = 0; dt < 16; ++dt) { const int col = g * 256 + dt * 16 + 4 * kg; const u32x2 zu = *(const u32x2*)(ZU + (size_t)row * 1024 + col);
        u32x2 wv; wv.x = pk2(__uint_as_float(zu.x << 16) * (acc[dt][0] + bs), __uint_as_float(zu.x & 0xffff0000u) * (acc[dt][1] + bs));
        wv.y = pk2(__uint_as_float(zu.y << 16) * (acc[dt][2] + bs), __uint_as_float(zu.y & 0xffff0000u) * (acc[dt][3] + bs));
        *(u32x2*)(CAT + (size_t)row * 2048 + 1024 + col) = wv; }
    WG_SYNC();
}
__device__ __forceinline__ void gate_sample_unit(const Frame& F, int n, int half, const bf16* ZU, const bf16* ZV, const long long* zvstat, const float* lng, const float* lnb, const float* w_s, const float* b_s, bf16* CAT, float* ogv) {
#pragma unroll
    for (int cc = half; cc < half + 1; ++cc) { const int col = F.tid + NTHR * cc, g = col >> 8; const float lg = lng[col], lb = lnb[col];
        float z[8];
#pragma unroll
        for (int j = 0; j < 8; ++j) { const int row = NP + n * 8 + j;
            const float mean = (float)zvstat[2 * row] * (1.0f / (1024.0f * 16777216.0f)), var = (float)zvstat[2 * row + 1] * (1.0f / (1024.0f * 16777216.0f)) - mean * mean, rstd = 1.0f / sqrtf(fmaxf(var, 0.f) + EPS);
            z[j] = (bf2f(ZV[(size_t)row * 1024 + col]) - mean) * rstd * lg + lb; ogv[(size_t)(n * 8 + j) * 1024 + col] = z[j]; }
#pragma unroll
        for (int i = 0; i < 8; ++i) { float mixed = b_s[g * 128 + i];
#pragma unroll
            for (int j = 0; j <= i; ++j) mixed += w_s[((size_t)g * 128 + i) * 128 + j] * z[j];
            const int row = NP + n * 8 + i; CAT[(size_t)row * 2048 + 1024 + col] = (bf16)f2bf(bf2f(ZU[(size_t)row * 1024 + col]) * mixed); } }
}
__device__ __forceinline__ void swa_sample_unit(const Frame& F, int n, int khp, const bf16* Q, const bf16* K, const bf16* V, const float* ck, const float* cv, const float* sinks, bf16* CAT, float* oks, float* ovs) {
    LAS bf16* Ks = (LAS bf16*)F.lds; LAS bf16* Vs = Ks + 2 * 144 * 72;
    const int lane = F.lane, kg = lane >> 4, w = F.wave;
#pragma unroll
    for (int i = 0; i < 8; ++i) { const int idx = F.tid + NTHR * i, j = idx >> 5, f4 = idx & 31, khl = f4 >> 4, d = (f4 & 15) * 4;
        const size_t off = (((size_t)n * 128 + j) * 4 + 2 * khp) * 64 + f4 * 4;
        const f32x4 kv = *(const f32x4*)(ck + off), vv = *(const f32x4*)(cv + off);
        u32x2 a; a.x = pk2(kv[0], kv[1]); a.y = pk2(kv[2], kv[3]); *(LAS u32x2*)(Ks + (khl * 144 + j) * 72 + d) = a;
        u32x2 c2; c2.x = pk2(vv[0], vv[1]); c2.y = pk2(vv[2], vv[3]); *(LAS u32x2*)(Vs + (khl * 160 + j) * 72 + d) = c2;
        if (j >= 8) { const size_t oo = (((size_t)n * 128 + j - 8) * 4 + 2 * khp) * 64 + f4 * 4; *(f32x4*)(oks + oo) = kv; *(f32x4*)(ovs + oo) = vv; } }
    if (F.tid < 128) { const int t = F.tid >> 4, khl = (F.tid >> 3) & 1, ch = F.tid & 7; const size_t off = (size_t)(NP + n * 8 + t) * 256 + (2 * khp + khl) * 64 + ch * 8;
        *(LAS u32x4*)(Ks + (khl * 144 + 128 + t) * 72 + ch * 8) = *(const u32x4*)(K + off); *(LAS u32x4*)(Vs + (khl * 160 + 128 + t) * 72 + ch * 8) = *(const u32x4*)(V + off); }
    else if (F.tid < 128 + 64 * 2) { const int x = F.tid - 128, khl = x >> 6, r = 136 + ((x & 63) >> 3), ch = x & 7; *(LAS u32x4*)(Ks + (khl * 144 + r) * 72 + ch * 8) = (u32x4){0u, 0u, 0u, 0u}; }
    for (int x = F.tid; x < 2 * 24 * 8; x += NTHR) { const int khl = x / 192, r = 136 + ((x % 192) >> 3), ch = x & 7; *(LAS u32x4*)(Vs + (khl * 160 + r) * 72 + ch * 8) = (u32x4){0u, 0u, 0u, 0u}; }
    WG_SYNC();
    if (w < 4) {
        const int khl = w >> 1, kh = 2 * khp + khl, t = lane & 7, head = kh * 4 + 2 * (w & 1) + ((lane & 15) >> 3), qrow = NP + n * 8 + t;
        const LAS bf16* Kh = Ks + khl * 144 * 72; const LAS bf16* Vh = Vs + khl * 160 * 72;
        const float sink2 = sinks[head] * LOG2E;
        bf16x8 bq[2];
#pragma unroll
        for (int ks = 0; ks < 2; ++ks) bq[ks] = *(const bf16x8*)(Q + (size_t)qrow * 1024 + head * 64 + ks * 32 + 8 * kg);
        f32x4 st[10]; float mx = -1e30f;
#pragma unroll
        for (int tt = 0; tt < 9; ++tt) { f32x4 a = (f32x4){0.f, 0.f, 0.f, 0.f};
#pragma unroll
            for (int ks = 0; ks < 2; ++ks) a = mfma16(frag_nat(Kh, 72, tt * 16, ks * 32, lane), bq[ks], a);
#pragma unroll
            for (int r = 0; r < 4; ++r) { const int j = tt * 16 + 4 * kg + r; const bool ok = (j > t) && (j <= t + 128);
                a[r] = ok ? a[r] * (0.125f * LOG2E) : -1e30f; mx = fmaxf(mx, a[r]); }
            st[tt] = a; }
        st[9] = (f32x4){-1e30f, -1e30f, -1e30f, -1e30f};
        mx = fmaxf(mx, __shfl_xor(mx, 16)); mx = fmaxf(mx, __shfl_xor(mx, 32)); mx = fmaxf(mx, sink2);
        float sum = 0.f;
#pragma unroll
        for (int tt = 0; tt < 10; ++tt)
#pragma unroll
            for (int r = 0; r < 4; ++r) { const float p = __builtin_amdgcn_exp2f(st[tt][r] - mx); st[tt][r] = p; sum += p; }
        sum += __shfl_xor(sum, 16); sum += __shfl_xor(sum, 32);
        const float inv = 1.0f / (sum + __builtin_amdgcn_exp2f(sink2 - mx));
        f32x4 o[4];
#pragma unroll
        for (int dt = 0; dt < 4; ++dt) o[dt] = (f32x4){0.f, 0.f, 0.f, 0.f};
#pragma unroll
        for (int s = 0; s < 5; ++s) { const bf16x8 pb = pack_p(st[2 * s], st[2 * s + 1]);
#pragma unroll
            for (int dt = 0; dt < 4; ++dt) o[dt] = mfma16(frag_tr_perm(Vh, 72, 32 * s, dt * 16, lane), pb, o[dt]); }
#pragma unroll
        for (int dt = 0; dt < 4; ++dt) { u32x2 wv; wv.x = pk2(o[dt][0] * inv, o[dt][1] * inv); wv.y = pk2(o[dt][2] * inv, o[dt][3] * inv);
            *(u32x2*)(CAT + (size_t)qrow * 2048 + head * 64 + dt * 16 + 4 * kg) = wv; }
    }
    WG_SYNC();
}

constexpr size_t QSEG = (size_t)132 * 1024 * 1024 / 2;
__device__ __forceinline__ bf16x8 ldq2(const bf16* p) {
    const u32x4 a = *(const u32x4*)p, b = *(const u32x4*)(p + QSEG); u32x4 o;
#pragma unroll
    for (int e = 0; e < 4; ++e) o[e] = pk2(__uint_as_float(a[e] << 16) + __uint_as_float(b[e] << 16), __uint_as_float(a[e] & 0xffff0000u) + __uint_as_float(b[e] & 0xffff0000u));
    return __builtin_bit_cast(bf16x8, o);
}
__device__ __forceinline__ void mem_attn_wave(const LAS bf16* Ks, const LAS bf16* Vs, const bf16* qptr  , bf16* optr, bool store, int lane) {
    const int kg = lane >> 4;
    bf16x8 bq[4];
#pragma unroll
    for (int ks = 0; ks < 4; ++ks) bq[ks] = ldq2(qptr + ks * 32 + 8 * kg);
    f32x4 st[16]; float mx = -1e30f;
#pragma unroll
    for (int t = 0; t < 16; ++t) { f32x4 a = (f32x4){0.f, 0.f, 0.f, 0.f};
#pragma unroll
        for (int ks = 0; ks < 4; ++ks) a = mfma16(frag_nat(Ks, 136, t * 16, ks * 32, lane), bq[ks], a);
#pragma unroll
        for (int r = 0; r < 4; ++r) { a[r] *= (0.08838834764831845f * LOG2E); mx = fmaxf(mx, a[r]); }
        st[t] = a; }
    mx = fmaxf(mx, __shfl_xor(mx, 16)); mx = fmaxf(mx, __shfl_xor(mx, 32));
    float sum = 0.f;
#pragma unroll
    for (int t = 0; t < 16; ++t)
#pragma unroll
        for (int r = 0; r < 4; ++r) { const float p = __builtin_amdgcn_exp2f(st[t][r] - mx); st[t][r] = p; sum += p; }
    sum += __shfl_xor(sum, 16); sum += __shfl_xor(sum, 32);
    const float inv = 1.0f / sum;
    f32x4 o[8];
#pragma unroll
    for (int dt = 0; dt < 8; ++dt) o[dt] = (f32x4){0.f, 0.f, 0.f, 0.f};
#pragma unroll
    for (int s = 0; s < 8; ++s) { const bf16x8 pb = pack_p(st[2 * s], st[2 * s + 1]);
#pragma unroll
        for (int dt = 0; dt < 8; ++dt) o[dt] = mfma16(frag_tr_perm(Vs, 136, 32 * s, dt * 16, lane), pb, o[dt]); }
    if (store) {
#pragma unroll
        for (int dt = 0; dt < 8; ++dt) { u32x2 wv; wv.x = pk2(o[dt][0] * inv, o[dt][1] * inv); wv.y = pk2(o[dt][2] * inv, o[dt][3] * inv); *(u32x2*)(optr + dt * 16 + 4 * kg) = wv; } }
}
__device__ __forceinline__ void mem_prompt_unit(const Frame& F, int b, int h, int qb, const bf16* QM, const bf16* KV, bf16* OM) {
    LAS bf16* Ks = (LAS bf16*)F.lds; LAS bf16* Vs = Ks + 256 * 136;
#pragma unroll
    for (int i = 0; i < 8; ++i) { const int idx = F.tid + NTHR * i, r = idx >> 4, ch = idx & 15; const size_t off = (size_t)(b * 256 + r) * 1024 + h * 128 + ch * 8;
        *(LAS u32x4*)(Ks + r * 136 + ch * 8) = *(const u32x4*)(KV + off); *(LAS u32x4*)(Vs + r * 136 + ch * 8) = *(const u32x4*)(KV + off + 512); }
    WG_SYNC();
    const size_t row = (size_t)b * SEQ + qb * 128 + F.wave * 16 + (F.lane & 15);
    mem_attn_wave(Ks, Vs, QM + row * 512 + h * 128, OM + row * 512 + h * 128, true, F.lane);
    WG_SYNC();
}
__device__ __forceinline__ void mem_sample_units(const Frame& F, int u0, int ustride, const bf16* QM, const float* ck, const float* cv, bf16* OM) {
    LAS bf16* Ks = (LAS bf16*)F.lds; LAS bf16* Vs = Ks + 256 * 136; LAS bf16* Pb = Vs + 256 * 136; LAS float* smax = (LAS float*)(Pb + 8 * 264); LAS float* ssum = smax + 64;
    const int lane = F.lane, kg = lane >> 4, w = F.wave, q = lane & 7;
    f32x4 kv[16], vv[16];
#define MS_LOAD(u_) do { const int n_ = (u_) >> 2, h_ = (u_) & 3; _Pragma("unroll") for (int i = 0; i < 16; ++i) { const int idx = F.tid + NTHR * i, r = idx >> 5, f4 = idx & 31; const size_t off = (((size_t)n_ * 256 + r) * 4 + h_) * 128 + f4 * 4; \
            kv[i] = __builtin_nontemporal_load((const f32x4*)(ck + off)); vv[i] = __builtin_nontemporal_load((const f32x4*)(cv + off)); } } while (0)
    if (u0 < 512) MS_LOAD(u0);
    for (int u = u0; u < 512; u += ustride) {
        const int n = u >> 2, h = u & 3;
#pragma unroll
        for (int i = 0; i < 16; ++i) { const int idx = F.tid + NTHR * i, r = idx >> 5, f4 = idx & 31;
            u32x2 a; a.x = pk2(kv[i][0], kv[i][1]); a.y = pk2(kv[i][2], kv[i][3]); *(LAS u32x2*)(Ks + r * 136 + f4 * 4) = a;
            u32x2 c2; c2.x = pk2(vv[i][0], vv[i][1]); c2.y = pk2(vv[i][2], vv[i][3]); *(LAS u32x2*)(Vs + r * 136 + f4 * 4) = c2; }
        if (u + ustride < 512) MS_LOAD(u + ustride);
        const size_t row = (size_t)NP + n * 8 + q;
        bf16x8 bq[4];
#pragma unroll
        for (int ks = 0; ks < 4; ++ks) bq[ks] = ldq2(QM + row * 512 + h * 128 + ks * 32 + 8 * kg);
        WG_SYNC();
        f32x4 st[2]; float mx = -1e30f;
#pragma unroll
        for (int t = 0; t < 2; ++t) { f32x4 a = (f32x4){0.f, 0.f, 0.f, 0.f};
#pragma unroll
            for (int ks = 0; ks < 4; ++ks) a = mfma16(frag_nat(Ks, 136, (2 * w + t) * 16, ks * 32, lane), bq[ks], a);
#pragma unroll
            for (int r = 0; r < 4; ++r) { a[r] *= (0.08838834764831845f * LOG2E); mx = fmaxf(mx, a[r]); }
            st[t] = a; }
        mx = fmaxf(mx, __shfl_xor(mx, 16)); mx = fmaxf(mx, __shfl_xor(mx, 32));
        if (lane < 8) smax[w * 8 + lane] = mx;
        WG_SYNC();
        float gm = smax[q];
#pragma unroll
        for (int ww = 1; ww < 8; ++ww) gm = fmaxf(gm, smax[ww * 8 + q]);
        float sum = 0.f;
#pragma unroll
        for (int t = 0; t < 2; ++t)
#pragma unroll
            for (int r = 0; r < 4; ++r) { const float p = __builtin_amdgcn_exp2f(st[t][r] - gm); sum += p; if ((lane & 15) < 8) Pb[q * 264 + (2 * w + t) * 16 + 4 * kg + r] = (bf16)f2bf(p); }
        sum += __shfl_xor(sum, 16); sum += __shfl_xor(sum, 32);
        if (lane < 8) ssum[w * 8 + lane] = sum;
        WG_SYNC();
        float tot = ssum[q];
#pragma unroll
        for (int ww = 1; ww < 8; ++ww) tot += ssum[ww * 8 + q];
        f32x4 o = (f32x4){0.f, 0.f, 0.f, 0.f};
#pragma unroll
        for (int s2 = 0; s2 < 8; ++s2) o = mfma16(frag_tr(Vs, 136, 32 * s2, w * 16, lane), *(const LAS bf16x8*)(Pb + q * 264 + 32 * s2 + 8 * kg), o);
        if ((lane & 15) < 8) { const float inv = 1.0f / tot; u32x2 wv; wv.x = pk2(o[0] * inv, o[1] * inv); wv.y = pk2(o[2] * inv, o[3] * inv); *(u32x2*)(OM + row * 512 + h * 128 + w * 16 + 4 * kg) = wv; }
        WG_SYNC();
    }
#undef MS_LOAD
}
constexpr int ES = 64, NE = ES / 16;
__device__ __forceinline__ float ret_lg2(int h) { return log2f(1.0f - exp2f(-5.0f - (float)h)); }
__device__ __forceinline__ void ret_prompt_scan(const Frame& F, int b, int h, int es, const bf16* ZR, bf16* OR, unsigned long long* SS, float* ostate) {
    constexpr int VST = ES + 8, NV = ES / 32;
    LAS bf16* Ks = (LAS bf16*)F.lds; LAS bf16* Vs = Ks + 128 * 264; LAS bf16* Vd = Vs + 128 * VST; LAS bf16* Ss = Vd + 128 * VST;
    constexpr int SST = 264;
    const int lane = F.lane, kg = lane >> 4, w = F.wave, tid = F.tid;
    const int it = (w < 4) ? w : 11 - w;
    const float lg2 = ret_lg2(h);
    const int e0 = es * ES;
    bf16x8 qf[8]; u32x4 kpre[8], vpre[NV];
    const size_t rb = (size_t)b * SEQ;
#define RET_LOAD_KV(c_, tid) do { \
        const unsigned kl_off = (unsigned)(((tid) >> 5) * RET_IN + ((tid) & 31) * 8) * 2u; \
        const char* kb_ = (const char*)(ZR + (rb + (size_t)(c_) * 128) * RET_IN + 2048 + h * 256); \
        _Pragma("unroll") for (int i = 0; i < 8; ++i) kpre[i] = *(const u32x4*)(kb_ + (size_t)i * (16 * RET_IN * 2) + kl_off); \
        _Pragma("unroll") for (int i = 0; i < NV; ++i) { const int idx = tid + NTHR * i, r = idx / (ES / 8), ch = idx % (ES / 8); vpre[i] = *(const u32x4*)(ZR + (rb + (c_) * 128 + r) * RET_IN + 4096 + h * 512 + e0 + ch * 8); } } while (0)
#define RET_LOAD_Q(c_, lane) do { const unsigned q_off = (unsigned)((16 * it + ((lane) & 15)) * RET_IN + 8 * ((lane) >> 4)) * 2u; const char* qb_ = (const char*)(ZR + (rb + (size_t)(c_) * 128) * RET_IN + h * 256); \
        _Pragma("unroll") for (int ks = 0; ks < 8; ++ks) qf[ks] = *(const bf16x8*)(qb_ + ks * 64 + q_off); } while (0)
#define RET_STORE_KV(tid) do { \
        const unsigned kl_lds = (unsigned)(((tid) >> 5) * 264 + ((tid) & 31) * 8) * 2u; \
        _Pragma("unroll") for (int i = 0; i < 8; ++i) *(LAS u32x4*)((LAS char*)Ks + kl_lds + i * (16 * 264 * 2)) = kpre[i]; \
        _Pragma("unroll") for (int i = 0; i < NV; ++i) { const int idx = tid + NTHR * i, r = idx / (ES / 8), ch = idx % (ES / 8); *(LAS u32x4*)(Vs + r * VST + ch * 8) = vpre[i]; \
          const float dk = __builtin_amdgcn_exp2f(lg2 * (float)(127 - r)); u32x4 o; \
          _Pragma("unroll") for (int e = 0; e < 4; ++e) o[e] = pk2(__uint_as_float(vpre[i][e] << 16) * dk, __uint_as_float(vpre[i][e] & 0xffff0000u) * dk); \
          *(LAS u32x4*)(Vd + r * VST + ch * 8) = o; } } while (0)
    for (int x = tid; x < ES * SST / 8; x += NTHR) *(LAS u32x4*)(Ss + x * 8) = (u32x4){0u, 0u, 0u, 0u};
    f32x4 sacc[2][NE];
#pragma unroll
    for (int a = 0; a < 2; ++a)
#pragma unroll
        for (int e = 0; e < NE; ++e) sacc[a][e] = (f32x4){0.f, 0.f, 0.f, 0.f};
    const float g128 = __builtin_amdgcn_exp2f(lg2 * 128.0f);
    RET_LOAD_KV(0, tid); RET_LOAD_Q(0, lane); RET_STORE_KV(tid);
    WG_SYNC();
    f32x4 oi[NE];
#pragma unroll
    for (int e = 0; e < NE; ++e) oi[e] = (f32x4){0.f, 0.f, 0.f, 0.f};
    for (int c = 0; c < 32; ++c) {
        int ln = lane, tc = tid; asm volatile("" : "+v"(ln), "+v"(tc));
        const int kg = ln >> 4, iq = 16 * it + (ln & 15);
        const float giq = __builtin_amdgcn_exp2f(lg2 * (float)iq);
        float gkr[4];
#pragma unroll
        for (int r = 0; r < 4; ++r) gkr[r] = __builtin_amdgcn_exp2f(lg2 * (float)(-(4 * kg + r)));
        if (c + 1 < 32) RET_LOAD_KV(c + 1, tc);
#pragma unroll
        for (int s = 0; s < 4; ++s) if (2 * s <= it) { asm volatile("" ::: "memory");
            f32x4 a2[2];
#pragma unroll
            for (int hh = 0; hh < 2; ++hh) { const int jt = 2 * s + hh; f32x4 a = (f32x4){0.f, 0.f, 0.f, 0.f};
                if (jt <= it) {
#pragma unroll
                    for (int ks = 0; ks < 8; ++ks) a = mfma16(frag_nat(Ks, 264, jt * 16, ks * 32, ln), qf[ks], a);
                    const float gj = giq * __builtin_amdgcn_exp2f(lg2 * (float)(-16 * jt));
#pragma unroll
                    for (int r = 0; r < 4; ++r) a[r] *= gj * gkr[r];
                    if (jt == it) {
#pragma unroll
                        for (int r = 0; r < 4; ++r) if (4 * kg + r > (ln & 15)) a[r] = 0.f; } }
                a2[hh] = a; }
            const bf16x8 pb = pack_p(a2[0], a2[1]);
#pragma unroll
            for (int e = 0; e < NE; ++e) oi[e] = mfma16(frag_tr_perm(Vs, VST, 32 * s, e * 16, ln), pb, oi[e]); }
        if (c + 1 < 32) RET_LOAD_Q(c + 1, ln);
        const size_t orow = rb + c * 128 + iq; float ssq = 0.f;
#pragma unroll
        for (int e = 0; e < NE; ++e) { const f32x4 o = oi[e]; ssq += (o[0] * o[0] + o[1] * o[1]) + (o[2] * o[2] + o[3] * o[3]);
            u32x2 wv; wv.x = pk2(o[0], o[1]); wv.y = pk2(o[2], o[3]); *(u32x2*)(OR + orow * 4096 + h * 512 + e0 + e * 16 + 4 * kg) = wv; }
        ssq += __shfl_xor(ssq, 16); ssq += __shfl_xor(ssq, 32);
        if (kg == 0) atomicAdd(SS + orow * 8 + h, (unsigned long long)__float2ll_rn(ssq * 16777216.0f));
#pragma unroll
        for (int a = 0; a < 2; ++a)
#pragma unroll
            for (int e = 0; e < NE; ++e) sacc[a][e] *= g128;
#pragma unroll
        for (int s = 0; s < 4; ++s) { asm volatile("" ::: "memory");
            bf16x8 vf[NE];
#pragma unroll
            for (int e = 0; e < NE; ++e) vf[e] = frag_tr(Vd, VST, 32 * s, e * 16, ln);
#pragma unroll
            for (int a = 0; a < 2; ++a) { const bf16x8 kf = frag_tr(Ks, 264, 32 * s, (2 * w + a) * 16, ln);
#pragma unroll
                for (int e = 0; e < NE; ++e) sacc[a][e] = mfma16(kf, vf[e], sacc[a][e]); } }
#pragma unroll
        for (int a = 0; a < 2; ++a)
#pragma unroll
            for (int e = 0; e < NE; ++e)
                { u32x2 wv; wv.x = pk2(sacc[a][e][0], sacc[a][e][1]); wv.y = pk2(sacc[a][e][2], sacc[a][e][3]);
                  *(LAS u32x2*)(Ss + (e * 16 + (ln & 15)) * SST + (2 * w + a) * 16 + 4 * kg) = wv; }
        WG_SYNC();
        if (c + 1 < 32) {
            RET_STORE_KV(tc);
#pragma unroll
            for (int e = 0; e < NE; ++e) oi[e] = (f32x4){0.f, 0.f, 0.f, 0.f};
#pragma unroll
            for (int ks = 0; ks < 8; ++ks) { if ((ks & 1) == 0) asm volatile("" ::: "memory");
#pragma unroll
                for (int e = 0; e < NE; ++e) oi[e] = mfma16(frag_nat(Ss, SST, e * 16, 32 * ks, ln), qf[ks], oi[e]); }
            { const float qd = __builtin_amdgcn_exp2f(lg2 * (float)(iq + 1));
#pragma unroll
              for (int e = 0; e < NE; ++e) oi[e] *= qd; }
        }
        WG_SYNC();
    }
#undef RET_LOAD_KV
#undef RET_LOAD_Q
#undef RET_STORE_KV
#pragma unroll
    for (int a = 0; a < 2; ++a)
#pragma unroll
        for (int e = 0; e < NE; ++e)
#pragma unroll
            for (int r = 0; r < 4; ++r) ostate[(((size_t)b * 8 + h) * 256 + (2 * w + a) * 16 + 4 * kg + r) * 512 + e0 + e * 16 + (lane & 15)] = sacc[a][e][r];
}
__device__ __forceinline__ void ret_sample_pass(const Frame& F, int unit0, const bf16* ZR, const float* state, float* ostate, bf16* OR, unsigned long long* SS) {
    const int grp = F.wave >> 2, dq = (F.wave >> 1) & 1, t = (F.wave & 1) * 64 + F.lane, t256 = dq * 128 + t, unit = unit0 + grp, n = unit >> 3, h = unit & 7;
    LAS float* qk = (LAS float*)F.lds + grp * (256 * 16 + 64 + 8 * 128 * 4); LAS float* sc = qk + 256 * 16; LAS f32x4* red = (LAS f32x4*)(sc + 64);
    const float lg2 = ret_lg2(h);
    const size_t r0 = (size_t)NP + n * 8;
#pragma unroll 4
    for (int x = t256; x < 8 * 256; x += 256) { const int i = x >> 8, d = x & 255;
        qk[d * 16 + i] = bf2f(ZR[(r0 + i) * RET_IN + h * 256 + d]);
        qk[d * 16 + 8 + i] = bf2f(ZR[(r0 + i) * RET_IN + 2048 + h * 256 + d]) * __builtin_amdgcn_exp2f(lg2 * (float)(7 - i)); }
    float v[8][4];
#pragma unroll
    for (int j = 0; j < 8; ++j) { const u32x2 raw = *(const u32x2*)(ZR + (r0 + j) * RET_IN + 4096 + h * 512 + 4 * t);
        v[j][0] = __uint_as_float(raw.x << 16); v[j][1] = __uint_as_float(raw.x & 0xffff0000u); v[j][2] = __uint_as_float(raw.y << 16); v[j][3] = __uint_as_float(raw.y & 0xffff0000u); }
    WG_SYNC();
    const float g8 = __builtin_amdgcn_exp2f(lg2 * 8.0f);
    const __amdgpu_buffer_rsrc_t rs_in = __builtin_amdgcn_make_buffer_rsrc((void*)(state + ((size_t)n * 8 + h) * 256 * 512), 0, 256 * 2048, 0x00020000);
    const __amdgpu_buffer_rsrc_t rs_out = __builtin_amdgcn_make_buffer_rsrc((void*)(ostate + ((size_t)n * 8 + h) * 256 * 512), 0, 256 * 2048, 0x00020000);
    const int loff = t * 16, dbase = dq * 128;
    f32x4 acc[8];
#pragma unroll
    for (int i = 0; i < 8; ++i) acc[i] = (f32x4){0.f, 0.f, 0.f, 0.f};
    constexpr int RB = 4;
    f32x4 bufA[RB], bufB[RB];
#define RS_LD(buf, d0_) do { _Pragma("unroll") for (int u = 0; u < RB; ++u) buf[u] = __builtin_bit_cast(f32x4, __builtin_amdgcn_raw_buffer_load_b128(rs_in, loff, (dbase + (d0_) + u) * 2048, 2)); } while (0)
#define RS_CP(buf, d0_) do { _Pragma("unroll") for (int u = 0; u < RB; ++u) { __builtin_amdgcn_sched_barrier(0); const LAS f32x4* qp = (const LAS f32x4*)(qk + (dbase + (d0_) + u) * 16); const f32x4 q0 = qp[0], q1 = qp[1], k0 = qp[2], k1 = qp[3]; \
            const f32x4 sv = buf[u]; f32x4 s1 = sv * g8; \
            _Pragma("unroll") for (int e = 0; e < 4; ++e) { \
                s1[e] += k0[0] * v[0][e] + k0[1] * v[1][e] + k0[2] * v[2][e] + k0[3] * v[3][e] + k1[0] * v[4][e] + k1[1] * v[5][e] + k1[2] * v[6][e] + k1[3] * v[7][e]; \
                acc[0][e] += q0[0] * sv[e]; acc[1][e] += q0[1] * sv[e]; acc[2][e] += q0[2] * sv[e]; acc[3][e] += q0[3] * sv[e]; \
                acc[4][e] += q1[0] * sv[e]; acc[5][e] += q1[1] * sv[e]; acc[6][e] += q1[2] * sv[e]; acc[7][e] += q1[3] * sv[e]; } \
            __builtin_amdgcn_raw_buffer_store_b128(__builtin_bit_cast(u32x4, s1), rs_out, loff, (dbase + (d0_) + u) * 2048, 2); } } while (0)
    RS_LD(bufA, 0);
#pragma unroll 1
    for (int d0 = 0; d0 < 128; d0 += 2 * RB) {
        RS_LD(bufB, d0 + RB);
        RS_CP(bufA, d0);
        if (d0 + 2 * RB < 128) RS_LD(bufA, d0 + 2 * RB);
        RS_CP(bufB, d0 + RB);
    }
#undef RS_LD
#undef RS_CP
    { int t3 = t256; asm volatile("" : "+v"(t3)); const int pr = t3 >> 2, i = pr >> 3, j = pr & 7, qd = t3 & 3; float s = 0.f;
      for (int d = qd * 64; d < qd * 64 + 64; ++d) s += qk[d * 16 + i] * qk[d * 16 + 8 + j];
      s += __shfl_xor(s, 1); s += __shfl_xor(s, 2);
      if (qd == 0) sc[i * 8 + j] = (j <= i) ? s * __builtin_amdgcn_exp2f(lg2 * (float)((i - j) - (7 - j))) : 0.f; }
    int t2 = t; asm volatile("" : "+v"(t2));
    if (dq == 1) {
#pragma unroll
        for (int i = 0; i < 8; ++i) red[i * 128 + t2] = acc[i]; }
    WG_SYNC();
    if (dq == 0) {
#pragma unroll
        for (int i = 0; i < 8; ++i) { f32x4 o = (acc[i] + red[i * 128 + t2]) * __builtin_amdgcn_exp2f(lg2 * (float)(i + 1));
#pragma unroll
            for (int j = 0; j <= i; ++j) { const float s = sc[i * 8 + j];
#pragma unroll
                for (int e = 0; e < 4; ++e) o[e] += s * v[j][e]; }
            u32x2 wv; wv.x = pk2(o[0], o[1]); wv.y = pk2(o[2], o[3]); *(u32x2*)(OR + (r0 + i) * 4096 + h * 512 + 4 * t2) = wv;
            float ssq = (o[0] * o[0] + o[1] * o[1]) + (o[2] * o[2] + o[3] * o[3]); ssq = wave_sum(ssq);
            if ((t2 & 63) == 0) atomicAdd(SS + (r0 + i) * 8 + h, (unsigned long long)__float2ll_rn(ssq * 16777216.0f)); } }
    WG_SYNC();
}
template <int NR>
__device__ __forceinline__ void ret_norm_rows(const Frame& F, const bf16* OR, const bf16* ZR, const unsigned long long* SS, bf16* YG) {
    const int gw = F.vcu * NWAVES + F.wave, NGW = F.G * NWAVES, lane = F.lane;
    for (int base = gw; base < 2 * M; base += NR * NGW) {
        u32x4 o[NR][4], g[NR][4];
#pragma unroll
        for (int r = 0; r < NR; ++r) { const int it = base + r * NGW, iw = it < 2 * M ? it : base, row = iw >> 1, c0 = (iw & 1) * 2048;
#pragma unroll
            for (int j = 0; j < 4; ++j) { const int col = c0 + (lane + 64 * j) * 8; o[r][j] = __builtin_nontemporal_load((const u32x4*)(OR + (size_t)row * 4096 + col)); g[r][j] = __builtin_nontemporal_load((const u32x4*)(ZR + (size_t)row * RET_IN + 8192 + col)); } }
#pragma unroll
        for (int r = 0; r < NR; ++r) { const int it = base + r * NGW; if (it >= 2 * M) break; const int row = it >> 1, c0 = (it & 1) * 2048;
#pragma unroll
            for (int j = 0; j < 4; ++j) { const int col = c0 + (lane + 64 * j) * 8, h = col >> 9; const float rs = 1.0f / sqrtf((float)SS[(size_t)row * 8 + h] * (1.0f / (512.0f * 16777216.0f)) + EPS); u32x4 y;
#pragma unroll
                for (int e = 0; e < 4; ++e) y[e] = pk2(__uint_as_float(o[r][j][e] << 16) * rs * __uint_as_float(g[r][j][e] << 16), __uint_as_float(o[r][j][e] & 0xffff0000u) * rs * __uint_as_float(g[r][j][e] & 0xffff0000u));
                *(u32x4*)(YG + (size_t)row * 4096 + col) = y; } }
    }
}
constexpr size_t MiB = 1u << 20;
constexpr size_t WS_CTL = 0, CTL_ZERO_BYTES = 32 * 1024;
constexpr size_t CTL_QUEUE = 1024, CTL_TQ = 2048, CTL_ZVSTAT = 256 * 1024, CTL_SS = 512 * 1024, CTL_BAR = 8 * 1024;
constexpr size_t WS_ROPE_A = 2 * MiB, WS_ROPE_R = 3 * MiB;
constexpr size_t WS_WT = 8 * MiB;
constexpr size_t WT_ABIN = WS_WT, WT_ABOUT = WT_ABIN + 14 * MiB, WT_RETIN = WT_ABOUT + 8 * MiB, WT_RETOUT = WT_RETIN + 48 * MiB, WT_MEMQ = WT_RETOUT + 16 * MiB,
                 WT_MEMKV = WT_MEMQ + 4 * MiB, WT_MEMO = WT_MEMKV + 8 * MiB, WT_UP = WT_MEMO + 4 * MiB, WT_DOWN = WT_UP + 64 * MiB, WT_END = WT_DOWN + 64 * MiB;
constexpr size_t WS_H = 240 * MiB, WS_Y0 = 276 * MiB, WS_Y1 = 348 * MiB, WS_BIG = 420 * MiB, WS_CAT = 636 * MiB, WS_OR = 708 * MiB, WS_QM = 780 * MiB, WS_OM = 789 * MiB, WS_HM = 798 * MiB, WS_MKV = 802 * MiB, WS_XB = 804 * MiB, WS_RS = 840 * MiB, WS_WTD = 842 * MiB, WS_QM2 = 912 * MiB, WS_END = 922 * MiB;
static_assert((WS_QM2 - WS_QM) / 2 == QSEG, "q partial distance");
static_assert(WT_END <= WS_H, "weights fit");
constexpr size_t BIG_Q = 0, BIG_K = 18 * MiB, BIG_V = BIG_K + 9216 * 256 * 2, BIG_ZU = 27 * MiB, BIG_ZV = 45 * MiB;
constexpr size_t O_X = 0, O_SKP = 18874368, O_SVP = 18939904, O_SKS = 19005440, O_SVS = 23199744, O_GV = 27394048, O_RP = 28442624, O_RS = 30539776, O_MK = 164757504, O_MV = 165281792, O_END = 165806080;
constexpr int LDFF = FF + 64;
constexpr int LDS_BYTES = 147456, MISC_OFF = LDS_BYTES - 512;

#define XB_TMO      128
#define XB_XCNT(j)  (256  + 64 * (j))
#define XB_XSUB(j)  (1280 + 64 * (j))
#define XB_XGEN(j)  (2304 + 64 * (j))
#define XB_TOP      3328
#define XB_TOPGEN   3392
#define XCD_BAR_WORDS 3456
#define XB_SPIN_CAP (1u << 18)

__device__ __forceinline__ unsigned xb_ld(unsigned* p)              { return __hip_atomic_load(p, __ATOMIC_RELAXED, __HIP_MEMORY_SCOPE_AGENT); }
__device__ __forceinline__ unsigned xb_add(unsigned* p, unsigned v) { return __hip_atomic_fetch_add(p, v, __ATOMIC_RELAXED, __HIP_MEMORY_SCOPE_AGENT); }
__device__ __forceinline__ unsigned xb_xcc_id() { return (unsigned)__builtin_amdgcn_s_getreg((3 << 11) | 20) & 0xFu; }
#define XB_SPIN(cond, bar) do { unsigned _sp = 0; while (cond) { \
    if ((++_sp & 255u) == 0u) { if (xb_ld(&(bar)[XB_TMO])) break; if (_sp > XB_SPIN_CAP) { atomicAdd(&(bar)[XB_TMO], 1u); break; } } } } while (0)

struct XcdBarrier {
    unsigned* bar; unsigned x;
    volatile LAS unsigned* st;
};

__device__ __forceinline__ XcdBarrier xcd_barrier_post(unsigned* bar, volatile LAS unsigned* st) {
    XcdBarrier b; b.bar = bar; b.x = xb_xcc_id(); b.st = st;
    if (threadIdx.x == 0) (void)xb_add(&bar[XB_XCNT(b.x)], 1u);
    return b;
}
__device__ __forceinline__ void xcd_barrier_complete(unsigned* bar, unsigned x, unsigned& nloc, unsigned& nx) {
    const unsigned G = gridDim.x * gridDim.y * gridDim.z;
    unsigned sum, cnt, mine, sp = 0u;
    for (;;) {
        sum = 0u; cnt = 0u; mine = 0u;
#pragma unroll
        for (unsigned j = 0; j < 16; ++j) { const unsigned c = xb_ld(&bar[XB_XCNT(j)]); sum += c; cnt += (c > 0u) ? 1u : 0u; mine = (j == x) ? c : mine; }
        if (sum == G) break;
        __builtin_amdgcn_s_sleep(1);
        if ((++sp & 255u) == 0u) { if (xb_ld(&bar[XB_TMO])) break; if (sp > XB_SPIN_CAP) { atomicAdd(&bar[XB_TMO], 1u); break; } }
    }
    nloc = mine > 0u ? mine : 1u; nx = cnt > 0u ? cnt : 1u;
}

__device__ __forceinline__ void xcd_barrier(const XcdBarrier& b) {
    asm volatile("s_waitcnt vmcnt(0)" ::: "memory");
    __syncthreads();
    if (threadIdx.x == 0) {
        unsigned* bar = b.bar;
        __builtin_amdgcn_s_waitcnt(0);
        unsigned nloc = b.st[0], nx = b.st[1];
        if (nloc == 0u) { xcd_barrier_complete(bar, b.x, nloc, nx); b.st[0] = nloc; b.st[1] = nx; }
        const unsigned old = xb_add(&bar[XB_XSUB(b.x)], 1u);
        const unsigned gen = old / nloc;
        if (old + 1u == (gen + 1u) * nloc) {
            __builtin_amdgcn_fence(__ATOMIC_RELEASE, "agent");
            asm volatile("s_waitcnt vmcnt(0)" ::: "memory");
            const unsigned og = xb_add(&bar[XB_TOP], 1u);
            const unsigned tg = og / nx;
            if (og + 1u == (tg + 1u) * nx) xb_add(&bar[XB_TOPGEN], 1u);
            else XB_SPIN(xb_ld(&bar[XB_TOPGEN]) == tg, bar);
            __builtin_amdgcn_fence(__ATOMIC_ACQUIRE, "agent");
            xb_add(&bar[XB_XGEN(b.x)], 1u);
            asm volatile("s_waitcnt vmcnt(0)" ::: "memory");
        } else {
            XB_SPIN(xb_ld(&bar[XB_XGEN(b.x)]) == gen, bar);
            __builtin_amdgcn_fence(__ATOMIC_ACQUIRE, "agent");
            asm volatile("s_waitcnt vmcnt(0)" ::: "memory");
        }
    }
    __syncthreads();
}

struct Args {
    const float *x_prompt, *x_sample, *cache_swa_k, *cache_swa_v, *state_ret, *cache_mem_k, *cache_mem_v, *mem_prompt;
    const float *norm_mix_pre, *norm_mix_post, *norm_mem, *norm_x_pre, *norm_x_post, *norm_ffn_pre, *norm_ffn_post;
    const float *w_ab_in, *w_ab_out, *swa_sinks, *gmlp_ln_g, *gmlp_ln_b, *gmlp_w_s, *gmlp_b_s, *w_ret_in, *w_ret_out, *w_mem_q, *w_mem_k, *w_mem_v, *w_mem_o, *w_ffn_up, *w_ffn_down;
    float* out; unsigned char* ws; int ph_lo, ph_hi, li, pad;
};
#ifndef PHASE_MASK
#define PHASE_MASK 0xFFFFFFFFu
#endif
#define EN(b) (((PHASE_MASK) >> (b)) & 1u)
#ifndef DUPMASK
#define DUPMASK 0u
#endif
#define REPS(b) ((((DUPMASK) >> (b)) & 1u) ? 2 : 1)
#define DUMMY(ptr_t, p_) (dup_ ? (ptr_t)(ws + WS_END + 64 * MiB) : (p_))
constexpr int N_PHASES = 25;

#define CAS __attribute__((address_space(4)))
#define KARGS ((const CAS Args*)__builtin_amdgcn_kernarg_segment_ptr())
#define ARG(f) (*(const float* const volatile CAS*)&(KARGS->f))
#define ARGI(f) (*(const int volatile CAS*)&(KARGS->f))
#define ARG_OUT() (*(float* const volatile CAS*)&(KARGS->out))
#define ARG_WS() (*(unsigned char* const volatile CAS*)&(KARGS->ws))
__global__ void __launch_bounds__(NTHR, 2) fwd(Args a_unused) {
    extern __shared__ __attribute__((aligned(16))) unsigned char lds_raw[];
    Frame F0; F0.lds = (LAS unsigned char*)lds_raw; F0.tid = threadIdx.x; F0.lane = F0.tid & 63; F0.wave = __builtin_amdgcn_readfirstlane(F0.tid >> 6);
    F0.G = gridDim.x; { const int bx = blockIdx.x; F0.vcu = (F0.G % 8 == 0) ? (bx % 8) * (F0.G / 8) + bx / 8 : bx; }
    volatile LAS unsigned* MISC = (volatile LAS unsigned*)(F0.lds + MISC_OFF);
    if (F0.tid < 128) MISC[F0.tid] = 0u;
    __syncthreads();
    const XcdBarrier bar = xcd_barrier_post((unsigned*)(ARG_WS() + WS_CTL + CTL_BAR) + ARGI(li) * XCD_BAR_WORDS, MISC + 8);
    const int lo = ARGI(ph_lo), hi = ARGI(ph_hi);
#define IN(k) (lo <= (k) && (k) < hi)
#define SEAM(k) do { if (IN(k) && IN((k) + 1)) xcd_barrier(bar); } while (0)
#define GW (F.vcu * NWAVES + F.wave)
#define NGW (F.G * NWAVES)
#define IDLE_TJOB(c0_, Wp, WTp, K_, N_, Gp, LDW) do { if ((int)blockIdx.x >= (c0_)) { const int nit_ = ((K_) / 64) * ((N_) / 64), nw_ = ((int)F.G - (c0_)) * NWAVES; const float* W_ = (Wp); bf16* WT_ = (bf16*)(WTp); \
        LAS float* scr_ = (LAS float*)(F.lds + F.wave * 16640); transpose_strided(W_, K_, N_, WT_, scr_, ((int)blockIdx.x - (c0_)) * NWAVES + F.wave, nw_, nit_, F.lane, (Gp), (LDW)); } } while (0)
#define PHASE_FRAME Frame P = F0; asm volatile("" : "+v"(P.tid), "+s"(P.wave), "+s"(P.vcu), "+s"(P.G)); P.lane = P.tid & 63

    if (EN(0) && IN(0)) { for (int rep_ = 0; rep_ < REPS(0); ++rep_) { PHASE_FRAME; const Frame& F = P; const bool dup_ = (rep_ != 0); (void)dup_; if (dup_) __syncthreads();
        unsigned char* ws = ARG_WS();
        LAS float* scr = (LAS float*)(F.lds + F.wave * 16640);
        const int gw = GW, ngw = NGW;
        { u32x4* z1 = (u32x4*)(ws + WS_CTL + CTL_ZVSTAT); u32x4* z2 = (u32x4*)(ws + WS_CTL + CTL_SS);
          for (int x = F.vcu * NTHR + F.tid; x < M * 2 * 8 / 16; x += F.G * NTHR) z1[x] = (u32x4){0u, 0u, 0u, 0u};
          for (int x = F.vcu * NTHR + F.tid; x < M * 8 * 8 / 16; x += F.G * NTHR) z2[x] = (u32x4){0u, 0u, 0u, 0u}; }
        int base = 0;
#define TJOB(Wp, WTp, K_, N_, Gp) do { const int nit = ((K_) / 64) * ((N_) / 64); int it = gw - (base % ngw); if (it < 0) it += ngw; const float* W_ = (Wp); bf16* WT_ = (bf16*)(WTp); \
            const float* G_ = (Gp); transpose_strided(W_, K_, N_, WT_, scr, it, ngw, nit, F.lane, G_, 0); base += nit; } while (0)
        TJOB(ARG(w_ab_in), ws + WT_ABIN, D, AB_IN, ARG(norm_mix_pre));
        TJOB(ARG(w_ab_out), ws + WT_ABOUT, D, D, (const float*)nullptr);
#pragma unroll 1
        for (int l = 0; l < 2; ++l) {
            TJOB(ARG(w_mem_q) + (size_t)l * D * MEMW, ws + WT_MEMQ + (size_t)l * MEMW * D * 2, D, MEMW, ARG(norm_x_pre) + (size_t)l * D);
            TJOB(ARG(w_mem_k) + (size_t)l * D * MEMW, ws + WT_MEMKV + (size_t)(2 * l) * MEMW * D * 2, D, MEMW, (const float*)nullptr);
            TJOB(ARG(w_mem_v) + (size_t)l * D * MEMW, ws + WT_MEMKV + (size_t)(2 * l + 1) * MEMW * D * 2, D, MEMW, (const float*)nullptr);
            TJOB(ARG(w_mem_o) + (size_t)l * MEMW * D, ws + WT_MEMO + (size_t)l * D * MEMW * 2, MEMW, D, (const float*)nullptr);
        }
#undef TJOB
        norm_rows<false, 4>(F, ARG(x_prompt), ARG(x_sample), nullptr, nullptr, nullptr, 0, nullptr, (float*)(ws + WS_RS), nullptr, (bf16*)(ws + WS_XB));
        { const float* memp = ARG(mem_prompt); const float* nmem = ARG(norm_mem); bf16* HM = (bf16*)(ws + WS_HM);
        for (int r2 = (gw + ngw - 1024 % ngw) % ngw; r2 < 1024; r2 += ngw) { const int l = r2 >> 9, row = r2 & 511;     const float* xr = memp + (size_t)row * D; const float* g = nmem + (size_t)l * D;
            f32x4 xv[8]; float ss = 0.f;
#pragma unroll
            for (int j = 0; j < 8; ++j) { xv[j] = ((const f32x4*)xr)[F.lane + 64 * j]; ss += (xv[j][0] * xv[j][0] + xv[j][1] * xv[j][1]) + (xv[j][2] * xv[j][2] + xv[j][3] * xv[j][3]); }
            const float rs = 1.0f / sqrtf(wave_sum(ss) * (1.0f / D) + EPS);
#pragma unroll
            for (int j = 0; j < 8; ++j) { const f32x4 gg = ((const f32x4*)g)[F.lane + 64 * j]; const f32x4 h = xv[j] * rs * gg; u32x2 w; w.x = pk2(h[0], h[1]); w.y = pk2(h[2], h[3]);
                ((u32x2*)(HM + (size_t)r2 * D))[F.lane + 64 * j] = w; } } }
    } }
    SEAM(0);

#pragma unroll 1
    for (int layer = 0; layer < 2; ++layer) {
        const int pb = 1 + 12 * layer;
        if (layer == 0) {
            if (EN(1) && IN(pb + 0)) { for (int rep_ = 0; rep_ < REPS(1); ++rep_) { PHASE_FRAME; const Frame& F = P; const bool dup_ = (rep_ != 0); (void)dup_; if (dup_) __syncthreads();
                unsigned char* ws = ARG_WS(); float* out = ARG_OUT(); bf16* BIG = (bf16*)(ws + WS_BIG);
                pg8::Gemm g{(const bf16*)(ws + WS_XB), (const bf16*)(ws + WT_ABIN), M, AB_IN, D}; pg8::StaticOrder S; S.init(M, AB_IN, D, F.G, (int)blockIdx.x);
                pg8::EpiAbIn E{BIG, out, (const float*)(ws + WS_RS), DUMMY(unsigned long long*, (unsigned long long*)(ws + WS_CTL + CTL_ZVSTAT))};
                static_assert(pg8::EpiAbIn::OK == BIG_K / 2 && pg8::EpiAbIn::OV == BIG_V / 2 && pg8::EpiAbIn::OZU == BIG_ZU / 2 && pg8::EpiAbIn::OZV == BIG_ZV / 2 && pg8::EpiAbIn::OKP == O_SKP && pg8::EpiAbIn::OVS == O_SVS, "maps");
                pg8::gemm_phase<pg8::EpiAbIn, pg8::StaticOrder, true, true>(F.lds, g, S, E);
            } }
            SEAM(pb + 0);
            if (IN(pb + 1)) {
                const bool sample_first = ((blockIdx.x >> 3) & 1) != 0;
#pragma unroll 1
                for (int step = 0; step < 2; ++step) {
                  if ((step == 0) != sample_first) {
                if (EN(2)) { for (int rep_ = 0; rep_ < REPS(2); ++rep_) { PHASE_FRAME; const Frame& F = P; const bool dup_ = (rep_ != 0); (void)dup_; if (dup_) __syncthreads();     unsigned char* ws = ARG_WS(); const bf16* BIG = (const bf16*)(ws + WS_BIG); const float* sinks = ARG(swa_sinks);
                    for (int u = F.vcu; u < 256; u += F.G) swa_prompt_unit(F, u >> 7, (u >> 2) & 31, u & 3, BIG + BIG_Q / 2, BIG + BIG_K / 2, BIG + BIG_V / 2, sinks, (bf16*)(ws + WS_CAT)); } }
                if (EN(3)) { for (int rep_ = 0; rep_ < REPS(3); ++rep_) { PHASE_FRAME; const Frame& F = P; const bool dup_ = (rep_ != 0); (void)dup_; if (dup_) __syncthreads();     unsigned char* ws = ARG_WS(); const bf16* BIG = (const bf16*)(ws + WS_BIG);
                    const float *lng = ARG(gmlp_ln_g), *lnb = ARG(gmlp_ln_b), *wsp = ARG(gmlp_w_s), *bsp = ARG(gmlp_b_s);
                    for (int u = F.vcu; u < 256; u += F.G) gate_prompt_unit(F, u >> 7, (u >> 2) & 31, u & 3, BIG + BIG_ZU / 2, BIG + BIG_ZV / 2, (const long long*)(ws + WS_CTL + CTL_ZVSTAT), lng, lnb, wsp, bsp, (bf16*)(ws + WS_CAT)); } }
                  } else {
                if (EN(4)) { for (int rep_ = 0; rep_ < REPS(4); ++rep_) { PHASE_FRAME; const Frame& F = P; const bool dup_ = (rep_ != 0); (void)dup_; if (dup_) __syncthreads();     unsigned char* ws = ARG_WS(); float* out = ARG_OUT(); const bf16* BIG = (const bf16*)(ws + WS_BIG); const float *ck = ARG(cache_swa_k), *cv = ARG(cache_swa_v), *sinks = ARG(swa_sinks);
                    for (int u = F.vcu; u < 256; u += F.G) swa_sample_unit(F, u >> 1, u & 1, BIG + BIG_Q / 2, BIG + BIG_K / 2, BIG + BIG_V / 2, ck, cv, sinks, (bf16*)(ws + WS_CAT), out + O_SKS, out + O_SVS); } }
                if (EN(5)) { for (int rep_ = 0; rep_ < REPS(5); ++rep_) { PHASE_FRAME; const Frame& F = P; const bool dup_ = (rep_ != 0); (void)dup_; if (dup_) __syncthreads();     unsigned char* ws = ARG_WS(); float* out = ARG_OUT(); const bf16* BIG = (const bf16*)(ws + WS_BIG);
                    const float *lng = ARG(gmlp_ln_g), *lnb = ARG(gmlp_ln_b), *wsp = ARG(gmlp_w_s), *bsp = ARG(gmlp_b_s);
                    for (int u = F.vcu; u < 256; u += F.G) gate_sample_unit(F, u >> 1, u & 1, BIG + BIG_ZU / 2, BIG + BIG_ZV / 2, (const long long*)(ws + WS_CTL + CTL_ZVSTAT), lng, lnb, wsp, bsp, (bf16*)(ws + WS_CAT), out + O_GV); } }
                  }
                }
            }
            SEAM(pb + 1);
            if (EN(6) && IN(pb + 3)) { for (int rep_ = 0; rep_ < REPS(6); ++rep_) { PHASE_FRAME; const Frame& F = P; const bool dup_ = (rep_ != 0); (void)dup_; if (dup_) __syncthreads();
                unsigned char* ws = ARG_WS();
                pg8::Gemm g{(const bf16*)(ws + WS_CAT), (const bf16*)(ws + WT_ABOUT), M, D, D}; pg8::PanelK S; S.init(D, F.G, F.vcu);
                pg8::EpiPart E{(bf16*)(ws + WS_Y0), (bf16*)(ws + WS_Y1)};
                pg8::gemm_phase<pg8::EpiPart, pg8::PanelK, true, true>(F.lds, g, S, E);
            } }
        } else {
            if (EN(7) && IN(pb + 0)) { for (int rep_ = 0; rep_ < REPS(7); ++rep_) { PHASE_FRAME; const Frame& F = P; const bool dup_ = (rep_ != 0); (void)dup_; if (dup_) __syncthreads();
                unsigned char* ws = ARG_WS();
                pg8::Gemm g{(const bf16*)(ws + WS_XB), (const bf16*)(ws + WT_RETIN), M, RET_IN, D}; pg8::StaticOrder S; S.init(M, RET_IN, D, F.G, (int)blockIdx.x);
                pg8::EpiRetIn E{(bf16*)(ws + WS_BIG), (const float*)(ws + WS_RS)};
                pg8::gemm_phase<pg8::EpiRetIn, pg8::StaticOrder, true, true>(F.lds, g, S, E);
            } }
            SEAM(pb + 0);
            if (IN(pb + 1)) {
                const int bx = blockIdx.x; const bool halves = (F0.G % 16 == 0);
                const int role = halves ? ((bx >> 3) & 1) : 0, rank = halves ? ((bx & 7) + 8 * (bx >> 4)) : bx, nrole0 = halves ? F0.G / 2 : F0.G;
                if (EN(9) && role == 0) { for (int rep_ = 0; rep_ < REPS(9); ++rep_) { PHASE_FRAME; const Frame& F = P; const bool dup_ = (rep_ != 0); (void)dup_; if (dup_) __syncthreads();     unsigned char* ws = ARG_WS(); float* out = ARG_OUT();
#ifdef SCAN_DELAY_TICKS
                    { const unsigned long long t0_ = __builtin_amdgcn_s_memrealtime(); while (__builtin_amdgcn_s_memrealtime() - t0_ < SCAN_DELAY_TICKS) __builtin_amdgcn_s_sleep(8); }
#endif
                    for (int u = rank; u < 128; u += nrole0) ret_prompt_scan(F, u >> 6, (u >> 3) & 7, u & 7, (const bf16*)(ws + WS_BIG), (bf16*)(ws + WS_OR), DUMMY(unsigned long long*, (unsigned long long*)(ws + WS_CTL + CTL_SS)), out + O_RP); } }
                if (EN(8)) { for (int rep_ = 0; rep_ < REPS(8); ++rep_) { PHASE_FRAME; const Frame& F = P; const bool dup_ = (rep_ != 0); (void)dup_; if (dup_) __syncthreads();     unsigned char* ws = ARG_WS(); float* out = ARG_OUT(); const float* st = ARG(state_ret);
                    unsigned* qctr = (unsigned*)(ws + WS_CTL + CTL_QUEUE) + (dup_ ? 64 : 0); volatile LAS unsigned* qw = (volatile LAS unsigned*)(F.lds + MISC_OFF + 64);
                    for (;;) {
                        if (F.tid == 0) qw[0] = atomicAdd(qctr, 1u);
                        __syncthreads();
                        const unsigned pss = (unsigned)__builtin_amdgcn_readfirstlane((int)qw[0]);
                        __syncthreads();
                        if (pss >= 512u) break;
                        ret_sample_pass(F, (int)pss * 2, (const bf16*)(ws + WS_BIG), st, out + O_RS, (bf16*)(ws + WS_OR), DUMMY(unsigned long long*, (unsigned long long*)(ws + WS_CTL + CTL_SS))); } } }
            }
            SEAM(pb + 1);
            if (EN(10) && IN(pb + 2)) { for (int rep_ = 0; rep_ < REPS(10); ++rep_) { PHASE_FRAME; const Frame& F = P; const bool dup_ = (rep_ != 0); (void)dup_; if (dup_) __syncthreads();     unsigned char* ws = ARG_WS(); ret_norm_rows<5>(F, (const bf16*)(ws + WS_OR), (const bf16*)(ws + WS_BIG), (const unsigned long long*)(ws + WS_CTL + CTL_SS), (bf16*)(ws + WS_CAT)); } }
            SEAM(pb + 2);
            if (EN(11) && IN(pb + 3)) { for (int rep_ = 0; rep_ < REPS(11); ++rep_) { PHASE_FRAME; const Frame& F = P; const bool dup_ = (rep_ != 0); (void)dup_; if (dup_) __syncthreads();
                unsigned char* ws = ARG_WS();
                pg8::Gemm g{(const bf16*)(ws + WS_CAT), (const bf16*)(ws + WT_RETOUT), M, D, 4096}; pg8::PanelK S; S.init(4096, F.G, F.vcu);
                pg8::EpiPart E{(bf16*)(ws + WS_Y0), (bf16*)(ws + WS_Y1)};
                pg8::gemm_phase<pg8::EpiPart, pg8::PanelK, true, true>(F.lds, g, S, E);
            } }
        }
        SEAM(pb + 3);
        if (EN(12) && IN(pb + 4)) { for (int rep_ = 0; rep_ < REPS(12); ++rep_) { PHASE_FRAME; const Frame& F = P; const bool dup_ = (rep_ != 0); (void)dup_; if (dup_) __syncthreads();
            unsigned char* ws = ARG_WS(); float* X = ARG_OUT() + O_X;
            pg8::PanelK S; S.init(layer == 0 ? D : 4096, F.G, 0);
            bf16* XB = (bf16*)(ws + WS_XB); (void)X;
            norm_rows_pipe<true>(F, XB, (const bf16*)(ws + WS_Y0), (const bf16*)(ws + WS_Y1), S.splits, ARG(norm_mix_post) + (size_t)layer * D, DUMMY(float*, (float*)(ws + WS_RS)), nullptr, DUMMY(bf16*, XB));
        } }
        SEAM(pb + 4);
        if (IN(pb + 5)) {
            if (EN(13)) { for (int rep_ = 0; rep_ < REPS(13); ++rep_) { PHASE_FRAME; const Frame& F = P; const bool dup_ = (rep_ != 0); (void)dup_; if (dup_) __syncthreads();     unsigned char* ws = ARG_WS();
              pg8::Gemm g{(const bf16*)(ws + WS_XB), (const bf16*)(ws + WT_MEMQ) + (size_t)layer * MEMW * D, M, MEMW, D}; pg8::SplitK2 S; S.init(D, F.G, (int)blockIdx.x);
              pg8::EpiBf16<0> E{(bf16*)(ws + WS_QM), MEMW, (const float*)(ws + WS_RS), QSEG};
              pg8::gemm_phase<pg8::EpiBf16<0>, pg8::SplitK2, true, true>(F.lds, g, S, E); } }
            if (EN(14) && layer == 0) { for (int rep_ = 0; rep_ < REPS(14); ++rep_) { PHASE_FRAME; const Frame& F = P; const bool dup_ = (rep_ != 0); (void)dup_; if (dup_) __syncthreads();     unsigned char* ws = ARG_WS(); float* out = ARG_OUT();
                pg8::Gemm g{(const bf16*)(ws + WS_HM), (const bf16*)(ws + WT_MEMKV), 1024, 2048, D}; pg8::MemKVOrder S{F.G, (int)((blockIdx.x + F.G - (144 % F.G)) % F.G)};
                pg8::EpiMemKV E{out + O_MK, out + O_MV, (bf16*)(ws + WS_MKV)};
                pg8::gemm_phase<pg8::EpiMemKV, pg8::MemKVOrder, true, true>(F.lds, g, S, E);
            } }
            if (EN(22)) { for (int rep_ = 0; rep_ < REPS(22); ++rep_) { PHASE_FRAME; const Frame& F = P; const bool dup_ = (rep_ != 0); if (dup_) __syncthreads(); unsigned char* ws = ARG_WS();
                unsigned* tq = (unsigned*)(ws + WS_CTL + CTL_TQ) + layer * 64 + (dup_ ? 128 : 0); LAS float* scr = (LAS float*)(F.lds + F.wave * 16640);
                const int n_up = (D / 64) * (FF / 64), n_dn = (layer == 0) ? n_up : 0, n_ro = (layer == 0) ? (4096 / 64) * (D / 64) : 0, n_all = n_up + n_dn + n_ro;
                const float* w_up = ARG(w_ffn_up) + (size_t)layer * D * FF; const float* w_dn = ARG(w_ffn_down) + (size_t)layer * FF * D; const float* w_ro = ARG(w_ret_out); const float* g_up = ARG(norm_ffn_pre) + (size_t)layer * D;
                volatile LAS unsigned* tqw = (volatile LAS unsigned*)(F.lds + MISC_OFF + 96);
#define TQ_RUN(qi, Wp, K_, N_, WTp, Gp, LDW, NIT) do { const int nit_ = (NIT); const float* W_ = (Wp); bf16* WT_ = (bf16*)(WTp); const float* G_ = (Gp); \
                    for (;;) { if (F.tid == 0) tqw[0] = atomicAdd(tq + (qi) * 16, 64u); __syncthreads(); const int base = __builtin_amdgcn_readfirstlane((int)tqw[0]); __syncthreads(); if (base >= nit_) break; \
                        transpose_strided(W_, K_, N_, WT_, scr, base + F.wave, 8, (base + 64 < nit_) ? base + 64 : nit_, F.lane, G_, (LDW)); } } while (0)
                TQ_RUN(0, w_up, D, FF, ws + WT_UP + (size_t)layer * FF * D * 2, g_up, 0, n_up);
                if (layer == 0) { TQ_RUN(1, w_dn, FF, D, ws + WS_WTD, (const float*)nullptr, LDFF, n_dn); TQ_RUN(2, w_ro, 4096, D, ws + WT_RETOUT, (const float*)nullptr, 0, n_ro); }
#undef TQ_RUN
                (void)n_all; } }
        }
        SEAM(pb + 5);
        if (IN(pb + 6)) {
            { const bool sample_first = ((blockIdx.x >> 3) & 1) != 0;
#pragma unroll 1
              for (int step = 0; step < 2; ++step) {
                  if ((step == 0) != sample_first) { if (EN(15)) { PHASE_FRAME; const Frame& F = P; unsigned char* ws = ARG_WS();
                      for (int u = F.vcu; u < 256; u += F.G) mem_prompt_unit(F, u >> 7, (u >> 5) & 3, u & 31, (const bf16*)(ws + WS_QM), (const bf16*)(ws + WS_MKV) + (size_t)layer * 512 * 1024, (bf16*)(ws + WS_OM)); } }
                  else { if (EN(16)) { PHASE_FRAME; const Frame& F = P; unsigned char* ws = ARG_WS(); const float* ck = ARG(cache_mem_k) + (size_t)layer * NS * 256 * 512; const float* cv = ARG(cache_mem_v) + (size_t)layer * NS * 256 * 512;
                      mem_sample_units(F, F.vcu, F.G, (const bf16*)(ws + WS_QM), ck, cv, (bf16*)(ws + WS_OM)); } } } }
        }
        SEAM(pb + 6);
        if (EN(17) && IN(pb + 7)) { for (int rep_ = 0; rep_ < REPS(17); ++rep_) { PHASE_FRAME; const Frame& F = P; const bool dup_ = (rep_ != 0); (void)dup_; if (dup_) __syncthreads();
            unsigned char* ws = ARG_WS();
            pg8::Gemm g{(const bf16*)(ws + WS_OM), (const bf16*)(ws + WT_MEMO) + (size_t)layer * D * MEMW, M, D, MEMW}; pg8::PanelK S; S.init(MEMW, F.G, F.vcu);
            pg8::EpiPart E{(bf16*)(ws + WS_Y0), (bf16*)(ws + WS_Y1)};
            pg8::gemm_phase<pg8::EpiPart, pg8::PanelK, true, true>(F.lds, g, S, E);
        } }
        SEAM(pb + 7);
        if (EN(18) && IN(pb + 8)) { for (int rep_ = 0; rep_ < REPS(18); ++rep_) { PHASE_FRAME; const Frame& F = P; const bool dup_ = (rep_ != 0); (void)dup_; if (dup_) __syncthreads();     unsigned char* ws = ARG_WS(); float* X = ARG_OUT() + O_X;
            bf16* XB = (bf16*)(ws + WS_XB); (void)X;
            norm_rows_pipe<true>(F, XB, (const bf16*)(ws + WS_Y0), (const bf16*)(ws + WS_Y1), 4, ARG(norm_x_post) + (size_t)layer * D, DUMMY(float*, (float*)(ws + WS_RS)), nullptr, DUMMY(bf16*, XB)); } }
        SEAM(pb + 8);
        if (EN(19) && IN(pb + 9)) { for (int rep_ = 0; rep_ < REPS(19); ++rep_) { PHASE_FRAME; const Frame& F = P; const bool dup_ = (rep_ != 0); (void)dup_; if (dup_) __syncthreads();
            unsigned char* ws = ARG_WS();
            pg8::Gemm g{(const bf16*)(ws + WS_XB), (const bf16*)(ws + WT_UP) + (size_t)layer * FF * D, M, FF, D}; pg8::StaticOrder S; S.init(M, FF, D, F.G, (int)blockIdx.x);
            pg8::EpiBf16<2> E{(bf16*)(ws + WS_BIG), LDFF, (const float*)(ws + WS_RS)};
            pg8::gemm_phase<pg8::EpiBf16<2>, pg8::StaticOrder, true, true>(F.lds, g, S, E);
            { const int c0 = (F.G > 128) ? 128 : 0;
              if (layer == 0) IDLE_TJOB(c0, ARG(w_ret_in), ws + WT_RETIN, D, RET_IN, ARG(norm_mix_pre) + D, 0);
              else IDLE_TJOB(c0, ARG(w_ffn_down) + (size_t)FF * D, ws + WS_WTD + (size_t)D * LDFF * 2, FF, D, (const float*)nullptr, LDFF); }
        } }
        SEAM(pb + 9);
        if (EN(20) && IN(pb + 10)) { for (int rep_ = 0; rep_ < REPS(20); ++rep_) { PHASE_FRAME; const Frame& F = P; const bool dup_ = (rep_ != 0); (void)dup_; if (dup_) __syncthreads();
            unsigned char* ws = ARG_WS();
            pg8::Gemm g{(const bf16*)(ws + WS_BIG), (const bf16*)(ws + WS_WTD) + (size_t)layer * D * LDFF, M, D, FF, LDFF, LDFF}; pg8::PanelK S; S.init(FF, F.G, F.vcu);
            pg8::EpiPart E{(bf16*)(ws + WS_Y0), (bf16*)(ws + WS_Y1)};
            pg8::gemm_phase<pg8::EpiPart, pg8::PanelK, true, true>(F.lds, g, S, E);
        } }
        SEAM(pb + 10);
        if (EN(21) && IN(pb + 11)) { for (int rep_ = 0; rep_ < REPS(21); ++rep_) { PHASE_FRAME; const Frame& F = P; const bool dup_ = (rep_ != 0); (void)dup_; if (dup_) __syncthreads();     unsigned char* ws = ARG_WS(); float* X = ARG_OUT() + O_X;
            pg8::PanelK S; S.init(FF, F.G, 0);
            bf16* XB = (bf16*)(ws + WS_XB);
            norm_rows_pipe<false>(F, XB, (const bf16*)(ws + WS_Y0), (const bf16*)(ws + WS_Y1), S.splits, ARG(norm_ffn_post) + (size_t)layer * D, layer == 0 ? DUMMY(float*, (float*)(ws + WS_RS)) : (float*)nullptr,
                            layer == 0 ? (float*)nullptr : DUMMY(float*, X), layer == 0 ? DUMMY(bf16*, XB) : (bf16*)nullptr); } }
        if (layer == 0) SEAM(pb + 11);
    }
#undef IN
#undef SEAM
}

#ifndef MK_N_LAUNCHES
#define MK_N_LAUNCHES 1
#endif
extern "C" void kernel_launch(void* const* d_in, const int* in_sizes, int n_in, void* d_out, int out_size, void* d_ws, size_t ws_size, hipStream_t stream) {
    static int grid = 0;
    if (grid == 0) {
        if (n_in != 30 || out_size != (int)O_END || ws_size < WS_END) { fprintf(stderr, "kernel_launch: unexpected shapes (n_in %d, out %d, ws %zu)\n", n_in, out_size, ws_size); grid = -1; return; }
        int dev = 0, cus = 0, per_cu = 0;
        if (hipGetDevice(&dev) != hipSuccess || hipDeviceGetAttribute(&cus, hipDeviceAttributeMultiprocessorCount, dev) != hipSuccess) { grid = -1; return; }
        if (hipFuncSetAttribute((const void*)fwd, hipFuncAttributeMaxDynamicSharedMemorySize, LDS_BYTES) != hipSuccess) { fprintf(stderr, "kernel_launch: hipFuncSetAttribute failed\n"); grid = -1; return; }
        if (hipOccupancyMaxActiveBlocksPerMultiprocessor(&per_cu, (const void*)fwd, NTHR, LDS_BYTES) != hipSuccess || per_cu < 1) fprintf(stderr, "kernel_launch: occupancy query says %d\n", per_cu);
        (void)hipGetLastError();
        grid = cus;
    }
    if (grid < 0) return;
    (void)hipMemsetAsync((char*)d_ws + WS_CTL, 0, CTL_ZERO_BYTES, stream);
    Args a{};
    const float** p = (const float**)&a;
    for (int i = 0; i < 30; ++i) p[i] = (const float*)d_in[i];
    a.out = (float*)d_out; a.ws = (unsigned char*)d_ws; a.pad = 0;
    for (int li = 0; li < MK_N_LAUNCHES; ++li) {
        a.ph_lo = (MK_N_LAUNCHES == 1) ? 0 : li; a.ph_hi = (MK_N_LAUNCHES == 1) ? N_PHASES : li + 1; a.li = li;
        hipLaunchKernelGGL(fwd, dim3(grid), dim3(NTHR), LDS_BYTES, stream, a);
    }
}
```
